# Optimizing an MI355X kernel written in HIP

```python
import math
import jax, jax.numpy as jnp
from jax import lax
import numpy as np

D_MODEL = 1024
BATCH = 8
SEQ = 8192
DEPTH = 2

CHUNK = 64
HEAD_DIM = 64
D_A = 384
HEADS_A = D_A // HEAD_DIM
D_B = 256
HEADS_B = D_B // HEAD_DIM
D_C = 384
HEADS_C = D_C // HEAD_DIM
D_MIX = D_A + D_B + D_C
IN_COLS = 2 * D_A + 3 * D_B + 2 * D_C
CONV_A_WIDTH = 31
CONV_B_WIDTH = 3
SG_BLOCK = 128
PEER_HEADS = 8
D_KEY = 256
N_KEYS = 128
N_EXPERTS = N_KEYS * N_KEYS
TOPK = 16
PEER_BLOCK = 128
PLE_DIM = 256
EPS = 1e-6

kernel_name = "hybrid_conv_sgmlp_peer_trunk"


def rmsnorm(x, g):
    xf = x.astype(jnp.float32)
    y = xf * lax.rsqrt(jnp.mean(xf * xf, axis=-1, keepdims=True) + EPS)
    return (y * g.astype(jnp.float32)).astype(x.dtype)


def group_layernorm(x, g, b, heads):
    shp = x.shape
    xf = x.astype(jnp.float32).reshape(shp[:-1] + (heads, shp[-1] // heads))
    m = jnp.mean(xf, axis=-1, keepdims=True)
    var = jnp.mean(jnp.square(xf - m), axis=-1, keepdims=True)
    y = ((xf - m) * lax.rsqrt(var + EPS)).reshape(shp)
    return (y * g.astype(jnp.float32) + b.astype(jnp.float32)).astype(x.dtype)


def causal_dwconv(x, w):
    k = w.shape[0]
    return lax.conv_general_dilated(
        x, w.astype(x.dtype)[:, None, :], window_strides=(1,), padding=[(k - 1, 0)],
        dimension_numbers=("NWC", "WIO", "NWC"), feature_group_count=x.shape[-1])


def conformer_conv(za, conv_w, conv_b, ln_g, ln_b):
    val, gate = jnp.split(za, 2, axis=-1)
    y = val * jax.nn.sigmoid(gate)
    y = causal_dwconv(y, conv_w) + conv_b.astype(y.dtype)
    y = group_layernorm(y, ln_g, ln_b, HEADS_A)
    return jax.nn.silu(y)


def short_gated_conv(zb, conv_w):
    bg, cg, xb = jnp.split(zb, 3, axis=-1)
    return bg * causal_dwconv(cg * xb, conv_w)


def spatial_gating(zc, ln_g, ln_b, w_s, b_s):
    u, v = jnp.split(zc, 2, axis=-1)
    bsz, s, _ = v.shape
    v = group_layernorm(v, ln_g, ln_b, HEADS_C)
    vb = v.reshape(bsz, s // SG_BLOCK, SG_BLOCK, HEADS_C, HEAD_DIM)
    pos = jnp.arange(SG_BLOCK)
    mask = (pos[None, :] // CHUNK) <= (pos[:, None] // CHUNK)
    ws = jnp.where(mask[None], w_s, 0).astype(v.dtype)
    mixed = jnp.einsum("hij,bnjhc->bnihc", ws, vb) + b_s.T.astype(v.dtype)[None, None, :, :, None]
    return u * mixed.reshape(bsz, s, D_C)


def peer(n, w_q, sub_keys, expert_u, expert_v):
    bsz, s, d = n.shape
    t = bsz * s
    nf = n.reshape(t, d)
    q = (nf @ w_q).reshape(t, PEER_HEADS, D_KEY)
    q1, q2 = q[..., : D_KEY // 2], q[..., D_KEY // 2:]
    s1 = jnp.einsum("thd,hkd->thk", q1, sub_keys[:, 0])
    s2 = jnp.einsum("thd,hkd->thk", q2, sub_keys[:, 1])
    v1, i1 = lax.top_k(s1, TOPK)
    v2, i2 = lax.top_k(s2, TOPK)
    cand = (v1[..., :, None] + v2[..., None, :]).reshape(t, PEER_HEADS, TOPK * TOPK)
    vals, ci = lax.top_k(cand, TOPK)
    e1 = jnp.take_along_axis(i1, ci // TOPK, axis=-1)
    e2 = jnp.take_along_axis(i2, ci % TOPK, axis=-1)
    idx = (e1 * N_KEYS + e2).reshape(t, PEER_HEADS * TOPK)
    gates = jax.nn.softmax(vals.astype(jnp.float32), axis=-1).astype(n.dtype)
    gates = gates.reshape(t, PEER_HEADS * TOPK)
    nblk = t // PEER_BLOCK

    def block(args):
        xb, ib, gb = args
        ug = expert_u[ib]
        act = jax.nn.gelu(jnp.einsum("td,tkd->tk", xb, ug)) * gb
        vg = expert_v[ib]
        return jnp.einsum("tk,tkd->td", act, vg)

    out = lax.map(block, (nf.reshape(nblk, PEER_BLOCK, d),
                          idx.reshape(nblk, PEER_BLOCK, PEER_HEADS * TOPK),
                          gates.reshape(nblk, PEER_BLOCK, PEER_HEADS * TOPK)))
    return out.reshape(bsz, s, d)


def setup_inputs(seed: int = 0) -> dict:
    key = jax.random.key(seed)
    ks = jax.random.split(key, 24)
    L, D = DEPTH, D_MODEL
    nrm = lambda k, shp, sc: jax.random.normal(k, shp, jnp.float32) * sc
    gain = lambda k, shp: 1.0 + 0.05 * jax.random.normal(k, shp, jnp.float32)
    return {
        "x": nrm(ks[0], (BATCH, SEQ, D), 1.0),
        "p": nrm(ks[1], (DEPTH, BATCH, SEQ, PLE_DIM), 1.0),
        "g_mix": gain(ks[2], (L, D)),
        "w_in": nrm(ks[3], (L, D, IN_COLS), D ** -0.5),
        "conv_a_w": nrm(ks[4], (L, CONV_A_WIDTH, D_A), CONV_A_WIDTH ** -0.5),
        "conv_a_b": nrm(ks[5], (L, D_A), 0.02),
        "ln_a_g": gain(ks[6], (L, D_A)),
        "ln_a_b": nrm(ks[7], (L, D_A), 0.02),
        "conv_b_w": nrm(ks[8], (L, CONV_B_WIDTH, D_B), CONV_B_WIDTH ** -0.5),
        "ln_c_g": gain(ks[9], (L, D_C)),
        "ln_c_b": nrm(ks[10], (L, D_C), 0.02),
        "w_s": nrm(ks[11], (L, HEADS_C, SG_BLOCK, SG_BLOCK), 0.5 * SG_BLOCK ** -0.5),
        "b_s": gain(ks[12], (L, HEADS_C, SG_BLOCK)),
        "w_out": nrm(ks[13], (L, D_MIX, D), D_MIX ** -0.5),
        "g_ffn": gain(ks[14], (L, D)),
        "w_q": nrm(ks[15], (L, D, PEER_HEADS * D_KEY), D ** -0.5),
        "sub_keys": nrm(ks[16], (L, PEER_HEADS, 2, N_KEYS, D_KEY // 2), (D_KEY // 2) ** -0.5),
        "expert_u": nrm(ks[17], (L, N_EXPERTS, D), D ** -0.5),
        "expert_v": nrm(ks[18], (L, N_EXPERTS, D), 0.1),
        "g_ple": gain(ks[19], (L, D)),
        "w_pe": nrm(ks[20], (L, PLE_DIM, D), PLE_DIM ** -0.5),
        "w_pg": nrm(ks[21], (L, D, D), D ** -0.5),
        "g_final": gain(ks[22], (D,)),
    }


def reference(x, p, g_mix, w_in, conv_a_w, conv_a_b, ln_a_g, ln_a_b, conv_b_w, ln_c_g, ln_c_b,
              w_s, b_s, w_out, g_ffn, w_q, sub_keys, expert_u, expert_v, g_ple, w_pe, w_pg,
              g_final):
    h = x
    for i in range(DEPTH):
        a = rmsnorm(h, g_mix[i])
        z = a @ w_in[i]
        za = z[..., : 2 * D_A]
        zb = z[..., 2 * D_A: 2 * D_A + 3 * D_B]
        zc = z[..., 2 * D_A + 3 * D_B:]
        ya = conformer_conv(za, conv_a_w[i], conv_a_b[i], ln_a_g[i], ln_a_b[i])
        yb = short_gated_conv(zb, conv_b_w[i])
        yc = spatial_gating(zc, ln_c_g[i], ln_c_b[i], w_s[i], b_s[i])
        h = h + jnp.concatenate([ya, yb, yc], axis=-1) @ w_out[i]
        h = h + peer(rmsnorm(h, g_ffn[i]), w_q[i], sub_keys[i], expert_u[i], expert_v[i])
        gate = jax.nn.sigmoid(rmsnorm(h, g_ple[i]) @ w_pg[i])
        h = h + (p[i] @ w_pe[i]) * gate
    return rmsnorm(h, g_final)
```

```cpp
#include <hip/hip_runtime.h>
#include <hip/hip_bf16.h>
#include <hip/hip_cooperative_groups.h>
#include <cstdio>
namespace cg = cooperative_groups;

#ifndef ONE_LAUNCH
#define ONE_LAUNCH 1
#endif

typedef unsigned short bf16_t;
using bf16x8 = __attribute__((ext_vector_type(8))) short;
using f32x4 = __attribute__((ext_vector_type(4))) float;

constexpr int T = 65536;
constexpr int D = 1024;
constexpr int SEQ = 8192;
constexpr int INC = 2304;
constexpr int NEXP = 16384;
constexpr float EPS = 1e-6f;
constexpr int SMEM_BYTES = 65536;
constexpr int NPHASE = 20;

constexpr size_t OFF_WINT = 0;
constexpr size_t OFF_WOUTT = OFF_WINT + (size_t)2 * 2304 * 1024 * 2;
constexpr size_t OFF_WQT = OFF_WOUTT + (size_t)2 * 1024 * 1024 * 2;
constexpr size_t OFF_WPGT = OFF_WQT + (size_t)2 * 2048 * 1024 * 2;
constexpr size_t OFF_WPET = OFF_WPGT + (size_t)2 * 1024 * 1024 * 2;
constexpr size_t OFF_KEYS = OFF_WPET + (size_t)2 * 1024 * 256 * 2;
constexpr size_t OFF_EU = OFF_KEYS + (size_t)2 * 8 * 2 * 128 * 128 * 2;
constexpr size_t OFF_EV = OFF_EU + (size_t)2 * NEXP * 1024 * 2;
constexpr size_t OFF_PBF = OFF_EV + (size_t)2 * NEXP * 1024 * 2;
constexpr size_t OFF_ABUF = OFF_PBF + (size_t)2 * T * 256 * 2;
constexpr size_t OFF_Z = OFF_ABUF + (size_t)T * 1024 * 2;
constexpr size_t OFF_IDX = OFF_Z + (size_t)T * 2304 * 2;
constexpr size_t OFF_GATE = OFF_IDX + (size_t)T * 128 * 4;
constexpr size_t WS_END = OFF_GATE + (size_t)T * 128 * 4;

struct Params {
  const float* in[23];
  float* out;
  char* ws;
  int ph_lo, ph_hi;
};

__device__ __forceinline__ unsigned short f2bf(float f) {
  unsigned u = __float_as_uint(f);
  u += 0x7fffu + ((u >> 16) & 1u);
  return (unsigned short)(u >> 16);
}
__device__ __forceinline__ float bf2f(unsigned short b) { return __uint_as_float(((unsigned)b) << 16); }
__device__ __forceinline__ unsigned pack2(float a, float b) { return (unsigned)f2bf(a) | ((unsigned)f2bf(b) << 16); }
__device__ __forceinline__ float bflo(unsigned u) { return __uint_as_float(u << 16); }
__device__ __forceinline__ float bfhi(unsigned u) { return __uint_as_float(u & 0xffff0000u); }
__device__ __forceinline__ float sigmoidf_(float x) { return 1.0f / (1.0f + __expf(-x)); }
__device__ __forceinline__ float gelu_tanh(float x) {
  float u = 0.7978845608028654f * (x + 0.044715f * x * x * x);
  float e = __expf(2.0f * u);
  float th = 1.0f - 2.0f / (e + 1.0f);
  return 0.5f * x * (1.0f + th);
}
template <int CTRL>
__device__ __forceinline__ float dpp_f(float v) {
  return __int_as_float(__builtin_amdgcn_update_dpp(0, __float_as_int(v), CTRL, 0xF, 0xF, true));
}
__device__ __forceinline__ float wave_sum(float v) {
  v += dpp_f<0xB1>(v);
  v += dpp_f<0x4E>(v);
  v += dpp_f<0x141>(v);
  v += dpp_f<0x140>(v);
  float s = __int_as_float(__builtin_amdgcn_readlane(__float_as_int(v), 0)) +
            __int_as_float(__builtin_amdgcn_readlane(__float_as_int(v), 16)) +
            __int_as_float(__builtin_amdgcn_readlane(__float_as_int(v), 32)) +
            __int_as_float(__builtin_amdgcn_readlane(__float_as_int(v), 48));
  return s;
}

__device__ __forceinline__ int lds_off(int r, int c) { return r * 128 + ((c ^ ((r >> 1) & 7)) << 4); }

__device__ __forceinline__ void gemm_kloop(const int TIDX, const int BIDX, const bf16_t* __restrict__ A, int lda,
                                           const bf16_t* __restrict__ Bt, int ldb, int K,
                                           char* smem, f32x4 (&acc)[4][4]) {
  const int tid = TIDX, lane = tid & 63, wid = tid >> 6;
  const int wr = wid >> 1, wc = wid & 1;
  const int fr = lane & 15, fq = lane >> 4;
  const int sr = tid >> 3, sc = tid & 7;
  const bf16_t* ga = A + (size_t)sr * lda + sc * 8;
  const bf16_t* gb = Bt + (size_t)sr * ldb + sc * 8;
  uint4 ra[4], rb[4];
#pragma unroll
  for (int i = 0; i < 4; ++i) {
    ra[i] = *(const uint4*)(ga + (size_t)(32 * i) * lda);
    rb[i] = *(const uint4*)(gb + (size_t)(32 * i) * ldb);
  }
#pragma unroll
  for (int mi = 0; mi < 4; ++mi)
#pragma unroll
    for (int ni = 0; ni < 4; ++ni) acc[mi][ni] = f32x4{0.f, 0.f, 0.f, 0.f};
#pragma unroll
  for (int i = 0; i < 4; ++i) {
    *(uint4*)(smem + lds_off(sr + 32 * i, sc)) = ra[i];
    *(uint4*)(smem + 16384 + lds_off(sr + 32 * i, sc)) = rb[i];
  }
  __syncthreads();
  const int nt = K >> 6;
  for (int kt = 0; kt < nt; ++kt) {
    char* bufp = smem + (kt & 1) * 32768;
    const bool more = (kt + 1 < nt);
    if (more) {
#pragma unroll
      for (int i = 0; i < 4; ++i) {
        ra[i] = *(const uint4*)(ga + (size_t)(32 * i) * lda + (kt + 1) * 64);
        rb[i] = *(const uint4*)(gb + (size_t)(32 * i) * ldb + (kt + 1) * 64);
      }
    }
#pragma unroll
    for (int kk = 0; kk < 2; ++kk) {
      bf16x8 af[4], bfr[4];
#pragma unroll
      for (int mi = 0; mi < 4; ++mi) af[mi] = *(const bf16x8*)(bufp + lds_off(wr * 64 + mi * 16 + fr, kk * 4 + fq));
#pragma unroll
      for (int ni = 0; ni < 4; ++ni) bfr[ni] = *(const bf16x8*)(bufp + 16384 + lds_off(wc * 64 + ni * 16 + fr, kk * 4 + fq));
#pragma unroll
      for (int mi = 0; mi < 4; ++mi)
#pragma unroll
        for (int ni = 0; ni < 4; ++ni)
          acc[mi][ni] = __builtin_amdgcn_mfma_f32_16x16x32_bf16(bfr[ni], af[mi], acc[mi][ni], 0, 0, 0);
    }
    if (more) {
      char* nb = smem + ((kt + 1) & 1) * 32768;
#pragma unroll
      for (int i = 0; i < 4; ++i) {
        *(uint4*)(nb + lds_off(sr + 32 * i, sc)) = ra[i];
        *(uint4*)(nb + 16384 + lds_off(sr + 32 * i, sc)) = rb[i];
      }
    }
    __syncthreads();
  }
}

struct TileIter {
  int nN, total, li, step, x;
  bool swz;
  __device__ TileIter(int nN_, const int BIDX) {
    nN = nN_;
    int G = gridDim.x, b = BIDX;
    swz = ((G & 7) == 0);
    if (swz) { x = b & 7; li = b >> 3; step = G >> 3; total = 64 * nN; }
    else { x = 0; li = b; step = G; total = 512 * nN; }
  }
  __device__ bool valid() const { return li < total; }
  __device__ void next() { li += step; }
  __device__ int mt() const { int m = li / nN; return swz ? (m * 8 + x) : m; }
  __device__ int ntile() const { return li % nN; }
};

__device__ __forceinline__ void transpose_convert(const float* __restrict__ src, const float* __restrict__ g, bf16_t* __restrict__ dst,
                                  int Lc, int K, int N, size_t gtid, size_t gsz) {
  const int K8 = K >> 3;
  const size_t total = (size_t)Lc * K8 * N;
  for (size_t u = gtid; u < total; u += gsz) {
    int n = (int)(u % N);
    size_t r = u / N;
    int kc = (int)(r % K8);
    int l = (int)(r / K8);
    float v[8];
#pragma unroll
    for (int i = 0; i < 8; ++i) {
      int k = kc * 8 + i;
      float w = src[((size_t)l * K + k) * N + n];
      if (g) w *= g[l * K + k];
      v[i] = w;
    }
    uint4 o;
    o.x = pack2(v[0], v[1]); o.y = pack2(v[2], v[3]); o.z = pack2(v[4], v[5]); o.w = pack2(v[6], v[7]);
    *(uint4*)(dst + ((size_t)l * N + n) * K + kc * 8) = o;
  }
}
__device__ __forceinline__ void convert_flat(const float* __restrict__ src, bf16_t* __restrict__ dst, size_t n8, size_t gtid, size_t gsz) {
  for (size_t u = gtid; u < n8; u += gsz) {
    float4 a = ((const float4*)src)[2 * u], b = ((const float4*)src)[2 * u + 1];
    uint4 o;
    o.x = pack2(a.x, a.y); o.y = pack2(a.z, a.w); o.z = pack2(b.x, b.y); o.w = pack2(b.z, b.w);
    ((uint4*)dst)[u] = o;
  }
}
__device__ __forceinline__ void phase_convert(const int TIDX, const int BIDX, const Params& P) {
  const size_t gtid = (size_t)BIDX * blockDim.x + TIDX;
  const size_t gsz = (size_t)gridDim.x * blockDim.x;
  char* ws = P.ws;
  transpose_convert(P.in[3], P.in[2], (bf16_t*)(ws + OFF_WINT), 2, 1024, 2304, gtid, gsz);
  transpose_convert(P.in[13], nullptr, (bf16_t*)(ws + OFF_WOUTT), 2, 1024, 1024, gtid, gsz);
  transpose_convert(P.in[15], nullptr, (bf16_t*)(ws + OFF_WQT), 2, 1024, 2048, gtid, gsz);
  transpose_convert(P.in[21], P.in[19], (bf16_t*)(ws + OFF_WPGT), 2, 1024, 1024, gtid, gsz);
  transpose_convert(P.in[20], nullptr, (bf16_t*)(ws + OFF_WPET), 2, 256, 1024, gtid, gsz);
  convert_flat(P.in[16], (bf16_t*)(ws + OFF_KEYS), (size_t)2 * 8 * 2 * 128 * 128 / 8, gtid, gsz);
  convert_flat(P.in[17], (bf16_t*)(ws + OFF_EU), (size_t)2 * NEXP * 1024 / 8, gtid, gsz);
  convert_flat(P.in[18], (bf16_t*)(ws + OFF_EV), (size_t)2 * NEXP * 1024 / 8, gtid, gsz);
  convert_flat(P.in[1], (bf16_t*)(ws + OFF_PBF), (size_t)2 * T * 256 / 8, gtid, gsz);
}

template <int MODE>
__device__ __forceinline__ void phase_norm(const int TIDX, const int BIDX, const float* __restrict__ h, const float* __restrict__ g, bf16_t* __restrict__ abuf, float* __restrict__ outp) {
  const int lane = TIDX & 63, wid = TIDX >> 6;
  const int gw = BIDX * 4 + wid, nW = gridDim.x * 4;
  float4 gv[4];
  if (MODE != 0) {
#pragma unroll
    for (int i = 0; i < 4; ++i) gv[i] = ((const float4*)g)[lane + 64 * i];
  }
  for (int t = gw; t < T; t += nW) {
    const float4* hr = (const float4*)(h + (size_t)t * D);
    float4 v[4];
#pragma unroll
    for (int i = 0; i < 4; ++i) v[i] = hr[lane + 64 * i];
    float ss = 0.f;
#pragma unroll
    for (int i = 0; i < 4; ++i) ss += v[i].x * v[i].x + v[i].y * v[i].y + v[i].z * v[i].z + v[i].w * v[i].w;
    ss = wave_sum(ss);
    float rs = rsqrtf(ss * (1.0f / D) + EPS);
#pragma unroll
    for (int i = 0; i < 4; ++i) {
      float4 o = v[i];
      o.x *= rs; o.y *= rs; o.z *= rs; o.w *= rs;
      if (MODE != 0) { o.x *= gv[i].x; o.y *= gv[i].y; o.z *= gv[i].z; o.w *= gv[i].w; }
      if (MODE == 2) {
        ((float4*)(outp + (size_t)t * D))[lane + 64 * i] = o;
      } else {
        uint2 pk; pk.x = pack2(o.x, o.y); pk.y = pack2(o.z, o.w);
        ((uint2*)(abuf + (size_t)t * D))[lane + 64 * i] = pk;
      }
    }
  }
}

__device__ __forceinline__ void phase_gemm_bf16out(const int TIDX, const int BIDX, const bf16_t* __restrict__ A, const bf16_t* __restrict__ Bt, bf16_t* __restrict__ dst,
                                   int N, int K, char* smem) {
  const int lane = TIDX & 63, wid = TIDX >> 6;
  const int wr = wid >> 1, wc = wid & 1, fr = lane & 15, fq = lane >> 4;
  for (TileIter it(N / 128, BIDX); it.valid(); it.next()) {
    const int m0 = it.mt() * 128, n0 = it.ntile() * 128;
    f32x4 acc[4][4];
    gemm_kloop(TIDX, BIDX, A + (size_t)m0 * K, K, Bt + (size_t)n0 * K, K, K, smem, acc);
#pragma unroll
    for (int mi = 0; mi < 4; ++mi)
#pragma unroll
      for (int ni = 0; ni < 4; ++ni) {
        int row = m0 + wr * 64 + mi * 16 + fr, col = n0 + wc * 64 + ni * 16 + fq * 4;
        uint2 pk; pk.x = pack2(acc[mi][ni][0], acc[mi][ni][1]); pk.y = pack2(acc[mi][ni][2], acc[mi][ni][3]);
        *(uint2*)(dst + (size_t)row * N + col) = pk;
      }
  }
}
__device__ __forceinline__ void phase_gemm_resid(const int TIDX, const int BIDX, const bf16_t* __restrict__ A, const bf16_t* __restrict__ Bt, const float* hin, float* hout,
                                 int K, char* smem) {
  const int lane = TIDX & 63, wid = TIDX >> 6;
  const int wr = wid >> 1, wc = wid & 1, fr = lane & 15, fq = lane >> 4;
  for (TileIter it(8, BIDX); it.valid(); it.next()) {
    const int m0 = it.mt() * 128, n0 = it.ntile() * 128;
    f32x4 acc[4][4];
    gemm_kloop(TIDX, BIDX, A + (size_t)m0 * K, K, Bt + (size_t)n0 * K, K, K, smem, acc);
#pragma unroll
    for (int mi = 0; mi < 4; ++mi)
#pragma unroll
      for (int ni = 0; ni < 4; ++ni) {
        int row = m0 + wr * 64 + mi * 16 + fr, col = n0 + wc * 64 + ni * 16 + fq * 4;
        float4 hv = *(const float4*)(hin + (size_t)row * D + col);
        hv.x += acc[mi][ni][0]; hv.y += acc[mi][ni][1]; hv.z += acc[mi][ni][2]; hv.w += acc[mi][ni][3];
        *(float4*)(hout + (size_t)row * D + col) = hv;
      }
  }
}
__device__ __forceinline__ void phase_gemm_ple(const int TIDX, const int BIDX, const bf16_t* __restrict__ A, const bf16_t* __restrict__ WpgT, const bf16_t* __restrict__ Pb,
                               const bf16_t* __restrict__ WpeT, float* h, bf16_t* sg, char* smem) {
  const int lane = TIDX & 63, wid = TIDX >> 6;
  const int wr = wid >> 1, wc = wid & 1, fr = lane & 15, fq = lane >> 4;
  for (TileIter it(8, BIDX); it.valid(); it.next()) {
    const int m0 = it.mt() * 128, n0 = it.ntile() * 128;
    f32x4 acc[4][4];
    gemm_kloop(TIDX, BIDX, A + (size_t)m0 * 1024, 1024, WpgT + (size_t)n0 * 1024, 1024, 1024, smem, acc);
#pragma unroll
    for (int mi = 0; mi < 4; ++mi)
#pragma unroll
      for (int ni = 0; ni < 4; ++ni) {
        int row = m0 + wr * 64 + mi * 16 + fr, col = n0 + wc * 64 + ni * 16 + fq * 4;
        uint2 pk;
        pk.x = pack2(sigmoidf_(acc[mi][ni][0]), sigmoidf_(acc[mi][ni][1]));
        pk.y = pack2(sigmoidf_(acc[mi][ni][2]), sigmoidf_(acc[mi][ni][3]));
        *(uint2*)(sg + (size_t)row * D + col) = pk;
      }
    gemm_kloop(TIDX, BIDX, Pb + (size_t)m0 * 256, 256, WpeT + (size_t)n0 * 256, 256, 256, smem, acc);
#pragma unroll
    for (int mi = 0; mi < 4; ++mi)
#pragma unroll
      for (int ni = 0; ni < 4; ++ni) {
        int row = m0 + wr * 64 + mi * 16 + fr, col = n0 + wc * 64 + ni * 16 + fq * 4;
        uint2 pk = *(const uint2*)(sg + (size_t)row * D + col);
        float4 hv = *(const float4*)(h + (size_t)row * D + col);
        hv.x += acc[mi][ni][0] * bflo(pk.x); hv.y += acc[mi][ni][1] * bfhi(pk.x);
        hv.z += acc[mi][ni][2] * bflo(pk.y); hv.w += acc[mi][ni][3] * bfhi(pk.y);
        *(float4*)(h + (size_t)row * D + col) = hv;
      }
  }
}

__device__ __forceinline__ void phase_mix(const int TIDX, const int BIDX, const Params& P, int L, const bf16_t* __restrict__ z, bf16_t* __restrict__ y, char* smem) {
  const int tid = TIDX, lane = tid & 63, wid = tid >> 6;
  const float* conv_a_w = P.in[4] + (size_t)L * 31 * 384;
  const float* conv_a_b = P.in[5] + L * 384;
  const float* ln_a_g = P.in[6] + L * 384;
  const float* ln_a_b = P.in[7] + L * 384;
  const float* conv_b_w = P.in[8] + L * 3 * 256;
  const float* ln_c_g = P.in[9] + L * 384;
  const float* ln_c_b = P.in[10] + L * 384;
  const float* w_s = P.in[11] + (size_t)L * 6 * 128 * 128;
  const float* b_s = P.in[12] + L * 6 * 128;
  float* fs = (float*)smem;
  for (int item = BIDX; item < 512 * 16; item += gridDim.x) {
    const int tb = item >> 4, part = item & 15;
    const int t0 = tb * 128;
    const int s0 = t0 & (SEQ - 1);
    if (part < 6) {
      const int ch = part * 64 + lane;
      for (int r = wid; r < 158; r += 4) {
        float yv = 0.f;
        if (r >= 30 || s0 > 0) {
          size_t tok = (size_t)(t0 - 30 + r);
          float val = bf2f(z[tok * INC + ch]);
          float gt = bf2f(z[tok * INC + 384 + ch]);
          yv = val * sigmoidf_(gt);
        }
        fs[r * 64 + lane] = yv;
      }
      float wk[31];
#pragma unroll
      for (int k = 0; k < 31; ++k) wk[k] = conv_a_w[k * 384 + ch];
      const float cb = conv_a_b[ch], lg = ln_a_g[ch], lb = ln_a_b[ch];
      __syncthreads();
      for (int i = 0; i < 32; ++i) {
        const int tl = wid * 32 + i;
        float a = cb;
#pragma unroll
        for (int k = 0; k < 31; ++k) a += wk[k] * fs[(tl + k) * 64 + lane];
        float mean = wave_sum(a) * (1.0f / 64);
        float d = a - mean;
        float var = wave_sum(d * d) * (1.0f / 64);
        float yn = d * rsqrtf(var + EPS) * lg + lb;
        float o = yn * sigmoidf_(yn);
        y[(size_t)(t0 + tl) * D + ch] = f2bf(o);
      }
      __syncthreads();
    } else if (part < 10) {
      const int cbn = (part - 6) * 64 + lane;
      const float w0 = conv_b_w[cbn], w1 = conv_b_w[256 + cbn], w2 = conv_b_w[512 + cbn];
      float pm2 = 0.f, pm1 = 0.f;
      const int tl0 = wid * 32;
      if (s0 + tl0 > 0) {
        size_t tk = (size_t)(t0 + tl0 - 2);
        pm2 = bf2f(z[tk * INC + 1024 + cbn]) * bf2f(z[tk * INC + 1280 + cbn]);
        tk += 1;
        pm1 = bf2f(z[tk * INC + 1024 + cbn]) * bf2f(z[tk * INC + 1280 + cbn]);
      }
      for (int i = 0; i < 32; ++i) {
        size_t tk = (size_t)(t0 + tl0 + i);
        float bg = bf2f(z[tk * INC + 768 + cbn]);
        float pc = bf2f(z[tk * INC + 1024 + cbn]) * bf2f(z[tk * INC + 1280 + cbn]);
        float o = bg * (w0 * pm2 + w1 * pm1 + w2 * pc);
        pm2 = pm1; pm1 = pc;
        y[tk * D + 384 + cbn] = f2bf(o);
      }
    } else {
      const int hc = part - 10;
      const int ch = hc * 64 + lane;
      const float lg = ln_c_g[ch], lb = ln_c_b[ch];
      float* vn = fs;
      float* wsT = fs + 128 * 64;
      for (int i = 0; i < 32; ++i) {
        const int tl = wid * 32 + i;
        float v = bf2f(z[(size_t)(t0 + tl) * INC + 1920 + ch]);
        float mean = wave_sum(v) * (1.0f / 64);
        float d = v - mean;
        float var = wave_sum(d * d) * (1.0f / 64);
        vn[tl * 64 + lane] = d * rsqrtf(var + EPS) * lg + lb;
      }
      const float* wsh = w_s + (size_t)hc * 128 * 128;
      for (int q = 0; q < 4; ++q) {
        const int J = (q < 2) ? 64 : 128;
        __syncthreads();
        for (int e = tid; e < 32 * J; e += 256) {
          int j = e % J, il = e / J;
          wsT[j * 36 + il] = wsh[(size_t)(q * 32 + il) * 128 + j];
        }
        __syncthreads();
        float a[8];
#pragma unroll
        for (int ii = 0; ii < 8; ++ii) a[ii] = 0.f;
        for (int j = 0; j < J; ++j) {
          float vj = vn[j * 64 + lane];
          float4 w0 = *(const float4*)(wsT + j * 36 + wid * 8);
          float4 w1 = *(const float4*)(wsT + j * 36 + wid * 8 + 4);
          a[0] += w0.x * vj; a[1] += w0.y * vj; a[2] += w0.z * vj; a[3] += w0.w * vj;
          a[4] += w1.x * vj; a[5] += w1.y * vj; a[6] += w1.z * vj; a[7] += w1.w * vj;
        }
#pragma unroll
        for (int ii = 0; ii < 8; ++ii) {
          int i = q * 32 + wid * 8 + ii;
          float mixed = a[ii] + b_s[hc * 128 + i];
          float u = bf2f(z[(size_t)(t0 + i) * INC + 1536 + ch]);
          y[(size_t)(t0 + i) * D + 640 + ch] = f2bf(u * mixed);
        }
      }
      __syncthreads();
    }
  }
}

__device__ __forceinline__ void ins16(float (&lv)[16], float v) {
#pragma unroll
  for (int i = 0; i < 16; ++i) {
    float t = fmaxf(lv[i], v);
    v = fminf(lv[i], v);
    lv[i] = t;
  }
}

__device__ __forceinline__ void phase_scores(const int TIDX, const int BIDX, const bf16_t* __restrict__ q, const bf16_t* __restrict__ keys  ,
                             int* __restrict__ idxo, float* __restrict__ gateo, char* smem) {
  const int tid = TIDX, lane = tid & 63, wid = tid >> 6;
  const int wr = wid >> 1, wc = wid & 1, fr = lane & 15, fq = lane >> 4;
  float* sT = (float*)smem;
  unsigned* slot = (unsigned*)smem;
  const int m = tid & 127, part = tid >> 7;
  for (int item = BIDX; item < 512 * 8; item += gridDim.x) {
    const int tt = item >> 3, hd = item & 7;
    float v1[16], v2[16];
#pragma unroll
    for (int half = 0; half < 2; ++half) {
      f32x4 acc[4][4];
      gemm_kloop(TIDX, BIDX, q + (size_t)tt * 128 * 2048 + hd * 256 + half * 128, 2048,
                 keys + (size_t)(hd * 2 + half) * 128 * 128, 128, 128, smem, acc);
#pragma unroll
      for (int mi = 0; mi < 4; ++mi)
#pragma unroll
        for (int ni = 0; ni < 4; ++ni)
#pragma unroll
          for (int j = 0; j < 4; ++j)
            sT[(wc * 64 + ni * 16 + fq * 4 + j) * 128 + wr * 64 + mi * 16 + fr] = acc[mi][ni][j];
      __syncthreads();
      float lv[16];
#pragma unroll
      for (int i = 0; i < 16; ++i) lv[i] = -3.0e38f;
#pragma unroll 4
      for (int k = 0; k < 64; ++k) {
        int key = part * 64 + k;
        unsigned u = (__float_as_uint(sT[key * 128 + m]) & 0xffffff80u) | (unsigned)key;
        ins16(lv, __uint_as_float(u));
      }
      __syncthreads();
      if (part == 1) {
#pragma unroll
        for (int i = 0; i < 16; ++i) sT[i * 128 + m] = lv[i];
      }
      __syncthreads();
      if (part == 0) {
#pragma unroll
        for (int i = 0; i < 16; ++i) ins16(lv, sT[i * 128 + m]);
      }
      __syncthreads();
      if (half == 0) {
#pragma unroll
        for (int i = 0; i < 16; ++i) v1[i] = lv[i];
      } else {
#pragma unroll
        for (int i = 0; i < 16; ++i) v2[i] = lv[i];
      }
    }
    if (part == 0) {
#pragma unroll
      for (int i = 0; i < 16; ++i) {
        slot[m * 33 + i] = __float_as_uint(v1[i]);
        slot[m * 33 + 16 + i] = __float_as_uint(v2[i]);
      }
      float fv[16];
#pragma unroll
      for (int i = 0; i < 16; ++i) fv[i] = -3.0e38f;
#pragma unroll
      for (int a = 0; a < 16; ++a)
#pragma unroll
        for (int b = 0; b < 16; ++b)
          if ((a + 1) * (b + 1) <= 16) {
            float sum = __uint_as_float(__float_as_uint(v1[a]) & 0xffffff80u) + __uint_as_float(__float_as_uint(v2[b]) & 0xffffff80u);
            unsigned u = (__float_as_uint(sum) & 0xffffff00u) | (unsigned)(a * 16 + b);
            ins16(fv, __uint_as_float(u));
          }
      float e[16];
      int ex[16];
      float mx = __uint_as_float(__float_as_uint(fv[0]) & 0xffffff00u), sum = 0.f;
#pragma unroll
      for (int i = 0; i < 16; ++i) {
        unsigned u = __float_as_uint(fv[i]);
        int code = (int)(u & 0xffu);
        float val = __uint_as_float(u & 0xffffff00u);
        int k1 = (int)(slot[m * 33 + (code >> 4)] & 127u);
        int k2 = (int)(slot[m * 33 + 16 + (code & 15)] & 127u);
        ex[i] = k1 * 128 + k2;
        e[i] = __expf(val - mx);
        sum += e[i];
      }
      float inv = 1.0f / sum;
      size_t o = (size_t)(tt * 128 + m) * 128 + hd * 16;
#pragma unroll
      for (int i = 0; i < 16; i += 4) {
        *(int4*)(idxo + o + i) = int4{ex[i], ex[i + 1], ex[i + 2], ex[i + 3]};
        *(float4*)(gateo + o + i) = float4{e[i] * inv, e[i + 1] * inv, e[i + 2] * inv, e[i + 3] * inv};
      }
    }
    __syncthreads();
  }
}

__device__ __forceinline__ void phase_peer(const int TIDX, const int BIDX, const bf16_t* __restrict__ Eu, const bf16_t* __restrict__ Ev, const int* __restrict__ idx,
                           const float* __restrict__ gate, float* h, bf16_t* abuf) {
  const int lane = TIDX & 63, wid = TIDX >> 6;
  const int gw = BIDX * 4 + wid, nW = gridDim.x * 4;
  for (int t = gw; t < T; t += nW) {
    float x[16];
    {
      const uint4* nr = (const uint4*)(abuf + (size_t)t * D);
      uint4 a0 = nr[lane], a1 = nr[64 + lane];
      x[0] = bflo(a0.x); x[1] = bfhi(a0.x); x[2] = bflo(a0.y); x[3] = bfhi(a0.y);
      x[4] = bflo(a0.z); x[5] = bfhi(a0.z); x[6] = bflo(a0.w); x[7] = bfhi(a0.w);
      x[8] = bflo(a1.x); x[9] = bfhi(a1.x); x[10] = bflo(a1.y); x[11] = bfhi(a1.y);
      x[12] = bflo(a1.z); x[13] = bfhi(a1.z); x[14] = bflo(a1.w); x[15] = bfhi(a1.w);
    }
    int id0 = idx[(size_t)t * 128 + lane], id1 = idx[(size_t)t * 128 + 64 + lane];
    float g0 = gate[(size_t)t * 128 + lane], g1 = gate[(size_t)t * 128 + 64 + lane];
    float act0 = 0.f, act1 = 0.f;
#pragma unroll
    for (int b = 0; b < 2; ++b) {
      float dots = 0.f;
      const int idv = b ? id1 : id0;
#pragma unroll 8
      for (int k = 0; k < 64; ++k) {
        int e = __builtin_amdgcn_readlane(idv, k);
        const uint4* row = (const uint4*)(Eu + (size_t)e * D);
        uint4 a0 = row[lane], a1 = row[64 + lane];
        float p = x[0] * bflo(a0.x) + x[1] * bfhi(a0.x) + x[2] * bflo(a0.y) + x[3] * bfhi(a0.y) +
                  x[4] * bflo(a0.z) + x[5] * bfhi(a0.z) + x[6] * bflo(a0.w) + x[7] * bfhi(a0.w) +
                  x[8] * bflo(a1.x) + x[9] * bfhi(a1.x) + x[10] * bflo(a1.y) + x[11] * bfhi(a1.y) +
                  x[12] * bflo(a1.z) + x[13] * bfhi(a1.z) + x[14] * bflo(a1.w) + x[15] * bfhi(a1.w);
        p = wave_sum(p);
        dots = (lane == k) ? p : dots;
      }
      float a = gelu_tanh(dots) * (b ? g1 : g0);
      if (b) act1 = a; else act0 = a;
    }
    float o[16];
#pragma unroll
    for (int i = 0; i < 16; ++i) o[i] = 0.f;
#pragma unroll
    for (int b = 0; b < 2; ++b) {
      const int idv = b ? id1 : id0;
      const float av = b ? act1 : act0;
#pragma unroll 8
      for (int k = 0; k < 64; ++k) {
        int e = __builtin_amdgcn_readlane(idv, k);
        float a = __int_as_float(__builtin_amdgcn_readlane(__float_as_int(av), k));
        const uint4* row = (const uint4*)(Ev + (size_t)e * D);
        uint4 a0 = row[lane], a1 = row[64 + lane];
        o[0] += a * bflo(a0.x); o[1] += a * bfhi(a0.x); o[2] += a * bflo(a0.y); o[3] += a * bfhi(a0.y);
        o[4] += a * bflo(a0.z); o[5] += a * bfhi(a0.z); o[6] += a * bflo(a0.w); o[7] += a * bfhi(a0.w);
        o[8] += a * bflo(a1.x); o[9] += a * bfhi(a1.x); o[10] += a * bflo(a1.y); o[11] += a * bfhi(a1.y);
        o[12] += a * bflo(a1.z); o[13] += a * bfhi(a1.z); o[14] += a * bflo(a1.w); o[15] += a * bfhi(a1.w);
      }
    }
    float4* hr = (float4*)(h + (size_t)t * D);
    float4 h0 = hr[lane * 2], h1 = hr[lane * 2 + 1], h2 = hr[128 + lane * 2], h3 = hr[128 + lane * 2 + 1];
    h0.x += o[0]; h0.y += o[1]; h0.z += o[2]; h0.w += o[3];
    h1.x += o[4]; h1.y += o[5]; h1.z += o[6]; h1.w += o[7];
    h2.x += o[8]; h2.y += o[9]; h2.z += o[10]; h2.w += o[11];
    h3.x += o[12]; h3.y += o[13]; h3.z += o[14]; h3.w += o[15];
    float ss = h0.x * h0.x + h0.y * h0.y + h0.z * h0.z + h0.w * h0.w + h1.x * h1.x + h1.y * h1.y + h1.z * h1.z + h1.w * h1.w +
               h2.x * h2.x + h2.y * h2.y + h2.z * h2.z + h2.w * h2.w + h3.x * h3.x + h3.y * h3.y + h3.z * h3.z + h3.w * h3.w;
    ss = wave_sum(ss);
    float rs = rsqrtf(ss * (1.0f / D) + EPS);
    hr[lane * 2] = h0; hr[lane * 2 + 1] = h1; hr[128 + lane * 2] = h2; hr[128 + lane * 2 + 1] = h3;
    uint4 p0, p1;
    p0.x = pack2(h0.x * rs, h0.y * rs); p0.y = pack2(h0.z * rs, h0.w * rs);
    p0.z = pack2(h1.x * rs, h1.y * rs); p0.w = pack2(h1.z * rs, h1.w * rs);
    p1.x = pack2(h2.x * rs, h2.y * rs); p1.y = pack2(h2.z * rs, h2.w * rs);
    p1.z = pack2(h3.x * rs, h3.y * rs); p1.w = pack2(h3.z * rs, h3.w * rs);
    uint4* ar = (uint4*)(abuf + (size_t)t * D);
    ar[lane] = p0; ar[64 + lane] = p1;
  }
}

__device__ __forceinline__ void run_phase(const int TIDX, const int BIDX, const Params& P, int ph, char* smem) {
  char* ws = P.ws;
  bf16_t* abuf = (bf16_t*)(ws + OFF_ABUF);
  bf16_t* zb = (bf16_t*)(ws + OFF_Z);
  float* h = P.out;
  if (ph == 0) { phase_convert(TIDX, BIDX, P); return; }
  if (ph == NPHASE - 1) { phase_norm<2>(TIDX, BIDX, h, P.in[22], nullptr, h); return; }
  const int L = (ph - 1) / 9, s = (ph - 1) % 9;
  const float* hin = (L == 0) ? P.in[0] : h;
  switch (s) {
    case 0: phase_norm<0>(TIDX, BIDX, hin, nullptr, abuf, nullptr); break;
    case 1: phase_gemm_bf16out(TIDX, BIDX, abuf, (const bf16_t*)(ws + OFF_WINT) + (size_t)L * 2304 * 1024, zb, 2304, 1024, smem); break;
    case 2: phase_mix(TIDX, BIDX, P, L, zb, abuf, smem); break;
    case 3: phase_gemm_resid(TIDX, BIDX, abuf, (const bf16_t*)(ws + OFF_WOUTT) + (size_t)L * 1024 * 1024, hin, h, 1024, smem); break;
    case 4: phase_norm<1>(TIDX, BIDX, h, P.in[14] + L * 1024, abuf, nullptr); break;
    case 5: phase_gemm_bf16out(TIDX, BIDX, abuf, (const bf16_t*)(ws + OFF_WQT) + (size_t)L * 2048 * 1024, zb, 2048, 1024, smem); break;
    case 6: phase_scores(TIDX, BIDX, zb, (const bf16_t*)(ws + OFF_KEYS) + (size_t)L * 8 * 2 * 128 * 128, (int*)(ws + OFF_IDX), (float*)(ws + OFF_GATE), smem); break;
    case 7: phase_peer(TIDX, BIDX, (const bf16_t*)(ws + OFF_EU) + (size_t)L * NEXP * 1024, (const bf16_t*)(ws + OFF_EV) + (size_t)L * NEXP * 1024,
                       (const int*)(ws + OFF_IDX), (const float*)(ws + OFF_GATE), h, abuf); break;
    case 8: phase_gemm_ple(TIDX, BIDX, abuf, (const bf16_t*)(ws + OFF_WPGT) + (size_t)L * 1024 * 1024, (const bf16_t*)(ws + OFF_PBF) + (size_t)L * T * 256,
                           (const bf16_t*)(ws + OFF_WPET) + (size_t)L * 1024 * 256, h, zb, smem); break;
  }
}

__global__ void __launch_bounds__(256, 2) peer_trunk_mk(Params P) {
  extern __shared__ __attribute__((aligned(16))) char smem[];
  cg::grid_group grid = cg::this_grid();
  for (int ph = P.ph_lo; ph < P.ph_hi; ++ph) {
    int tl = (int)__builtin_amdgcn_workitem_id_x(), bl = (int)__builtin_amdgcn_workgroup_id_x();
    asm volatile("" : "+v"(tl));
    asm volatile("" : "+s"(bl));
    run_phase(tl, bl, P, ph, smem);
    if (ph + 1 < P.ph_hi) grid.sync();
  }
}

extern "C" void kernel_launch(void* const* d_in, const int* in_sizes, int n_in, void* d_out, int out_size,
                              void* d_ws, size_t ws_size, hipStream_t stream) {
  static int grid_blocks = 0;
  if (grid_blocks == 0) {
    if (n_in != 23 || ws_size < WS_END) { fprintf(stderr, "kernel_launch: unexpected n_in %d or ws_size %zu (< %zu)\n", n_in, ws_size, (size_t)WS_END); grid_blocks = -1; return; }
    int dev = 0, cus = 0, per_cu = 0;
    hipGetDevice(&dev);
    hipDeviceGetAttribute(&cus, hipDeviceAttributeMultiprocessorCount, dev);
    hipFuncSetAttribute((const void*)peer_trunk_mk, hipFuncAttributeMaxDynamicSharedMemorySize, SMEM_BYTES);
    hipOccupancyMaxActiveBlocksPerMultiprocessor(&per_cu, (const void*)peer_trunk_mk, 256, SMEM_BYTES);
    if (per_cu < 1) per_cu = 1;
    if (per_cu > 2) per_cu = 2;
    grid_blocks = cus * per_cu;
    fprintf(stderr, "kernel_launch: cus %d per_cu %d grid %d\n", cus, per_cu, grid_blocks);
  }
  if (grid_blocks < 0) return;
  Params P{};
  for (int i = 0; i < 23; ++i) P.in[i] = (const float*)d_in[i];
  P.out = (float*)d_out;
  P.ws = (char*)d_ws;
#if ONE_LAUNCH
  P.ph_lo = 0; P.ph_hi = NPHASE;
  void* args[] = {&P};
  hipError_t e = hipLaunchCooperativeKernel((void*)peer_trunk_mk, dim3(grid_blocks), dim3(256), args, SMEM_BYTES, stream);
  if (e != hipSuccess) fprintf(stderr, "cooperative launch failed: %s (grid %d)\n", hipGetErrorString(e), grid_blocks);
#else
  for (int ph = 0; ph < NPHASE; ++ph) {
    P.ph_lo = ph; P.ph_hi = ph + 1;
    hipLaunchKernelGGL(peer_trunk_mk, dim3(grid_blocks), dim3(256), SMEM_BYTES, stream, P);
  }
#endif
}
```

```cpp
#include <hip/hip_runtime.h>
#include <hip/hip_bf16.h>
#include <hip/hip_cooperative_groups.h>
#include <cstdio>
namespace cg = cooperative_groups;

#ifndef ONE_LAUNCH
#define ONE_LAUNCH 1
#endif

typedef unsigned short bf16_t;
using bf16x8 = __attribute__((ext_vector_type(8))) short;
using f32x4 = __attribute__((ext_vector_type(4))) float;

constexpr int T = 65536;
constexpr int D = 1024;
constexpr int SEQ = 8192;
constexpr int INC = 2304;
constexpr int NEXP = 16384;
constexpr float EPS = 1e-6f;
constexpr int SMEM_BYTES = 65536;
constexpr int NPHASE = 20;

constexpr size_t OFF_WINT = 0;
constexpr size_t OFF_WOUTT = OFF_WINT + (size_t)2 * 2304 * 1024 * 2;
constexpr size_t OFF_WQT = OFF_WOUTT + (size_t)2 * 1024 * 1024 * 2;
constexpr size_t OFF_WPGT = OFF_WQT + (size_t)2 * 2048 * 1024 * 2;
constexpr size_t OFF_WPET = OFF_WPGT + (size_t)2 * 1024 * 1024 * 2;
constexpr size_t OFF_KEYS = OFF_WPET + (size_t)2 * 1024 * 256 * 2;
constexpr size_t OFF_EU = OFF_KEYS + (size_t)2 * 8 * 2 * 128 * 128 * 2;
constexpr size_t OFF_EV = OFF_EU + (size_t)2 * NEXP * 1024;
constexpr size_t OFF_ESC = OFF_EV + (size_t)2 * NEXP * 1024;
constexpr size_t OFF_PBF = OFF_ESC + (size_t)4 * NEXP * 4;
constexpr size_t OFF_ABUF = OFF_PBF + (size_t)2 * T * 256 * 2;
constexpr size_t OFF_Z = OFF_ABUF + (size_t)T * 1024 * 2;
constexpr size_t OFF_IDX = OFF_Z + (size_t)T * 2304 * 2;
constexpr size_t OFF_GATE = OFF_IDX + (size_t)T * 128 * 4;
constexpr size_t WS_END = OFF_GATE + (size_t)T * 128 * 4;

struct Params {
  const float* in[23];
  float* out;
  char* ws;
  int ph_lo, ph_hi;
};

__device__ __forceinline__ unsigned short f2bf(float f) {
  unsigned u = __float_as_uint(f);
  u += 0x7fffu + ((u >> 16) & 1u);
  return (unsigned short)(u >> 16);
}
__device__ __forceinline__ float bf2f(unsigned short b) { return __uint_as_float(((unsigned)b) << 16); }
__device__ __forceinline__ unsigned pack2(float a, float b) { return (unsigned)f2bf(a) | ((unsigned)f2bf(b) << 16); }
__device__ __forceinline__ float bflo(unsigned u) { return __uint_as_float(u << 16); }
__device__ __forceinline__ float bfhi(unsigned u) { return __uint_as_float(u & 0xffff0000u); }
__device__ __forceinline__ float sigmoidf_(float x) { return 1.0f / (1.0f + __expf(-x)); }
__device__ __forceinline__ float gelu_tanh(float x) {
  float u = 0.7978845608028654f * (x + 0.044715f * x * x * x);
  float e = __expf(2.0f * u);
  float th = 1.0f - 2.0f / (e + 1.0f);
  return 0.5f * x * (1.0f + th);
}
template <int CTRL>
__device__ __forceinline__ float dpp_f(float v) {
  return __int_as_float(__builtin_amdgcn_update_dpp(0, __float_as_int(v), CTRL, 0xF, 0xF, true));
}
__device__ __forceinline__ float wave_sum(float v) {
  v += dpp_f<0xB1>(v);
  v += dpp_f<0x4E>(v);
  v += dpp_f<0x141>(v);
  v += dpp_f<0x140>(v);
  float s = __int_as_float(__builtin_amdgcn_readlane(__float_as_int(v), 0)) +
            __int_as_float(__builtin_amdgcn_readlane(__float_as_int(v), 16)) +
            __int_as_float(__builtin_amdgcn_readlane(__float_as_int(v), 32)) +
            __int_as_float(__builtin_amdgcn_readlane(__float_as_int(v), 48));
  return s;
}

__device__ __forceinline__ float wave_max(float v) {
  v = fmaxf(v, dpp_f<0xB1>(v));
  v = fmaxf(v, dpp_f<0x4E>(v));
  v = fmaxf(v, dpp_f<0x141>(v));
  v = fmaxf(v, dpp_f<0x140>(v));
  float s = fmaxf(fmaxf(__int_as_float(__builtin_amdgcn_readlane(__float_as_int(v), 0)),
                        __int_as_float(__builtin_amdgcn_readlane(__float_as_int(v), 16))),
                  fmaxf(__int_as_float(__builtin_amdgcn_readlane(__float_as_int(v), 32)),
                        __int_as_float(__builtin_amdgcn_readlane(__float_as_int(v), 48))));
  return s;
}
typedef float f32x2 __attribute__((ext_vector_type(2)));

__device__ __forceinline__ int lds_off(int r, int c) { return r * 128 + ((c ^ ((r >> 1) & 7)) << 4); }

__device__ __forceinline__ void gemm_kloop(const int TIDX, const int BIDX, const bf16_t* __restrict__ A, int lda,
                                           const bf16_t* __restrict__ Bt, int ldb, int K,
                                           char* smem, f32x4 (&acc)[4][4]) {
  const int tid = TIDX, lane = tid & 63, wid = tid >> 6;
  const int wr = wid >> 1, wc = wid & 1;
  const int fr = lane & 15, fq = lane >> 4;
  const int sr = tid >> 3, sc = tid & 7;
  const bf16_t* ga = A + (size_t)sr * lda + sc * 8;
  const bf16_t* gb = Bt + (size_t)sr * ldb + sc * 8;
  uint4 ra[4], rb[4];
#pragma unroll
  for (int i = 0; i < 4; ++i) {
    ra[i] = *(const uint4*)(ga + (size_t)(32 * i) * lda);
    rb[i] = *(const uint4*)(gb + (size_t)(32 * i) * ldb);
  }
#pragma unroll
  for (int mi = 0; mi < 4; ++mi)
#pragma unroll
    for (int ni = 0; ni < 4; ++ni) acc[mi][ni] = f32x4{0.f, 0.f, 0.f, 0.f};
#pragma unroll
  for (int i = 0; i < 4; ++i) {
    *(uint4*)(smem + lds_off(sr + 32 * i, sc)) = ra[i];
    *(uint4*)(smem + 16384 + lds_off(sr + 32 * i, sc)) = rb[i];
  }
  __syncthreads();
  const int nt = K >> 6;
  for (int kt = 0; kt < nt; ++kt) {
    char* bufp = smem + (kt & 1) * 32768;
    const bool more = (kt + 1 < nt);
    if (more) {
#pragma unroll
      for (int i = 0; i < 4; ++i) {
        ra[i] = *(const uint4*)(ga + (size_t)(32 * i) * lda + (kt + 1) * 64);
        rb[i] = *(const uint4*)(gb + (size_t)(32 * i) * ldb + (kt + 1) * 64);
      }
    }
#pragma unroll
    for (int kk = 0; kk < 2; ++kk) {
      bf16x8 af[4], bfr[4];
#pragma unroll
      for (int mi = 0; mi < 4; ++mi) af[mi] = *(const bf16x8*)(bufp + lds_off(wr * 64 + mi * 16 + fr, kk * 4 + fq));
#pragma unroll
      for (int ni = 0; ni < 4; ++ni) bfr[ni] = *(const bf16x8*)(bufp + 16384 + lds_off(wc * 64 + ni * 16 + fr, kk * 4 + fq));
#pragma unroll
      for (int mi = 0; mi < 4; ++mi)
#pragma unroll
        for (int ni = 0; ni < 4; ++ni)
          acc[mi][ni] = __builtin_amdgcn_mfma_f32_16x16x32_bf16(bfr[ni], af[mi], acc[mi][ni], 0, 0, 0);
    }
    if (more) {
      char* nb = smem + ((kt + 1) & 1) * 32768;
#pragma unroll
      for (int i = 0; i < 4; ++i) {
        *(uint4*)(nb + lds_off(sr + 32 * i, sc)) = ra[i];
        *(uint4*)(nb + 16384 + lds_off(sr + 32 * i, sc)) = rb[i];
      }
    }
    __syncthreads();
  }
}

struct TileIter {
  int nN, total, li, step, x;
  bool swz;
  __device__ TileIter(int nN_, const int BIDX) {
    nN = nN_;
    int G = gridDim.x, b = BIDX;
    swz = ((G & 7) == 0);
    if (swz) { x = b & 7; li = b >> 3; step = G >> 3; total = 64 * nN; }
    else { x = 0; li = b; step = G; total = 512 * nN; }
  }
  __device__ bool valid() const { return li < total; }
  __device__ void next() { li += step; }
  __device__ int mt() const { int m = li / nN; return swz ? (m * 8 + x) : m; }
  __device__ int ntile() const { return li % nN; }
};

__device__ __forceinline__ void transpose_convert(const float* __restrict__ src, const float* __restrict__ g, bf16_t* __restrict__ dst,
                                  int Lc, int K, int N, size_t gtid, size_t gsz) {
  const int K8 = K >> 3;
  const size_t total = (size_t)Lc * K8 * N;
  for (size_t u = gtid; u < total; u += gsz) {
    int n = (int)(u % N);
    size_t r = u / N;
    int kc = (int)(r % K8);
    int l = (int)(r / K8);
    float v[8];
#pragma unroll
    for (int i = 0; i < 8; ++i) {
      int k = kc * 8 + i;
      float w = src[((size_t)l * K + k) * N + n];
      if (g) w *= g[l * K + k];
      v[i] = w;
    }
    uint4 o;
    o.x = pack2(v[0], v[1]); o.y = pack2(v[2], v[3]); o.z = pack2(v[4], v[5]); o.w = pack2(v[6], v[7]);
    *(uint4*)(dst + ((size_t)l * N + n) * K + kc * 8) = o;
  }
}
__device__ __forceinline__ void convert_flat(const float* __restrict__ src, bf16_t* __restrict__ dst, size_t n8, size_t gtid, size_t gsz) {
  for (size_t u = gtid; u < n8; u += gsz) {
    float4 a = ((const float4*)src)[2 * u], b = ((const float4*)src)[2 * u + 1];
    uint4 o;
    o.x = pack2(a.x, a.y); o.y = pack2(a.z, a.w); o.z = pack2(b.x, b.y); o.w = pack2(b.z, b.w);
    ((uint4*)dst)[u] = o;
  }
}
__device__ __forceinline__ void phase_convert(const int TIDX, const int BIDX, const Params& P) {
  const size_t gtid = (size_t)BIDX * blockDim.x + TIDX;
  const size_t gsz = (size_t)gridDim.x * blockDim.x;
  char* ws = P.ws;
  transpose_convert(P.in[3], P.in[2], (bf16_t*)(ws + OFF_WINT), 2, 1024, 2304, gtid, gsz);
  transpose_convert(P.in[13], nullptr, (bf16_t*)(ws + OFF_WOUTT), 2, 1024, 1024, gtid, gsz);
  transpose_convert(P.in[15], nullptr, (bf16_t*)(ws + OFF_WQT), 2, 1024, 2048, gtid, gsz);
  transpose_convert(P.in[21], P.in[19], (bf16_t*)(ws + OFF_WPGT), 2, 1024, 1024, gtid, gsz);
  transpose_convert(P.in[20], nullptr, (bf16_t*)(ws + OFF_WPET), 2, 256, 1024, gtid, gsz);
  convert_flat(P.in[16], (bf16_t*)(ws + OFF_KEYS), (size_t)2 * 8 * 2 * 128 * 128 / 8, gtid, gsz);
  {
    const int lane = TIDX & 63;
    const int gw = BIDX * 4 + (TIDX >> 6), nW = gridDim.x * 4;
    float* esc = (float*)(ws + OFF_ESC);
    for (int row = gw; row < 4 * NEXP; row += nW) {
      const float* src = (row < 2 * NEXP) ? (P.in[17] + (size_t)row * 1024) : (P.in[18] + (size_t)(row - 2 * NEXP) * 1024);
      float4 v[4];
#pragma unroll
      for (int i = 0; i < 4; ++i) v[i] = ((const float4*)src)[lane * 4 + i];
      float m = 0.f;
#pragma unroll
      for (int i = 0; i < 4; ++i) m = fmaxf(m, fmaxf(fmaxf(fabsf(v[i].x), fabsf(v[i].y)), fmaxf(fabsf(v[i].z), fabsf(v[i].w))));
      m = wave_max(m);
      const float sc = (m > 0.f) ? 224.0f / m : 0.f;
      uint4 o;
      unsigned w[4];
#pragma unroll
      for (int i = 0; i < 4; ++i) {
        int t = __builtin_amdgcn_cvt_pk_fp8_f32(v[i].x * sc, v[i].y * sc, 0, false);
        t = __builtin_amdgcn_cvt_pk_fp8_f32(v[i].z * sc, v[i].w * sc, t, true);
        w[i] = (unsigned)t;
      }
      o.x = w[0]; o.y = w[1]; o.z = w[2]; o.w = w[3];
      *(uint4*)(ws + OFF_EU + (size_t)row * 1024 + lane * 16) = o;
      if (lane == 0) esc[row] = m * (1.0f / 224.0f);
    }
  }
  convert_flat(P.in[1], (bf16_t*)(ws + OFF_PBF), (size_t)2 * T * 256 / 8, gtid, gsz);
}

template <int MODE>
__device__ __forceinline__ void phase_norm(const int TIDX, const int BIDX, const float* __restrict__ h, const float* __restrict__ g, bf16_t* __restrict__ abuf, float* __restrict__ outp) {
  const int lane = TIDX & 63, wid = TIDX >> 6;
  const int gw = BIDX * 4 + wid, nW = gridDim.x * 4;
  float4 gv[4];
  if (MODE != 0) {
#pragma unroll
    for (int i = 0; i < 4; ++i) gv[i] = ((const float4*)g)[lane + 64 * i];
  }
  for (int t = gw; t < T; t += nW) {
    const float4* hr = (const float4*)(h + (size_t)t * D);
    float4 v[4];
#pragma unroll
    for (int i = 0; i < 4; ++i) v[i] = hr[lane + 64 * i];
    float ss = 0.f;
#pragma unroll
    for (int i = 0; i < 4; ++i) ss += v[i].x * v[i].x + v[i].y * v[i].y + v[i].z * v[i].z + v[i].w * v[i].w;
    ss = wave_sum(ss);
    float rs = rsqrtf(ss * (1.0f / D) + EPS);
#pragma unroll
    for (int i = 0; i < 4; ++i) {
      float4 o = v[i];
      o.x *= rs; o.y *= rs; o.z *= rs; o.w *= rs;
      if (MODE != 0) { o.x *= gv[i].x; o.y *= gv[i].y; o.z *= gv[i].z; o.w *= gv[i].w; }
      if (MODE == 2) {
        ((float4*)(outp + (size_t)t * D))[lane + 64 * i] = o;
      } else {
        uint2 pk; pk.x = pack2(o.x, o.y); pk.y = pack2(o.z, o.w);
        ((uint2*)(abuf + (size_t)t * D))[lane + 64 * i] = pk;
      }
    }
  }
}

__device__ __forceinline__ void phase_gemm_bf16out(const int TIDX, const int BIDX, const bf16_t* __restrict__ A, const bf16_t* __restrict__ Bt, bf16_t* __restrict__ dst,
                                   int N, int K, char* smem) {
  const int lane = TIDX & 63, wid = TIDX >> 6;
  const int wr = wid >> 1, wc = wid & 1, fr = lane & 15, fq = lane >> 4;
  for (TileIter it(N / 128, BIDX); it.valid(); it.next()) {
    const int m0 = it.mt() * 128, n0 = it.ntile() * 128;
    f32x4 acc[4][4];
    gemm_kloop(TIDX, BIDX, A + (size_t)m0 * K, K, Bt + (size_t)n0 * K, K, K, smem, acc);
#pragma unroll
    for (int mi = 0; mi < 4; ++mi)
#pragma unroll
      for (int ni = 0; ni < 4; ++ni) {
        int row = m0 + wr * 64 + mi * 16 + fr, col = n0 + wc * 64 + ni * 16 + fq * 4;
        uint2 pk; pk.x = pack2(acc[mi][ni][0], acc[mi][ni][1]); pk.y = pack2(acc[mi][ni][2], acc[mi][ni][3]);
        *(uint2*)(dst + (size_t)row * N + col) = pk;
      }
  }
}
__device__ __forceinline__ void phase_gemm_resid(const int TIDX, const int BIDX, const bf16_t* __restrict__ A, const bf16_t* __restrict__ Bt, const float* hin, float* hout,
                                 int K, char* smem) {
  const int lane = TIDX & 63, wid = TIDX >> 6;
  const int wr = wid >> 1, wc = wid & 1, fr = lane & 15, fq = lane >> 4;
  for (TileIter it(8, BIDX); it.valid(); it.next()) {
    const int m0 = it.mt() * 128, n0 = it.ntile() * 128;
    f32x4 acc[4][4];
    gemm_kloop(TIDX, BIDX, A + (size_t)m0 * K, K, Bt + (size_t)n0 * K, K, K, smem, acc);
#pragma unroll
    for (int mi = 0; mi < 4; ++mi)
#pragma unroll
      for (int ni = 0; ni < 4; ++ni) {
        int row = m0 + wr * 64 + mi * 16 + fr, col = n0 + wc * 64 + ni * 16 + fq * 4;
        float4 hv = *(const float4*)(hin + (size_t)row * D + col);
        hv.x += acc[mi][ni][0]; hv.y += acc[mi][ni][1]; hv.z += acc[mi][ni][2]; hv.w += acc[mi][ni][3];
        *(float4*)(hout + (size_t)row * D + col) = hv;
      }
  }
}
__device__ __forceinline__ void phase_gemm_ple(const int TIDX, const int BIDX, const bf16_t* __restrict__ A, const bf16_t* __restrict__ WpgT, const bf16_t* __restrict__ Pb,
                               const bf16_t* __restrict__ WpeT, float* h, bf16_t* sg, char* smem) {
  const int lane = TIDX & 63, wid = TIDX >> 6;
  const int wr = wid >> 1, wc = wid & 1, fr = lane & 15, fq = lane >> 4;
  for (TileIter it(8, BIDX); it.valid(); it.next()) {
    const int m0 = it.mt() * 128, n0 = it.ntile() * 128;
    f32x4 acc[4][4];
    gemm_kloop(TIDX, BIDX, A + (size_t)m0 * 1024, 1024, WpgT + (size_t)n0 * 1024, 1024, 1024, smem, acc);
#pragma unroll
    for (int mi = 0; mi < 4; ++mi)
#pragma unroll
      for (int ni = 0; ni < 4; ++ni) {
        int row = m0 + wr * 64 + mi * 16 + fr, col = n0 + wc * 64 + ni * 16 + fq * 4;
        uint2 pk;
        pk.x = pack2(sigmoidf_(acc[mi][ni][0]), sigmoidf_(acc[mi][ni][1]));
        pk.y = pack2(sigmoidf_(acc[mi][ni][2]), sigmoidf_(acc[mi][ni][3]));
        *(uint2*)(sg + (size_t)row * D + col) = pk;
      }
    gemm_kloop(TIDX, BIDX, Pb + (size_t)m0 * 256, 256, WpeT + (size_t)n0 * 256, 256, 256, smem, acc);
#pragma unroll
    for (int mi = 0; mi < 4; ++mi)
#pragma unroll
      for (int ni = 0; ni < 4; ++ni) {
        int row = m0 + wr * 64 + mi * 16 + fr, col = n0 + wc * 64 + ni * 16 + fq * 4;
        uint2 pk = *(const uint2*)(sg + (size_t)row * D + col);
        float4 hv = *(const float4*)(h + (size_t)row * D + col);
        hv.x += acc[mi][ni][0] * bflo(pk.x); hv.y += acc[mi][ni][1] * bfhi(pk.x);
        hv.z += acc[mi][ni][2] * bflo(pk.y); hv.w += acc[mi][ni][3] * bfhi(pk.y);
        *(float4*)(h + (size_t)row * D + col) = hv;
      }
  }
}

__device__ __forceinline__ void phase_mix(const int TIDX, const int BIDX, const Params& P, int L, const bf16_t* __restrict__ z, bf16_t* __restrict__ y, char* smem) {
  const int tid = TIDX, lane = tid & 63, wid = tid >> 6;
  const float* conv_a_w = P.in[4] + (size_t)L * 31 * 384;
  const float* conv_a_b = P.in[5] + L * 384;
  const float* ln_a_g = P.in[6] + L * 384;
  const float* ln_a_b = P.in[7] + L * 384;
  const float* conv_b_w = P.in[8] + L * 3 * 256;
  const float* ln_c_g = P.in[9] + L * 384;
  const float* ln_c_b = P.in[10] + L * 384;
  const float* w_s = P.in[11] + (size_t)L * 6 * 128 * 128;
  const float* b_s = P.in[12] + L * 6 * 128;
  float* fs = (float*)smem;
  for (int item = BIDX; item < 512 * 16; item += gridDim.x) {
    const int tb = item >> 4, part = item & 15;
    const int t0 = tb * 128;
    const int s0 = t0 & (SEQ - 1);
    if (part < 6) {
      const int ch = part * 64 + lane;
      for (int r = wid; r < 158; r += 4) {
        float yv = 0.f;
        if (r >= 30 || s0 > 0) {
          size_t tok = (size_t)(t0 - 30 + r);
          float val = bf2f(z[tok * INC + ch]);
          float gt = bf2f(z[tok * INC + 384 + ch]);
          yv = val * sigmoidf_(gt);
        }
        fs[r * 64 + lane] = yv;
      }
      float wk[31];
#pragma unroll
      for (int k = 0; k < 31; ++k) wk[k] = conv_a_w[k * 384 + ch];
      const float cb = conv_a_b[ch], lg = ln_a_g[ch], lb = ln_a_b[ch];
      __syncthreads();
      for (int i = 0; i < 32; ++i) {
        const int tl = wid * 32 + i;
        float a = cb;
#pragma unroll
        for (int k = 0; k < 31; ++k) a += wk[k] * fs[(tl + k) * 64 + lane];
        float mean = wave_sum(a) * (1.0f / 64);
        float d = a - mean;
        float var = wave_sum(d * d) * (1.0f / 64);
        float yn = d * rsqrtf(var + EPS) * lg + lb;
        float o = yn * sigmoidf_(yn);
        y[(size_t)(t0 + tl) * D + ch] = f2bf(o);
      }
      __syncthreads();
    } else if (part < 10) {
      const int cbn = (part - 6) * 64 + lane;
      const float w0 = conv_b_w[cbn], w1 = conv_b_w[256 + cbn], w2 = conv_b_w[512 + cbn];
      float pm2 = 0.f, pm1 = 0.f;
      const int tl0 = wid * 32;
      if (s0 + tl0 > 0) {
        size_t tk = (size_t)(t0 + tl0 - 2);
        pm2 = bf2f(z[tk * INC + 1024 + cbn]) * bf2f(z[tk * INC + 1280 + cbn]);
        tk += 1;
        pm1 = bf2f(z[tk * INC + 1024 + cbn]) * bf2f(z[tk * INC + 1280 + cbn]);
      }
      for (int i = 0; i < 32; ++i) {
        size_t tk = (size_t)(t0 + tl0 + i);
        float bg = bf2f(z[tk * INC + 768 + cbn]);
        float pc = bf2f(z[tk * INC + 1024 + cbn]) * bf2f(z[tk * INC + 1280 + cbn]);
        float o = bg * (w0 * pm2 + w1 * pm1 + w2 * pc);
        pm2 = pm1; pm1 = pc;
        y[tk * D + 384 + cbn] = f2bf(o);
      }
    } else {
      const int hc = part - 10;
      const int ch = hc * 64 + lane;
      const float lg = ln_c_g[ch], lb = ln_c_b[ch];
      float* vn = fs;
      float* wsT = fs + 128 * 64;
      for (int i = 0; i < 32; ++i) {
        const int tl = wid * 32 + i;
        float v = bf2f(z[(size_t)(t0 + tl) * INC + 1920 + ch]);
        float mean = wave_sum(v) * (1.0f / 64);
        float d = v - mean;
        float var = wave_sum(d * d) * (1.0f / 64);
        vn[tl * 64 + lane] = d * rsqrtf(var + EPS) * lg + lb;
      }
      const float* wsh = w_s + (size_t)hc * 128 * 128;
      for (int q = 0; q < 4; ++q) {
        const int J = (q < 2) ? 64 : 128;
        __syncthreads();
        for (int e = tid; e < 32 * J; e += 256) {
          int j = e % J, il = e / J;
          wsT[j * 36 + il] = wsh[(size_t)(q * 32 + il) * 128 + j];
        }
        __syncthreads();
        float a[8];
#pragma unroll
        for (int ii = 0; ii < 8; ++ii) a[ii] = 0.f;
        for (int j = 0; j < J; ++j) {
          float vj = vn[j * 64 + lane];
          float4 w0 = *(const float4*)(wsT + j * 36 + wid * 8);
          float4 w1 = *(const float4*)(wsT + j * 36 + wid * 8 + 4);
          a[0] += w0.x * vj; a[1] += w0.y * vj; a[2] += w0.z * vj; a[3] += w0.w * vj;
          a[4] += w1.x * vj; a[5] += w1.y * vj; a[6] += w1.z * vj; a[7] += w1.w * vj;
        }
#pragma unroll
        for (int ii = 0; ii < 8; ++ii) {
          int i = q * 32 + wid * 8 + ii;
          float mixed = a[ii] + b_s[hc * 128 + i];
          float u = bf2f(z[(size_t)(t0 + i) * INC + 1536 + ch]);
          y[(size_t)(t0 + i) * D + 640 + ch] = f2bf(u * mixed);
        }
      }
      __syncthreads();
    }
  }
}

__device__ __forceinline__ void ins16(float (&lv)[16], float v) {
#pragma unroll
  for (int i = 0; i < 16; ++i) {
    float t = fmaxf(lv[i], v);
    v = fminf(lv[i], v);
    lv[i] = t;
  }
}

__device__ __forceinline__ void phase_scores(const int TIDX, const int BIDX, const bf16_t* __restrict__ q, const bf16_t* __restrict__ keys  ,
                             int* __restrict__ idxo, float* __restrict__ gateo, char* smem) {
  const int tid = TIDX, lane = tid & 63, wid = tid >> 6;
  const int wr = wid >> 1, wc = wid & 1, fr = lane & 15, fq = lane >> 4;
  float* sT = (float*)smem;
  unsigned* slot = (unsigned*)smem;
  const int m = tid & 127, part = tid >> 7;
  for (int item = BIDX; item < 512 * 8; item += gridDim.x) {
    const int tt = item >> 3, hd = item & 7;
    float v1[16], v2[16];
#pragma unroll
    for (int half = 0; half < 2; ++half) {
      f32x4 acc[4][4];
      gemm_kloop(TIDX, BIDX, q + (size_t)tt * 128 * 2048 + hd * 256 + half * 128, 2048,
                 keys + (size_t)(hd * 2 + half) * 128 * 128, 128, 128, smem, acc);
#pragma unroll
      for (int mi = 0; mi < 4; ++mi)
#pragma unroll
        for (int ni = 0; ni < 4; ++ni)
#pragma unroll
          for (int j = 0; j < 4; ++j)
            sT[(wc * 64 + ni * 16 + fq * 4 + j) * 128 + wr * 64 + mi * 16 + fr] = acc[mi][ni][j];
      __syncthreads();
      float lv[16];
#pragma unroll
      for (int i = 0; i < 16; ++i) lv[i] = -3.0e38f;
#pragma unroll 4
      for (int k = 0; k < 64; ++k) {
        int key = part * 64 + k;
        unsigned u = (__float_as_uint(sT[key * 128 + m]) & 0xffffff80u) | (unsigned)key;
        ins16(lv, __uint_as_float(u));
      }
      __syncthreads();
      if (part == 1) {
#pragma unroll
        for (int i = 0; i < 16; ++i) sT[i * 128 + m] = lv[i];
      }
      __syncthreads();
      if (part == 0) {
#pragma unroll
        for (int i = 0; i < 16; ++i) ins16(lv, sT[i * 128 + m]);
      }
      __syncthreads();
      if (half == 0) {
#pragma unroll
        for (int i = 0; i < 16; ++i) v1[i] = lv[i];
      } else {
#pragma unroll
        for (int i = 0; i < 16; ++i) v2[i] = lv[i];
      }
    }
    if (part == 0) {
#pragma unroll
      for (int i = 0; i < 16; ++i) {
        slot[m * 33 + i] = __float_as_uint(v1[i]);
        slot[m * 33 + 16 + i] = __float_as_uint(v2[i]);
      }
      float fv[16];
#pragma unroll
      for (int i = 0; i < 16; ++i) fv[i] = -3.0e38f;
#pragma unroll
      for (int a = 0; a < 16; ++a)
#pragma unroll
        for (int b = 0; b < 16; ++b)
          if ((a + 1) * (b + 1) <= 16) {
            float sum = __uint_as_float(__float_as_uint(v1[a]) & 0xffffff80u) + __uint_as_float(__float_as_uint(v2[b]) & 0xffffff80u);
            unsigned u = (__float_as_uint(sum) & 0xffffff00u) | (unsigned)(a * 16 + b);
            ins16(fv, __uint_as_float(u));
          }
      float e[16];
      int ex[16];
      float mx = __uint_as_float(__float_as_uint(fv[0]) & 0xffffff00u), sum = 0.f;
#pragma unroll
      for (int i = 0; i < 16; ++i) {
        unsigned u = __float_as_uint(fv[i]);
        int code = (int)(u & 0xffu);
        float val = __uint_as_float(u & 0xffffff00u);
        int k1 = (int)(slot[m * 33 + (code >> 4)] & 127u);
        int k2 = (int)(slot[m * 33 + 16 + (code & 15)] & 127u);
        ex[i] = k1 * 128 + k2;
        e[i] = __expf(val - mx);
        sum += e[i];
      }
      float inv = 1.0f / sum;
      size_t o = (size_t)(tt * 128 + m) * 128 + hd * 16;
#pragma unroll
      for (int i = 0; i < 16; i += 4) {
        *(int4*)(idxo + o + i) = int4{ex[i], ex[i + 1], ex[i + 2], ex[i + 3]};
        *(float4*)(gateo + o + i) = float4{e[i] * inv, e[i + 1] * inv, e[i + 2] * inv, e[i + 3] * inv};
      }
    }
    __syncthreads();
  }
}

__device__ __forceinline__ void peer_issue(uint4 (&buf)[8], const unsigned char* __restrict__ tab, int idv, int gp, int lane) {
#pragma unroll
  for (int e = 0; e < 8; ++e) {
    const unsigned ex = (unsigned)__builtin_amdgcn_readlane(idv, 8 * e + gp);
    const unsigned char* rowp = tab + ((size_t)ex << 10);
    buf[e] = *(const uint4*)(rowp + (unsigned)(lane << 4));
  }
}
__device__ __forceinline__ float peer_dot(const uint4& r, const f32x2 (&x2)[8]) {
  f32x2 a0 = __builtin_amdgcn_cvt_pk_f32_fp8((int)r.x, false) * x2[0];
  f32x2 a1 = __builtin_amdgcn_cvt_pk_f32_fp8((int)r.x, true) * x2[1];
  a0 += __builtin_amdgcn_cvt_pk_f32_fp8((int)r.y, false) * x2[2];
  a1 += __builtin_amdgcn_cvt_pk_f32_fp8((int)r.y, true) * x2[3];
  a0 += __builtin_amdgcn_cvt_pk_f32_fp8((int)r.z, false) * x2[4];
  a1 += __builtin_amdgcn_cvt_pk_f32_fp8((int)r.z, true) * x2[5];
  a0 += __builtin_amdgcn_cvt_pk_f32_fp8((int)r.w, false) * x2[6];
  a1 += __builtin_amdgcn_cvt_pk_f32_fp8((int)r.w, true) * x2[7];
  a0 += a1;
  return a0.x + a0.y;
}
__device__ __forceinline__ void peer_axpy(const uint4& r, float a, f32x2 (&o2)[8]) {
  const f32x2 aa = {a, a};
  o2[0] += __builtin_amdgcn_cvt_pk_f32_fp8((int)r.x, false) * aa;
  o2[1] += __builtin_amdgcn_cvt_pk_f32_fp8((int)r.x, true) * aa;
  o2[2] += __builtin_amdgcn_cvt_pk_f32_fp8((int)r.y, false) * aa;
  o2[3] += __builtin_amdgcn_cvt_pk_f32_fp8((int)r.y, true) * aa;
  o2[4] += __builtin_amdgcn_cvt_pk_f32_fp8((int)r.z, false) * aa;
  o2[5] += __builtin_amdgcn_cvt_pk_f32_fp8((int)r.z, true) * aa;
  o2[6] += __builtin_amdgcn_cvt_pk_f32_fp8((int)r.w, false) * aa;
  o2[7] += __builtin_amdgcn_cvt_pk_f32_fp8((int)r.w, true) * aa;
}
__device__ __forceinline__ float reduce8(float (&p)[8], int lane) {
  float q[4];
#pragma unroll
  for (int j = 0; j < 4; ++j) {
    auto r = __builtin_amdgcn_permlane32_swap(__float_as_uint(p[j]), __float_as_uint(p[j + 4]), false, false);
    q[j] = __uint_as_float(r[0]) + __uint_as_float(r[1]);
  }
  float s2[2];
#pragma unroll
  for (int j = 0; j < 2; ++j) {
    auto r = __builtin_amdgcn_permlane16_swap(__float_as_uint(q[j]), __float_as_uint(q[j + 2]), false, false);
    s2[j] = __uint_as_float(r[0]) + __uint_as_float(r[1]);
  }
  const bool b3 = (lane & 8) != 0;
  float keep = b3 ? s2[1] : s2[0];
  float give = b3 ? s2[0] : s2[1];
  float w = keep + dpp_f<0x128>(give);
  w += dpp_f<0xB1>(w);
  w += dpp_f<0x4E>(w);
  w += dpp_f<0x141>(w);
  return w;
}

__device__ __forceinline__ void phase_peer(const int TIDX, const int BIDX, const unsigned char* __restrict__ Eu, const unsigned char* __restrict__ Ev,
                           const float* __restrict__ su, const float* __restrict__ sv, const int* __restrict__ idx,
                           const float* __restrict__ gate, float* h, bf16_t* abuf) {
  const int lane = TIDX & 63, wid = TIDX >> 6;
  const int gw = BIDX * 4 + wid, nW = gridDim.x * 4;
  int t = gw;
  if (t >= T) return;
  int id0 = idx[(size_t)t * 128 + lane], id1 = idx[(size_t)t * 128 + 64 + lane];
  float g0 = gate[(size_t)t * 128 + lane], g1 = gate[(size_t)t * 128 + 64 + lane];
  uint4 xa, xb;
  {
    const uint4* nr = (const uint4*)(abuf + (size_t)t * D);
    xa = nr[lane * 2]; xb = nr[lane * 2 + 1];
  }
  for (; t < T; t += nW) {
    f32x2 x2[8];
    x2[0] = f32x2{bflo(xa.x), bfhi(xa.x)}; x2[1] = f32x2{bflo(xa.y), bfhi(xa.y)};
    x2[2] = f32x2{bflo(xa.z), bfhi(xa.z)}; x2[3] = f32x2{bflo(xa.w), bfhi(xa.w)};
    x2[4] = f32x2{bflo(xb.x), bfhi(xb.x)}; x2[5] = f32x2{bflo(xb.y), bfhi(xb.y)};
    x2[6] = f32x2{bflo(xb.z), bfhi(xb.z)}; x2[7] = f32x2{bflo(xb.w), bfhi(xb.w)};
    const int c0 = id0, c1 = id1;
    const float cg0 = g0, cg1 = g1;
    uint4 buf[3][8];
    peer_issue(buf[0], Eu, c0, 0, lane);
    peer_issue(buf[1], Eu, c0, 1, lane);
    __builtin_amdgcn_sched_barrier(0);
    float su0 = su[c0], su1 = su[c1], sv0 = sv[c0], sv1 = sv[c1];
    const int tn = t + nW;
    if (tn < T) {
      id0 = idx[(size_t)tn * 128 + lane]; id1 = idx[(size_t)tn * 128 + 64 + lane];
      g0 = gate[(size_t)tn * 128 + lane]; g1 = gate[(size_t)tn * 128 + 64 + lane];
      const uint4* nr = (const uint4*)(abuf + (size_t)tn * D);
      xa = nr[lane * 2]; xb = nr[lane * 2 + 1];
    }
    float dot0 = 0.f, dot1 = 0.f, act0 = 0.f, act1 = 0.f;
    f32x2 o2[8];
#pragma unroll
    for (int i = 0; i < 8; ++i) o2[i] = f32x2{0.f, 0.f};
    float4 hv[4];
#pragma unroll
    for (int B = 0; B < 32; ++B) {
      if (B + 2 < 32) {
        const int Bn = B + 2;
        const bool isv = Bn >= 16;
        const int bb = (Bn >> 3) & 1, gp = Bn & 7;
        peer_issue(buf[Bn % 3], isv ? Ev : Eu, bb ? c1 : c0, gp, lane);
      }
      __builtin_amdgcn_sched_barrier(0);
      const int bb = (B >> 3) & 1, gp = B & 7;
      if (B < 16) {
        float p[8];
#pragma unroll
        for (int e = 0; e < 8; ++e) p[e] = peer_dot(buf[B % 3][e], x2);
        float w = reduce8(p, lane);
        if (bb == 0) dot0 = ((lane & 7) == gp) ? w : dot0;
        else dot1 = ((lane & 7) == gp) ? w : dot1;
        if (B == 15) {
          act0 = gelu_tanh(dot0 * su0) * cg0 * sv0;
          act1 = gelu_tanh(dot1 * su1) * cg1 * sv1;
        }
      } else {
        if (B == 24) {
          const float4* hr = (const float4*)(h + (size_t)t * D);
#pragma unroll
          for (int i = 0; i < 4; ++i) hv[i] = hr[lane * 4 + i];
        }
        const float av = bb ? act1 : act0;
#pragma unroll
        for (int e = 0; e < 8; ++e) {
          float a = __int_as_float(__builtin_amdgcn_readlane(__float_as_int(av), 8 * e + gp));
          peer_axpy(buf[B % 3][e], a, o2);
        }
      }
      __builtin_amdgcn_sched_barrier(0);
    }
    float ss = 0.f;
#pragma unroll
    for (int i = 0; i < 4; ++i) {
      hv[i].x += o2[2 * i].x; hv[i].y += o2[2 * i].y; hv[i].z += o2[2 * i + 1].x; hv[i].w += o2[2 * i + 1].y;
      ss += hv[i].x * hv[i].x + hv[i].y * hv[i].y + hv[i].z * hv[i].z + hv[i].w * hv[i].w;
    }
    ss = wave_sum(ss);
    const float rs = rsqrtf(ss * (1.0f / D) + EPS);
    float4* hw = (float4*)(h + (size_t)t * D);
#pragma unroll
    for (int i = 0; i < 4; ++i) hw[lane * 4 + i] = hv[i];
    uint4 p0, p1;
    p0.x = pack2(hv[0].x * rs, hv[0].y * rs); p0.y = pack2(hv[0].z * rs, hv[0].w * rs);
    p0.z = pack2(hv[1].x * rs, hv[1].y * rs); p0.w = pack2(hv[1].z * rs, hv[1].w * rs);
    p1.x = pack2(hv[2].x * rs, hv[2].y * rs); p1.y = pack2(hv[2].z * rs, hv[2].w * rs);
    p1.z = pack2(hv[3].x * rs, hv[3].y * rs); p1.w = pack2(hv[3].z * rs, hv[3].w * rs);
    uint4* ar = (uint4*)(abuf + (size_t)t * D);
    ar[lane * 2] = p0; ar[lane * 2 + 1] = p1;
  }
}

__device__ __forceinline__ void run_phase(const int TIDX, const int BIDX, const Params& P, int ph, char* smem) {
  char* ws = P.ws;
  bf16_t* abuf = (bf16_t*)(ws + OFF_ABUF);
  bf16_t* zb = (bf16_t*)(ws + OFF_Z);
  float* h = P.out;
  if (ph == 0) { phase_convert(TIDX, BIDX, P); return; }
  if (ph == NPHASE - 1) { phase_norm<2>(TIDX, BIDX, h, P.in[22], nullptr, h); return; }
  const int L = (ph - 1) / 9, s = (ph - 1) % 9;
  const float* hin = (L == 0) ? P.in[0] : h;
  switch (s) {
    case 0: phase_norm<0>(TIDX, BIDX, hin, nullptr, abuf, nullptr); break;
    case 1: phase_gemm_bf16out(TIDX, BIDX, abuf, (const bf16_t*)(ws + OFF_WINT) + (size_t)L * 2304 * 1024, zb, 2304, 1024, smem); break;
    case 2: phase_mix(TIDX, BIDX, P, L, zb, abuf, smem); break;
    case 3: phase_gemm_resid(TIDX, BIDX, abuf, (const bf16_t*)(ws + OFF_WOUTT) + (size_t)L * 1024 * 1024, hin, h, 1024, smem); break;
    case 4: phase_norm<1>(TIDX, BIDX, h, P.in[14] + L * 1024, abuf, nullptr); break;
    case 5: phase_gemm_bf16out(TIDX, BIDX, abuf, (const bf16_t*)(ws + OFF_WQT) + (size_t)L * 2048 * 1024, zb, 2048, 1024, smem); break;
    case 6: phase_scores(TIDX, BIDX, zb, (const bf16_t*)(ws + OFF_KEYS) + (size_t)L * 8 * 2 * 128 * 128, (int*)(ws + OFF_IDX), (float*)(ws + OFF_GATE), smem); break;
    case 7: phase_peer(TIDX, BIDX, (const unsigned char*)(ws + OFF_EU) + (size_t)L * NEXP * 1024, (const unsigned char*)(ws + OFF_EV) + (size_t)L * NEXP * 1024,
                       (const float*)(ws + OFF_ESC) + L * NEXP, (const float*)(ws + OFF_ESC) + (2 + L) * NEXP,
                       (const int*)(ws + OFF_IDX), (const float*)(ws + OFF_GATE), h, abuf); break;
    case 8: phase_gemm_ple(TIDX, BIDX, abuf, (const bf16_t*)(ws + OFF_WPGT) + (size_t)L * 1024 * 1024, (const bf16_t*)(ws + OFF_PBF) + (size_t)L * T * 256,
                           (const bf16_t*)(ws + OFF_WPET) + (size_t)L * 1024 * 256, h, zb, smem); break;
  }
}

__global__ void __launch_bounds__(256, 2) peer_trunk_mk(Params P) {
  extern __shared__ __attribute__((aligned(16))) char smem[];
  cg::grid_group grid = cg::this_grid();
  for (int ph = P.ph_lo; ph < P.ph_hi; ++ph) {
    int tl = (int)__builtin_amdgcn_workitem_id_x(), bl = (int)__builtin_amdgcn_workgroup_id_x();
    asm volatile("" : "+v"(tl));
    asm volatile("" : "+s"(bl));
    run_phase(tl, bl, P, ph, smem);
#ifdef PROBE_DUP
    if (ph == 1 + PROBE_DUP) { grid.sync(); run_phase(tl, bl, P, ph, smem); }
#endif
    if (ph + 1 < P.ph_hi) grid.sync();
  }
}

extern "C" void kernel_launch(void* const* d_in, const int* in_sizes, int n_in, void* d_out, int out_size,
                              void* d_ws, size_t ws_size, hipStream_t stream) {
  static int grid_blocks = 0;
  if (grid_blocks == 0) {
    if (n_in != 23 || ws_size < WS_END) { fprintf(stderr, "kernel_launch: unexpected n_in %d or ws_size %zu (< %zu)\n", n_in, ws_size, (size_t)WS_END); grid_blocks = -1; return; }
    int dev = 0, cus = 0, per_cu = 0;
    hipGetDevice(&dev);
    hipDeviceGetAttribute(&cus, hipDeviceAttributeMultiprocessorCount, dev);
    hipFuncSetAttribute((const void*)peer_trunk_mk, hipFuncAttributeMaxDynamicSharedMemorySize, SMEM_BYTES);
    hipOccupancyMaxActiveBlocksPerMultiprocessor(&per_cu, (const void*)peer_trunk_mk, 256, SMEM_BYTES);
    if (per_cu < 1) per_cu = 1;
    if (per_cu > 2) per_cu = 2;
    grid_blocks = cus * per_cu;
    fprintf(stderr, "kernel_launch: cus %d per_cu %d grid %d\n", cus, per_cu, grid_blocks);
  }
  if (grid_blocks < 0) return;
  Params P{};
  for (int i = 0; i < 23; ++i) P.in[i] = (const float*)d_in[i];
  P.out = (float*)d_out;
  P.ws = (char*)d_ws;
#if ONE_LAUNCH
  P.ph_lo = 0; P.ph_hi = NPHASE;
  void* args[] = {&P};
  hipError_t e = hipLaunchCooperativeKernel((void*)peer_trunk_mk, dim3(grid_blocks), dim3(256), args, SMEM_BYTES, stream);
  if (e != hipSuccess) fprintf(stderr, "cooperative launch failed: %s (grid %d)\n", hipGetErrorString(e), grid_blocks);
#else
  for (int ph = 0; ph < NPHASE; ++ph) {
    P.ph_lo = ph; P.ph_hi = ph + 1;
    hipLaunchKernelGGL(peer_trunk_mk, dim3(grid_blocks), dim3(256), SMEM_BYTES, stream, P);
  }
#endif
}
```

```cpp
#include <hip/hip_runtime.h>
#include <hip/hip_bf16.h>
#include <hip/hip_cooperative_groups.h>
#include <cstdio>
namespace cg = cooperative_groups;

#ifndef ONE_LAUNCH
#define ONE_LAUNCH 1
#endif

typedef unsigned short bf16_t;
using bf16x8 = __attribute__((ext_vector_type(8))) short;
using f32x4 = __attribute__((ext_vector_type(4))) float;

constexpr int T = 65536;
constexpr int D = 1024;
constexpr int SEQ = 8192;
constexpr int INC = 2304;
constexpr int NEXP = 16384;
constexpr float EPS = 1e-6f;
constexpr int SMEM_BYTES = 131072 + 16;
__device__ __forceinline__ int launder_s(int x) { asm volatile("" : "+s"(x)); return x; }
#define VGRID (launder_s((int)gridDim.x * 2))
constexpr int NPHASE = 24;

constexpr size_t OFF_WINT = 0;
constexpr size_t OFF_WOUTT = OFF_WINT + (size_t)2 * 2304 * 1024 * 2;
constexpr size_t OFF_WQT = OFF_WOUTT + (size_t)2 * 1024 * 1024 * 2;
constexpr size_t OFF_WPGT = OFF_WQT + (size_t)2 * 2048 * 1024 * 2;
constexpr size_t OFF_WPET = OFF_WPGT + (size_t)2 * 1024 * 1024 * 2;
constexpr size_t OFF_KEYS = OFF_WPET + (size_t)2 * 1024 * 256 * 2;
constexpr size_t OFF_EU = OFF_KEYS + (size_t)2 * 8 * 2 * 128 * 128 * 2;
constexpr size_t OFF_EV = OFF_EU + (size_t)2 * NEXP * 1024;
constexpr size_t OFF_ESC = OFF_EV + (size_t)2 * NEXP * 1024;
constexpr size_t OFF_PBF = OFF_ESC + (size_t)4 * NEXP * 4;
constexpr size_t OFF_ABUF = OFF_PBF + (size_t)2 * T * 256 * 2;
constexpr size_t OFF_Z = OFF_ABUF + (size_t)T * 1024 * 2;
constexpr size_t OFF_IDX = OFF_Z + (size_t)T * 2304 * 2;
constexpr size_t OFF_GATE = OFF_IDX + (size_t)T * 128 * 4;
constexpr size_t OFF_WSB = OFF_GATE + (size_t)T * 128 * 4;
constexpr size_t OFF_ACT = OFF_WSB + (size_t)2 * 6 * 128 * 128 * 2;
constexpr size_t OFF_SSQ = OFF_ACT + (size_t)T * 128 * 4;
constexpr size_t OFF_N8 = OFF_SSQ + (size_t)8 * T * 4;
constexpr size_t OFF_BAR = OFF_N8 + (size_t)T * 1024;
constexpr size_t OFF_H = OFF_BAR + 16384;
constexpr size_t OFF_SSQA = OFF_H + (size_t)T * 1024 * 2;
constexpr size_t OFF_SSQB = OFF_SSQA + (size_t)T * 4;
constexpr size_t WS_END = OFF_SSQB + (size_t)T * 4;

struct Params {
  const float* in[23];
  float* out;
  char* ws;
  int ph_lo, ph_hi;
};

typedef float cvt_f2 __attribute__((ext_vector_type(2)));
typedef __bf16 cvt_b2 __attribute__((ext_vector_type(2)));
__device__ __forceinline__ unsigned pack2(float a, float b) {
  const cvt_f2 v = {a, b};
  return __builtin_bit_cast(unsigned, __builtin_convertvector(v, cvt_b2));
}
__device__ __forceinline__ unsigned short f2bf(float f) { return (unsigned short)(pack2(f, f) & 0xffffu); }
__device__ __forceinline__ float bf2f(unsigned short b) { return __uint_as_float(((unsigned)b) << 16); }
__device__ __forceinline__ float bflo(unsigned u) { return __uint_as_float(u << 16); }
__device__ __forceinline__ float bfhi(unsigned u) { return __uint_as_float(u & 0xffff0000u); }
__device__ __forceinline__ float sigmoidf_(float x) { return __builtin_amdgcn_rcpf(1.0f + __builtin_amdgcn_exp2f(x * -1.4426950408889634f)); }
__device__ __forceinline__ float gelu_tanh(float x) {
  float u = 0.7978845608028654f * (x + 0.044715f * x * x * x);
  float e = __builtin_amdgcn_exp2f(u * 2.8853900817779268f);
  float th = 1.0f - 2.0f * __builtin_amdgcn_rcpf(e + 1.0f);
  return 0.5f * x * (1.0f + th);
}
template <int CTRL>
__device__ __forceinline__ float dpp_f(float v) {
  return __int_as_float(__builtin_amdgcn_update_dpp(0, __float_as_int(v), CTRL, 0xF, 0xF, true));
}
__device__ __forceinline__ float wave_sum(float v) {
  v += dpp_f<0xB1>(v);
  v += dpp_f<0x4E>(v);
  v += dpp_f<0x141>(v);
  v += dpp_f<0x140>(v);
  float s = __int_as_float(__builtin_amdgcn_readlane(__float_as_int(v), 0)) +
            __int_as_float(__builtin_amdgcn_readlane(__float_as_int(v), 16)) +
            __int_as_float(__builtin_amdgcn_readlane(__float_as_int(v), 32)) +
            __int_as_float(__builtin_amdgcn_readlane(__float_as_int(v), 48));
  return s;
}

__device__ __forceinline__ float wave_max(float v) {
  v = fmaxf(v, dpp_f<0xB1>(v));
  v = fmaxf(v, dpp_f<0x4E>(v));
  v = fmaxf(v, dpp_f<0x141>(v));
  v = fmaxf(v, dpp_f<0x140>(v));
  float s = fmaxf(fmaxf(__int_as_float(__builtin_amdgcn_readlane(__float_as_int(v), 0)),
                        __int_as_float(__builtin_amdgcn_readlane(__float_as_int(v), 16))),
                  fmaxf(__int_as_float(__builtin_amdgcn_readlane(__float_as_int(v), 32)),
                        __int_as_float(__builtin_amdgcn_readlane(__float_as_int(v), 48))));
  return s;
}
typedef float f32x2 __attribute__((ext_vector_type(2)));
__device__ __forceinline__ float group8_sum(float v) {
  v += dpp_f<0xB1>(v);
  v += dpp_f<0x4E>(v);
  v += dpp_f<0x141>(v);
  return v;
}

__device__ __forceinline__ int lds_off(int r, int c) { return r * 128 + ((c ^ ((r >> 1) & 7)) << 4); }

typedef unsigned u32x4_k __attribute__((ext_vector_type(4)));
__device__ __forceinline__ void gemm_kloop_issue(const int TIDX, const bf16_t* __restrict__ A, int lda, const bf16_t* __restrict__ Bt, int ldb,
                                                 u32x4_k (&ra)[4], u32x4_k (&rb)[4]) {
  const int sr = TIDX >> 3, sc = TIDX & 7;
  const bf16_t* ga = A + (size_t)sr * lda + sc * 8;
  const bf16_t* gb = Bt + (size_t)sr * ldb + sc * 8;
#pragma unroll
  for (int i = 0; i < 4; ++i) {
    ra[i] = *(const u32x4_k*)(ga + (size_t)(32 * i) * lda);
    rb[i] = *(const u32x4_k*)(gb + (size_t)(32 * i) * ldb);
  }
}
__device__ __forceinline__ void gemm_kloop(const int TIDX, const int BIDX, const bf16_t* __restrict__ A, int lda,
                                           const bf16_t* __restrict__ Bt, int ldb, int K,
                                           char* smem, f32x4 (&acc)[4][4], u32x4_k (&ra)[4], u32x4_k (&rb)[4]) {
  const int tid = TIDX, lane = tid & 63, wid = tid >> 6;
  const int wr = wid >> 1, wc = wid & 1;
  const int fr = lane & 15, fq = lane >> 4;
  const int sr = tid >> 3, sc = tid & 7;
  const bf16_t* ga = A + (size_t)sr * lda + sc * 8;
  const bf16_t* gb = Bt + (size_t)sr * ldb + sc * 8;
#pragma unroll
  for (int mi = 0; mi < 4; ++mi)
#pragma unroll
    for (int ni = 0; ni < 4; ++ni) acc[mi][ni] = f32x4{0.f, 0.f, 0.f, 0.f};
#pragma unroll
  for (int i = 0; i < 4; ++i) {
    *(u32x4_k*)(smem + lds_off(sr + 32 * i, sc)) = ra[i];
    *(u32x4_k*)(smem + 16384 + lds_off(sr + 32 * i, sc)) = rb[i];
  }
  __syncthreads();
  const int nt = K >> 6;
  for (int kt = 0; kt < nt; ++kt) {
    char* bufp = smem + (kt & 1) * 32768;
    const bool more = (kt + 1 < nt);
    if (more) {
#pragma unroll
      for (int i = 0; i < 4; ++i) {
        ra[i] = *(const u32x4_k*)(ga + (size_t)(32 * i) * lda + (kt + 1) * 64);
        rb[i] = *(const u32x4_k*)(gb + (size_t)(32 * i) * ldb + (kt + 1) * 64);
      }
    }
#pragma unroll
    for (int kk = 0; kk < 2; ++kk) {
      bf16x8 af[4], bfr[4];
#pragma unroll
      for (int mi = 0; mi < 4; ++mi) af[mi] = *(const bf16x8*)(bufp + lds_off(wr * 64 + mi * 16 + fr, kk * 4 + fq));
#pragma unroll
      for (int ni = 0; ni < 4; ++ni) bfr[ni] = *(const bf16x8*)(bufp + 16384 + lds_off(wc * 64 + ni * 16 + fr, kk * 4 + fq));
#pragma unroll
      for (int mi = 0; mi < 4; ++mi)
#pragma unroll
        for (int ni = 0; ni < 4; ++ni)
          acc[mi][ni] = __builtin_amdgcn_mfma_f32_16x16x32_bf16(bfr[ni], af[mi], acc[mi][ni], 0, 0, 0);
    }
    if (more) {
      char* nb = smem + ((kt + 1) & 1) * 32768;
#pragma unroll
      for (int i = 0; i < 4; ++i) {
        *(u32x4_k*)(nb + lds_off(sr + 32 * i, sc)) = ra[i];
        *(u32x4_k*)(nb + 16384 + lds_off(sr + 32 * i, sc)) = rb[i];
      }
    }
    __syncthreads();
  }
}

__device__ __forceinline__ void transpose_convert(const float* __restrict__ src, const float* __restrict__ g, bf16_t* __restrict__ dst,
                                  int Lc, int K, int N, size_t gtid, size_t gsz) {
  const int K8 = K >> 3;
  const size_t total = (size_t)Lc * K8 * N;
  for (size_t u = gtid; u < total; u += gsz) {
    int n = (int)(u % N);
    size_t r = u / N;
    int kc = (int)(r % K8);
    int l = (int)(r / K8);
    float v[8];
#pragma unroll
    for (int i = 0; i < 8; ++i) {
      int k = kc * 8 + i;
      float w = src[((size_t)l * K + k) * N + n];
      if (g) w *= g[l * K + k];
      v[i] = w;
    }
    uint4 o;
    o.x = pack2(v[0], v[1]); o.y = pack2(v[2], v[3]); o.z = pack2(v[4], v[5]); o.w = pack2(v[6], v[7]);
    *(uint4*)(dst + ((size_t)l * N + n) * K + kc * 8) = o;
  }
}
__device__ __forceinline__ void convert_flat(const float* __restrict__ src, bf16_t* __restrict__ dst, size_t n8, size_t gtid, size_t gsz) {
  for (size_t u = gtid; u < n8; u += gsz) {
    float4 a = ((const float4*)src)[2 * u], b = ((const float4*)src)[2 * u + 1];
    uint4 o;
    o.x = pack2(a.x, a.y); o.y = pack2(a.z, a.w); o.z = pack2(b.x, b.y); o.w = pack2(b.z, b.w);
    ((uint4*)dst)[u] = o;
  }
}
__device__ __forceinline__ void phase_convert(const int TIDX, const int BIDX, const Params& P) {
  const size_t gtid = (size_t)BIDX * 256 + TIDX;
  const size_t gsz = (size_t)VGRID * 256;
  char* ws = P.ws;
  transpose_convert(P.in[3], P.in[2], (bf16_t*)(ws + OFF_WINT), 2, 1024, 2304, gtid, gsz);
  transpose_convert(P.in[13], nullptr, (bf16_t*)(ws + OFF_WOUTT), 2, 1024, 1024, gtid, gsz);
  transpose_convert(P.in[15], P.in[14], (bf16_t*)(ws + OFF_WQT), 2, 1024, 2048, gtid, gsz);
  transpose_convert(P.in[21], P.in[19], (bf16_t*)(ws + OFF_WPGT), 2, 1024, 1024, gtid, gsz);
  transpose_convert(P.in[20], nullptr, (bf16_t*)(ws + OFF_WPET), 2, 256, 1024, gtid, gsz);
  convert_flat(P.in[16], (bf16_t*)(ws + OFF_KEYS), (size_t)2 * 8 * 2 * 128 * 128 / 8, gtid, gsz);
  {
    const int lane = TIDX & 63;
    const int gw = BIDX * 4 + (TIDX >> 6), nW = VGRID * 4;
    float* esc = (float*)(ws + OFF_ESC);
    for (int row0 = gw * 2; row0 < 4 * NEXP; row0 += nW * 2) {
      float4 v[2][4];
#pragma unroll
      for (int rr = 0; rr < 2; ++rr) {
        const int row = row0 + rr;
        const float* src = (row < 2 * NEXP) ? (P.in[17] + (size_t)row * 1024) : (P.in[18] + (size_t)(row - 2 * NEXP) * 1024);
#pragma unroll
        for (int i = 0; i < 4; ++i) v[rr][i] = ((const float4*)src)[lane * 4 + i];
      }
#pragma unroll
      for (int rr = 0; rr < 2; ++rr) {
        const int row = row0 + rr;
        float m = 0.f;
#pragma unroll
        for (int i = 0; i < 4; ++i) m = fmaxf(m, fmaxf(fmaxf(fabsf(v[rr][i].x), fabsf(v[rr][i].y)), fmaxf(fabsf(v[rr][i].z), fabsf(v[rr][i].w))));
        m = wave_max(m);
        const float sc = (m > 0.f) ? 224.0f * __builtin_amdgcn_rcpf(m) : 0.f;
        uint4 o;
        unsigned w[4];
#pragma unroll
        for (int i = 0; i < 4; ++i) {
          int t = __builtin_amdgcn_cvt_pk_fp8_f32(v[rr][i].x * sc, v[rr][i].y * sc, 0, false);
          t = __builtin_amdgcn_cvt_pk_fp8_f32(v[rr][i].z * sc, v[rr][i].w * sc, t, true);
          w[i] = (unsigned)t;
        }
        o.x = w[0]; o.y = w[1]; o.z = w[2]; o.w = w[3];
        *(uint4*)(ws + OFF_EU + (size_t)(row / NEXP) * ((size_t)NEXP * 1024) + (size_t)(lane >> 3) * ((size_t)NEXP * 128) + (size_t)(row % NEXP) * 128 + (lane & 7) * 16) = o;
        if (lane == 0) esc[row] = m * (1.0f / 224.0f);
      }
    }
  }
  {
    bf16_t* wsb = (bf16_t*)(ws + OFF_WSB);
    for (size_t u = gtid; u < (size_t)2 * 6 * 128 * 128; u += gsz) {
      int j = (int)(u & 127), i = (int)((u >> 7) & 127);
      float w = P.in[11][u];
      wsb[u] = ((j >> 6) <= (i >> 6)) ? f2bf(w) : (bf16_t)0;
    }
  }
  convert_flat(P.in[1], (bf16_t*)(ws + OFF_PBF), (size_t)2 * T * 256 / 8, gtid, gsz);
}

template <int MODE, bool INB>
__device__ __forceinline__ void phase_norm(const int TIDX, const int BIDX, const void* __restrict__ hraw, const float* __restrict__ g, bf16_t* __restrict__ abuf, float* __restrict__ outp, unsigned char* __restrict__ n8 = nullptr) {
  const int lane = TIDX & 63, wid = TIDX >> 6;
  const int gw = BIDX * 4 + wid, nW = VGRID * 4;
  float4 gv[4];
  if (MODE != 0) {
#pragma unroll
    for (int i = 0; i < 4; ++i) gv[i] = ((const float4*)g)[lane + 64 * i];
  }
  for (int t0 = gw * 4; t0 < T; t0 += nW * 4) {
    float4 v[4][4];
#pragma unroll
    for (int rr = 0; rr < 4; ++rr)
#pragma unroll
      for (int i = 0; i < 4; ++i) {
        if (INB) {
          const uint2 pk = ((const uint2*)((const bf16_t*)hraw + (size_t)(t0 + rr) * D))[lane + 64 * i];
          v[rr][i] = float4{bflo(pk.x), bfhi(pk.x), bflo(pk.y), bfhi(pk.y)};
        } else {
          v[rr][i] = ((const float4*)((const float*)hraw + (size_t)(t0 + rr) * D))[lane + 64 * i];
        }
      }
#pragma unroll
    for (int rr = 0; rr < 4; ++rr) {
      const int t = t0 + rr;
      float ss = 0.f;
#pragma unroll
      for (int i = 0; i < 4; ++i) ss += v[rr][i].x * v[rr][i].x + v[rr][i].y * v[rr][i].y + v[rr][i].z * v[rr][i].z + v[rr][i].w * v[rr][i].w;
      ss = wave_sum(ss);
      float rs = __builtin_amdgcn_rsqf(ss * (1.0f / D) + EPS);
#pragma unroll
      for (int i = 0; i < 4; ++i) {
        float4 o = v[rr][i];
        o.x *= rs; o.y *= rs; o.z *= rs; o.w *= rs;
        if (MODE != 0) { o.x *= gv[i].x; o.y *= gv[i].y; o.z *= gv[i].z; o.w *= gv[i].w; }
        if (MODE == 2) {
          ((float4*)(outp + (size_t)t * D))[lane + 64 * i] = o;
        } else {
          uint2 pk; pk.x = pack2(o.x, o.y); pk.y = pack2(o.z, o.w);
          ((uint2*)(abuf + (size_t)t * D))[lane + 64 * i] = pk;
          if (MODE == 1) {
            const float c0 = fminf(fmaxf(o.x * 16.0f, -440.f), 440.f), c1 = fminf(fmaxf(o.y * 16.0f, -440.f), 440.f);
            const float c2 = fminf(fmaxf(o.z * 16.0f, -440.f), 440.f), c3 = fminf(fmaxf(o.w * 16.0f, -440.f), 440.f);
            int w8 = __builtin_amdgcn_cvt_pk_fp8_f32(c0, c1, 0, false);
            w8 = __builtin_amdgcn_cvt_pk_fp8_f32(c2, c3, w8, true);
            ((int*)(n8 + (size_t)t * D))[lane + 64 * i] = w8;
          }
        }
      }
    }
  }
}

namespace pg8 {
#define PG8_LAS __attribute__((address_space(3)))
typedef unsigned short bf16_t;
typedef short bf16x8 __attribute__((ext_vector_type(8)));
typedef float f32x4 __attribute__((ext_vector_type(4)));
typedef unsigned u32x4 __attribute__((ext_vector_type(4)));
constexpr int BM = 256, BK = 64, HALF = 128, HTB = HALF * BK * 2  , STAGE_BYTES = 8 * HTB, NXCD = 8, WGM = 8;

__host__ __device__ __forceinline__ int lds_byte(int r, int c) { const int st = (r >> 4) * 2 + (c >> 5), rr = r & 15, cc = c & 31, ob = rr * 64 + cc * 2; return st * 1024 + (ob ^ (((ob >> 9) & 1) << 5)); }
__host__ __device__ __forceinline__ void stage_rc(int b, int& R, int& C) { const int st = b / 1024, sb = b % 1024, swz = sb ^ (((sb >> 9) & 1) << 5); R = (st >> 1) * 16 + swz / 64; C = (st & 1) * 32 + (swz % 64) / 2; }
__host__ __device__ __forceinline__ int perm32(int rho) { const int n = rho >> 4, i = rho & 15; return 8 * (i >> 2) + 4 * n + (i & 3); }

struct Unit { int pm, pn; };
struct Gemm { const bf16_t* A; const bf16_t* Bt; int M, N, K; };

struct StaticOrder {
    int nM, nN, nwg, G, c;
    __host__ __device__ void init(int M, int N, int G_, int c_) { nM = M / BM; nN = N / BM; nwg = nM * nN; G = G_; c = c_; }
    __host__ __device__ bool next(int i, Unit& u) const {
        const long L = (long)i * G + c; if (L >= nwg) return false;
        int wgid = (int)L; { const int q = nwg / NXCD, r = nwg % NXCD, xcd = wgid % NXCD, off = wgid / NXCD; wgid = (xcd < r ? xcd * (q + 1) : r * (q + 1) + (xcd - r) * q) + off; }
        const int nig = WGM * nN, gid = wgid / nig, fm = gid * WGM, gsz = (nM - fm) < WGM ? (nM - fm) : WGM;
        u.pm = fm + ((wgid % nig) % gsz); u.pn = (wgid % nig) / gsz; return true;
    }
    __device__ __forceinline__ void a_ready(const Unit&) const {}
    __device__ __forceinline__ void done(const Unit&) const {}
};
__device__ __forceinline__ unsigned cvt_pk_bf16(float lo, float hi) { unsigned r; asm volatile("v_cvt_pk_bf16_f32 %0, %1, %2" : "=v"(r) : "v"(lo), "v"(hi)); return r; }
typedef float f32x2 __attribute__((ext_vector_type(2)));
__device__ __forceinline__ f32x2 gelu_pk(f32x2 v) {
    const f32x2 av = __builtin_elementwise_abs(v), d = av * 0.2316418882f + 1.0f;
    f32x2 t; t.x = __builtin_amdgcn_rcpf(d.x); t.y = __builtin_amdgcn_rcpf(d.y);
    f32x2 q = t * 0.5307027145f + (-0.7265760135f); q = q * t + 0.7107068705f; q = q * t + (-0.142248368f); q = q * t + 0.127414796f; q = q * t;
    const f32x2 s = (v * v) * (-0.72134752044f);
    f32x2 e; e.x = __builtin_amdgcn_exp2f(s.x); e.y = __builtin_amdgcn_exp2f(s.y);
    const f32x2 m = v * (q * e), r = v - m;
    f32x2 o; o.x = v.x < 0.f ? m.x : r.x; o.y = v.y < 0.f ? m.y : r.y; return o;
}
template <int ACT  > struct EpiBf16 {
    static constexpr bool PERM = true, AFTER_DRAIN = false;
    bf16_t* O; int ldc; const float* bias; int split_cols; size_t split_stride;
    __device__ __forceinline__ void operator()(const f32x4 (&acc)[2][2][4][2], const Unit& u, int wr, int wc, int fr, int fq) const {
        const int row0 = u.pm * BM + wr * 64 + fr; int colt = u.pn * BM; bf16_t* base = O;
        if (split_cols) { const int t = colt / split_cols; base += (size_t)t * split_stride; colt -= t * split_cols; }
        const int col0 = colt + wc * 32 + 8 * fq, bcol0 = u.pn * BM + wc * 32 + 8 * fq;
        f32x4 bv[2][2];
#pragma unroll
        for (int bj = 0; bj < 2; ++bj)
#pragma unroll
            for (int n = 0; n < 2; ++n) bv[bj][n] = bias ? *(const f32x4*)(bias + bcol0 + bj * HALF + 4 * n) : (f32x4){0.f, 0.f, 0.f, 0.f};
#pragma unroll
        for (int ai = 0; ai < 2; ++ai)
#pragma unroll
            for (int m = 0; m < 4; ++m) { bf16_t* rowp = base + (size_t)(row0 + ai * HALF + m * 16) * ldc + col0;
#pragma unroll
                for (int bj = 0; bj < 2; ++bj) { f32x4 v0 = acc[ai][bj][m][0] + bv[bj][0], v1 = acc[ai][bj][m][1] + bv[bj][1];
                    if (ACT == 1) { f32x2 a = gelu_pk((f32x2){v0[0], v0[1]}), b = gelu_pk((f32x2){v0[2], v0[3]}), c = gelu_pk((f32x2){v1[0], v1[1]}), d = gelu_pk((f32x2){v1[2], v1[3]});
                        v0 = (f32x4){a.x, a.y, b.x, b.y}; v1 = (f32x4){c.x, c.y, d.x, d.y}; }
                    if (ACT == 2) {
#pragma unroll
                        for (int j = 0; j < 4; ++j) { v0[j] = 0.5f * v0[j] * (1.0f + erff(v0[j] * 0.70710678f)); v1[j] = 0.5f * v1[j] * (1.0f + erff(v1[j] * 0.70710678f)); } }
                    u32x4 w; w.x = cvt_pk_bf16(v0[0], v0[1]); w.y = cvt_pk_bf16(v0[2], v0[3]); w.z = cvt_pk_bf16(v1[0], v1[1]); w.w = cvt_pk_bf16(v1[2], v1[3]);
                    *(u32x4*)(rowp + bj * HALF) = w; } }
    }
};
template <class Epi, class Sched, bool STAMP = false>
__device__ __forceinline__ void gemm_phase(const int TL, PG8_LAS unsigned char* lds, const Gemm g, const Sched& S, const Epi& E, unsigned long long* stamps) {
    const int tid = TL, wid = __builtin_amdgcn_readfirstlane(tid >> 6), lane = tid & 63, wr = wid >> 2, wc = wid & 3, fr = lane & 15, fq = lane >> 4;
    const int K = g.K, nt = K / BK;
    int ts_lo = 0, ts_hi = 0, nts = 0; const unsigned long long rt_entry = STAMP ? (unsigned long long)wall_clock64() : 0ull;
#define PG8_STAMP() do { if (STAMP && wid == 0 && nts < 64) { const unsigned long long _c = (unsigned long long)clock64(); \
        ts_lo = (lane == nts) ? (int)(unsigned)_c : ts_lo; ts_hi = (lane == nts) ? (int)(unsigned)(_c >> 32) : ts_hi; ++nts; } } while (0)
    PG8_STAMP();
    unsigned voffA[2], voffB[2];
#pragma unroll
    for (int i = 0; i < 2; ++i) { int R, C; stage_rc(tid * 16 + i * 8192, R, C); const int Rb = Epi::PERM ? ((R & ~31) + perm32(R & 31)) : R;
        voffA[i] = (unsigned)(R * K + C) * 2u; voffB[i] = (unsigned)(Rb * K + C) * 2u; }
    const size_t kstep = (size_t)(BK * 2);
    const size_t hstep = (size_t)HALF * K * 2;
    const size_t tstep = 2 * hstep;
    const unsigned ldsw = (unsigned)wid * 1024u;
    const int aoff = lds_byte(wr * 64 + fr, fq * 8), boff = lds_byte(wc * 32 + fr, fq * 8);
#define PG8_SA(b, h) (((b) * 2 + (h)) * HTB)
#define PG8_SB(b, h) ((4 + (b) * 2 + (h)) * HTB)
#define PG8_STAGE(bufoff, gbase, voff) do { _Pragma("unroll") for (int _i = 0; _i < 2; ++_i) \
        __builtin_amdgcn_global_load_lds((const unsigned*)((const char*)(gbase) + (voff)[_i]), (PG8_LAS unsigned*)(lds + (bufoff) + ldsw + _i * 8192), 16, 0, 0); } while (0)
#define PG8_LDA(dst, b, h) do { _Pragma("unroll") for (int m = 0; m < 4; ++m) _Pragma("unroll") for (int k = 0; k < 2; ++k) dst[m][k] = *(const PG8_LAS bf16x8*)(lds + PG8_SA(b, h) + aoff + m * 2048 + k * 1024); } while (0)
#define PG8_LDB(dst, b, h) do { _Pragma("unroll") for (int n = 0; n < 2; ++n) _Pragma("unroll") for (int k = 0; k < 2; ++k) dst[n][k] = *(const PG8_LAS bf16x8*)(lds + PG8_SB(b, h) + boff + n * 2048 + k * 1024); } while (0)
#define PG8_MMA(ai, bj, At, Bt) do { __builtin_amdgcn_s_setprio(1); _Pragma("unroll") for (int m = 0; m < 4; ++m) _Pragma("unroll") for (int n = 0; n < 2; ++n) _Pragma("unroll") for (int k = 0; k < 2; ++k) \
        acc[ai][bj][m][n] = __builtin_amdgcn_mfma_f32_16x16x32_bf16(Bt[n][k], At[m][k], acc[ai][bj][m][n], 0, 0, 0); __builtin_amdgcn_s_setprio(0); } while (0)
#define PG8_WAIT_V(n) asm volatile("s_waitcnt vmcnt(" #n ")" ::: "memory")
#define PG8_WAIT_L(n) asm volatile("s_waitcnt lgkmcnt(" #n ")" ::: "memory")
#define PG8_BAR __builtin_amdgcn_s_barrier()
#define PG8_SCHED __builtin_amdgcn_sched_barrier(0)
    Unit cur, nxt; int ui = 0;
    if (!S.next(0, cur)) return;
    f32x4 acc[2][2][4][2];
#pragma unroll
    for (int a = 0; a < 2; ++a)
#pragma unroll
        for (int b = 0; b < 2; ++b)
#pragma unroll
            for (int m = 0; m < 4; ++m)
#pragma unroll
                for (int n = 0; n < 2; ++n) acc[a][b][m][n] = (f32x4){0.f, 0.f, 0.f, 0.f};
    bf16x8 At[4][2], B0[2][2], B1[2][2];
    const char* cA = (const char*)g.A + (size_t)cur.pm * tstep; const char* cB = (const char*)g.Bt + (size_t)cur.pn * tstep;
    S.a_ready(cur);
    PG8_STAGE(PG8_SB(0, 0), cB, voffB); PG8_STAGE(PG8_SA(0, 0), cA, voffA); PG8_STAGE(PG8_SB(0, 1), cB + hstep, voffB); PG8_STAGE(PG8_SA(0, 1), cA + hstep, voffA);
    if (wr == 1) PG8_BAR;
    PG8_WAIT_V(4); PG8_BAR;
    PG8_STAGE(PG8_SB(1, 0), cB + kstep, voffB); PG8_STAGE(PG8_SA(1, 0), cA + kstep, voffA); PG8_STAGE(PG8_SB(1, 1), cB + hstep + kstep, voffB);
    PG8_WAIT_V(6); PG8_BAR;
    PG8_STAMP();
    for (;;) {
        const bool has_next = S.next(ui + 1, nxt);
        const char* nA = has_next ? (const char*)g.A + (size_t)nxt.pm * tstep : cA; const char* nB = has_next ? (const char*)g.Bt + (size_t)nxt.pn * tstep : cB;
        for (int t = 0; t < nt; t += 2) {
            const bool last = (t == nt - 2);
            const char* a1 = cA + (size_t)(t + 1) * kstep;
            const char* a2 = last ? nA : cA + (size_t)(t + 2) * kstep; const char* b2 = last ? nB : cB + (size_t)(t + 2) * kstep;
            const char* a3 = a2 + kstep; const char* b3 = b2 + kstep;
            if (last && has_next) S.a_ready(nxt);
            PG8_LDB(B0, 0, 0); PG8_SCHED; PG8_LDA(At, 0, 0); PG8_STAGE(PG8_SA(1, 1), a1 + hstep, voffA);
            PG8_WAIT_L(8); PG8_BAR; PG8_WAIT_L(0); PG8_MMA(0, 0, At, B0); PG8_BAR; PG8_SCHED;
            PG8_LDB(B1, 0, 1); PG8_STAGE(PG8_SB(0, 0), b2, voffB);
            PG8_BAR; PG8_WAIT_L(0); PG8_MMA(0, 1, At, B1); PG8_BAR;
            PG8_LDA(At, 0, 1); PG8_STAGE(PG8_SA(0, 0), a2, voffA);
            PG8_BAR; PG8_WAIT_L(0); PG8_MMA(1, 0, At, B0); PG8_BAR; PG8_SCHED;
            PG8_STAGE(PG8_SB(0, 1), b2 + hstep, voffB);
            PG8_WAIT_V(6); PG8_BAR; PG8_MMA(1, 1, At, B1); PG8_BAR;
            PG8_LDB(B0, 1, 0); PG8_SCHED; PG8_LDA(At, 1, 0); PG8_STAGE(PG8_SA(0, 1), a2 + hstep, voffA);
            PG8_WAIT_L(8); PG8_BAR; PG8_WAIT_L(0); PG8_MMA(0, 0, At, B0); PG8_BAR; PG8_SCHED;
            PG8_LDB(B1, 1, 1); PG8_STAGE(PG8_SB(1, 0), b3, voffB);
            PG8_BAR; PG8_WAIT_L(0); PG8_MMA(0, 1, At, B1); PG8_BAR;
            PG8_LDA(At, 1, 1); PG8_STAGE(PG8_SA(1, 0), a3, voffA);
            PG8_BAR; PG8_WAIT_L(0); PG8_MMA(1, 0, At, B0); PG8_BAR; PG8_SCHED;
            PG8_STAGE(PG8_SB(1, 1), b3 + hstep, voffB);
            PG8_WAIT_V(6); PG8_BAR; PG8_MMA(1, 1, At, B1); PG8_BAR;
        }
        PG8_STAMP();
        if constexpr (!Epi::AFTER_DRAIN) { E(acc, cur, wr, wc, fr, fq); S.done(cur); }
        PG8_STAMP();
        if (!has_next) break;
#pragma unroll
        for (int a = 0; a < 2; ++a)
#pragma unroll
            for (int b = 0; b < 2; ++b)
#pragma unroll
                for (int m = 0; m < 4; ++m)
#pragma unroll
                    for (int n = 0; n < 2; ++n) acc[a][b][m][n] = (f32x4){0.f, 0.f, 0.f, 0.f};
        cur = nxt; cA = nA; cB = nB; ++ui;
    }
    PG8_WAIT_V(0);
    if (wr == 0) PG8_BAR;
    PG8_BAR;
    if constexpr (Epi::AFTER_DRAIN) { E.fused(acc, cur, wr, wc, fr, fq, lds, wid, lane); S.done(cur); }
    PG8_STAMP();
    if (STAMP && wid == 0) { stamps[lane] = lane < nts ? (((unsigned long long)(unsigned)ts_hi << 32) | (unsigned)ts_lo) : 0ull;
        if (lane == 62) stamps[62] = rt_entry; if (lane == 63) stamps[63] = (unsigned long long)wall_clock64(); }
#undef PG8_STAMP
#undef PG8_SA
#undef PG8_SB
#undef PG8_STAGE
#undef PG8_LDA
#undef PG8_LDB
#undef PG8_MMA
#undef PG8_WAIT_V
#undef PG8_WAIT_L
#undef PG8_BAR
#undef PG8_SCHED
}
}

template <bool INB>
struct EpiResid {
  static constexpr bool PERM = true, AFTER_DRAIN = false;
  const void* hin; bf16_t* hout; float* ssq; int wave_id;
  __device__ __forceinline__ void operator()(const pg8::f32x4 (&acc)[2][2][4][2], const pg8::Unit& u, int, int, int, int) const {
    int lane_id;
    asm volatile("v_mbcnt_lo_u32_b32 %0, -1, 0\n\tv_mbcnt_hi_u32_b32 %0, -1, %0" : "=v"(lane_id));
    const int wr = wave_id >> 2, wc = wave_id & 3, fr = lane_id & 15, fq = lane_id >> 4;
    const int row0 = u.pm * 256 + wr * 64 + fr, col0 = u.pn * 256 + wc * 32 + 8 * fq;
#pragma unroll
    for (int ai = 0; ai < 2; ++ai)
#pragma unroll
      for (int m = 0; m < 4; ++m) {
        const int row = row0 + ai * 128 + m * 16;
        const size_t ro = (size_t)row * D + col0;
        float sq = 0.f;
#pragma unroll
        for (int bj = 0; bj < 2; ++bj)
#pragma unroll
          for (int n = 0; n < 2; ++n) {
            const size_t o = ro + bj * 128 + n * 4;
            pg8::f32x4 v;
            if (INB) { const uint2 pk = *(const uint2*)((const bf16_t*)hin + o); v = pg8::f32x4{bflo(pk.x), bfhi(pk.x), bflo(pk.y), bfhi(pk.y)}; }
            else v = *(const pg8::f32x4*)((const float*)hin + o);
            v = v + acc[ai][bj][m][n];
            uint2 w; w.x = pack2(v[0], v[1]); w.y = pack2(v[2], v[3]);
            *(uint2*)(hout + o) = w;
            const float r0 = bflo(w.x), r1 = bfhi(w.x), r2 = bflo(w.y), r3 = bfhi(w.y);
            sq += r0 * r0 + r1 * r1 + r2 * r2 + r3 * r3;
          }
        sq += __shfl_xor(sq, 16);
        sq += __shfl_xor(sq, 32);
        if (fq == 0) atomicAdd(ssq + row, sq);
      }
  }
};
struct EpiBf16Rs {
  static constexpr bool PERM = true, AFTER_DRAIN = false;
  bf16_t* O; int ldc; const float* ssq; int wave_id;
  __device__ __forceinline__ void operator()(const pg8::f32x4 (&acc)[2][2][4][2], const pg8::Unit& u, int, int, int, int) const {
    int lane_id;
    asm volatile("v_mbcnt_lo_u32_b32 %0, -1, 0\n\tv_mbcnt_hi_u32_b32 %0, -1, %0" : "=v"(lane_id));
    const int wr = wave_id >> 2, wc = wave_id & 3, fr = lane_id & 15, fq = lane_id >> 4;
    const int row0 = u.pm * 256 + wr * 64 + fr, col0 = u.pn * 256 + wc * 32 + 8 * fq;
#pragma unroll
    for (int ai = 0; ai < 2; ++ai)
#pragma unroll
      for (int m = 0; m < 4; ++m) {
        const int row = row0 + ai * 128 + m * 16;
        const float rs = __builtin_amdgcn_rsqf(ssq[row] * (1.0f / D) + EPS);
        bf16_t* rowp = O + (size_t)row * ldc + col0;
#pragma unroll
        for (int bj = 0; bj < 2; ++bj) {
          const pg8::f32x4 v0 = acc[ai][bj][m][0], v1 = acc[ai][bj][m][1];
          pg8::u32x4 w;
          w.x = pack2(v0[0] * rs, v0[1] * rs); w.y = pack2(v0[2] * rs, v0[3] * rs);
          w.z = pack2(v1[0] * rs, v1[1] * rs); w.w = pack2(v1[2] * rs, v1[3] * rs);
          *(pg8::u32x4*)(rowp + bj * 128) = w;
        }
      }
  }
};
struct EpiSig {
  static constexpr bool PERM = true, AFTER_DRAIN = false;
  const float* ssq; bf16_t* sg; int wave_id;
  __device__ __forceinline__ void operator()(const pg8::f32x4 (&acc)[2][2][4][2], const pg8::Unit& u, int, int, int, int) const {
    int lane_id;
    asm volatile("v_mbcnt_lo_u32_b32 %0, -1, 0\n\tv_mbcnt_hi_u32_b32 %0, -1, %0" : "=v"(lane_id));
    const int wr = wave_id >> 2, wc = wave_id & 3, fr = lane_id & 15, fq = lane_id >> 4;
    const int row0 = u.pm * 256 + wr * 64 + fr, col0 = u.pn * 256 + wc * 32 + 8 * fq;
#pragma unroll
    for (int ai = 0; ai < 2; ++ai)
#pragma unroll
      for (int m = 0; m < 4; ++m) {
        const int row = row0 + ai * 128 + m * 16;
        float sq = 0.f;
#pragma unroll
        for (int xx = 0; xx < 8; ++xx) sq += ssq[(size_t)xx * T + row];
        const float rs = __builtin_amdgcn_rsqf(sq * (1.0f / D) + EPS);
        const size_t ro = (size_t)row * D + col0;
#pragma unroll
        for (int bj = 0; bj < 2; ++bj)
#pragma unroll
          for (int n = 0; n < 2; ++n) {
            const pg8::f32x4 a = acc[ai][bj][m][n];
            uint2 pk;
            pk.x = pack2(sigmoidf_(rs * a[0]), sigmoidf_(rs * a[1]));
            pk.y = pack2(sigmoidf_(rs * a[2]), sigmoidf_(rs * a[3]));
            *(uint2*)(sg + ro + bj * 128 + n * 4) = pk;
          }
      }
  }
};
struct EpiPle {
  static constexpr bool PERM = true, AFTER_DRAIN = false;
  bf16_t* h; const bf16_t* sg; float* ssq; int wave_id;
  __device__ __forceinline__ void operator()(const pg8::f32x4 (&acc)[2][2][4][2], const pg8::Unit& u, int, int, int, int) const {
    int lane_id;
    asm volatile("v_mbcnt_lo_u32_b32 %0, -1, 0\n\tv_mbcnt_hi_u32_b32 %0, -1, %0" : "=v"(lane_id));
    const int wr = wave_id >> 2, wc = wave_id & 3, fr = lane_id & 15, fq = lane_id >> 4;
    const int row0 = u.pm * 256 + wr * 64 + fr, col0 = u.pn * 256 + wc * 32 + 8 * fq;
#pragma unroll
    for (int ai = 0; ai < 2; ++ai)
#pragma unroll
      for (int m = 0; m < 4; ++m) {
        const int row = row0 + ai * 128 + m * 16;
        const size_t ro = (size_t)row * D + col0;
        float sq = 0.f;
#pragma unroll
        for (int bj = 0; bj < 2; ++bj)
#pragma unroll
          for (int n = 0; n < 2; ++n) {
            const size_t o = ro + bj * 128 + n * 4;
            const uint2 pk = *(const uint2*)(sg + o);
            const uint2 hp = *(const uint2*)(h + o);
            const pg8::f32x4 a = acc[ai][bj][m][n];
            uint2 w;
            w.x = pack2(bflo(hp.x) + a[0] * bflo(pk.x), bfhi(hp.x) + a[1] * bfhi(pk.x));
            w.y = pack2(bflo(hp.y) + a[2] * bflo(pk.y), bfhi(hp.y) + a[3] * bfhi(pk.y));
            *(uint2*)(h + o) = w;
            const float r0 = bflo(w.x), r1 = bfhi(w.x), r2 = bflo(w.y), r3 = bfhi(w.y);
            sq += r0 * r0 + r1 * r1 + r2 * r2 + r3 * r3;
          }
        sq += __shfl_xor(sq, 16);
        sq += __shfl_xor(sq, 32);
        if (fq == 0) atomicAdd(ssq + row, sq);
      }
  }
};
template <class Epi>
__device__ __forceinline__ void run_gemm(const int TL, const int BL, char* smem, const bf16_t* A, const bf16_t* Bt, int N, int K, const Epi& E) {
  pg8::Gemm g{A, Bt, T, N, K};
  pg8::StaticOrder S; S.init(T, N, (int)gridDim.x, BL);
  pg8::gemm_phase<Epi, pg8::StaticOrder, false>(TL, (PG8_LAS unsigned char*)smem, g, S, E, nullptr);
}

__device__ __forceinline__ void unpack8(const uint4& u, float (&f)[8]) {
  f[0] = bflo(u.x); f[1] = bfhi(u.x); f[2] = bflo(u.y); f[3] = bfhi(u.y);
  f[4] = bflo(u.z); f[5] = bfhi(u.z); f[6] = bflo(u.w); f[7] = bfhi(u.w);
}
__device__ __forceinline__ void phase_mix(const int TIDX, const int BIDX, const Params& P, int L, const bf16_t* __restrict__ z, bf16_t* __restrict__ y,
                                          const bf16_t* __restrict__ wsb, char* smem) {
  const int tid = TIDX, lane = tid & 63, wid = tid >> 6;
  const int r8 = tid >> 3, c8 = tid & 7;
  const float* conv_a_w = P.in[4] + (size_t)L * 31 * 384;
  const float* conv_a_b = P.in[5] + L * 384;
  const float* ln_a_g = P.in[6] + L * 384;
  const float* ln_a_b = P.in[7] + L * 384;
  const float* conv_b_w = P.in[8] + L * 3 * 256;
  const float* ln_c_g = P.in[9] + L * 384;
  const float* ln_c_b = P.in[10] + L * 384;
  const float* b_s = P.in[12] + L * 6 * 128;
  float* fs = (float*)smem;
  for (int item = BIDX; item < 512 * 16; item += VGRID) {
    const int tb = item >> 4, part = (item ^ (item >> 9)) & 15;
    const int t0 = tb * 128;
    const int s0 = t0 & (SEQ - 1);
    if (part < 6) {
      {
        const int ch0 = part * 64 + c8 * 8;
        uint4 vv[5], gg[5];
#pragma unroll
        for (int p = 0; p < 5; ++p) {
          const int r = r8 + 32 * p;
          vv[p] = uint4{0, 0, 0, 0}; gg[p] = uint4{0, 0, 0, 0};
          if (r < 158 && (r >= 30 || s0 > 0)) {
            const bf16_t* zr = z + (size_t)(t0 - 30 + r) * INC + ch0;
            vv[p] = *(const uint4*)zr;
            gg[p] = *(const uint4*)(zr + 384);
          }
        }
#pragma unroll
        for (int p = 0; p < 5; ++p) {
          const int r = r8 + 32 * p;
          if (r < 158) {
            float a[8], g[8];
            unpack8(vv[p], a); unpack8(gg[p], g);
            float4 o0, o1;
            o0.x = a[0] * sigmoidf_(g[0]); o0.y = a[1] * sigmoidf_(g[1]); o0.z = a[2] * sigmoidf_(g[2]); o0.w = a[3] * sigmoidf_(g[3]);
            o1.x = a[4] * sigmoidf_(g[4]); o1.y = a[5] * sigmoidf_(g[5]); o1.z = a[6] * sigmoidf_(g[6]); o1.w = a[7] * sigmoidf_(g[7]);
            *(float4*)(fs + r * 64 + c8 * 8) = o0;
            *(float4*)(fs + r * 64 + c8 * 8 + 4) = o1;
          }
        }
      }
      const int ch = part * 64 + lane;
      float wk[31];
#pragma unroll
      for (int k = 0; k < 31; ++k) wk[k] = conv_a_w[k * 384 + ch];
      const float cb = conv_a_b[ch], lg = ln_a_g[ch], lb = ln_a_b[ch];
      __syncthreads();
      for (int g4 = 0; g4 < 8; ++g4) {
        const int tl = wid * 32 + g4 * 4;
        float yv[34];
#pragma unroll
        for (int k = 0; k < 34; ++k) yv[k] = fs[(tl + k) * 64 + lane];
#pragma unroll
        for (int q = 0; q < 4; ++q) {
          float a = cb;
#pragma unroll
          for (int k = 0; k < 31; ++k) a += wk[k] * yv[q + k];
          float mean = wave_sum(a) * (1.0f / 64);
          float d = a - mean;
          float var = wave_sum(d * d) * (1.0f / 64);
          float yn = d * __builtin_amdgcn_rsqf(var + EPS) * lg + lb;
          float o = yn * sigmoidf_(yn);
          y[(size_t)(t0 + tl + q) * D + ch] = f2bf(o);
        }
      }
      __syncthreads();
    } else if (part < 10) {
      const int cbn = (part - 6) * 64 + c8 * 8;
      float w0[8], w1[8], w2[8];
#pragma unroll
      for (int i = 0; i < 8; ++i) { w0[i] = conv_b_w[cbn + i]; w1[i] = conv_b_w[256 + cbn + i]; w2[i] = conv_b_w[512 + cbn + i]; }
      const int tl0 = r8 * 4;
      uint4 cgv[6], xbv[6], bgv[4];
#pragma unroll
      for (int k = 0; k < 6; ++k) {
        cgv[k] = uint4{0, 0, 0, 0}; xbv[k] = uint4{0, 0, 0, 0};
        if (k >= 2 || (s0 + tl0) > 0) {
          const bf16_t* zr = z + (size_t)(t0 + tl0 - 2 + k) * INC + cbn;
          cgv[k] = *(const uint4*)(zr + 1024);
          xbv[k] = *(const uint4*)(zr + 1280);
        }
      }
#pragma unroll
      for (int k = 0; k < 4; ++k) bgv[k] = *(const uint4*)(z + (size_t)(t0 + tl0 + k) * INC + 768 + cbn);
      float pr[6][8];
#pragma unroll
      for (int k = 0; k < 6; ++k) {
        float a[8], b[8];
        unpack8(cgv[k], a); unpack8(xbv[k], b);
#pragma unroll
        for (int i = 0; i < 8; ++i) pr[k][i] = a[i] * b[i];
      }
#pragma unroll
      for (int k = 0; k < 4; ++k) {
        float bg[8], o[8];
        unpack8(bgv[k], bg);
#pragma unroll
        for (int i = 0; i < 8; ++i) o[i] = bg[i] * (w0[i] * pr[k][i] + w1[i] * pr[k + 1][i] + w2[i] * pr[k + 2][i]);
        uint4 pk; pk.x = pack2(o[0], o[1]); pk.y = pack2(o[2], o[3]); pk.z = pack2(o[4], o[5]); pk.w = pack2(o[6], o[7]);
        *(uint4*)(y + (size_t)(t0 + tl0 + k) * D + 384 + cbn) = pk;
      }
    } else {
      const int hc = part - 10;
      const int ch0 = hc * 64 + c8 * 8;
      bf16_t* vnT = (bf16_t*)smem;
      {
        float lg[8], lb[8];
#pragma unroll
        for (int i = 0; i < 8; ++i) { lg[i] = ln_c_g[ch0 + i]; lb[i] = ln_c_b[ch0 + i]; }
        uint4 vv[4];
#pragma unroll
        for (int p = 0; p < 4; ++p) vv[p] = *(const uint4*)(z + (size_t)(t0 + r8 + 32 * p) * INC + 1920 + ch0);
#pragma unroll
        for (int p = 0; p < 4; ++p) {
          float v[8];
          unpack8(vv[p], v);
          float sm = ((v[0] + v[1]) + (v[2] + v[3])) + ((v[4] + v[5]) + (v[6] + v[7]));
          float mean = group8_sum(sm) * (1.0f / 64);
          float sq = 0.f;
#pragma unroll
          for (int i = 0; i < 8; ++i) { v[i] -= mean; sq += v[i] * v[i]; }
          float rstd = __builtin_amdgcn_rsqf(group8_sum(sq) * (1.0f / 64) + EPS);
          const int r = r8 + 32 * p;
#pragma unroll
          for (int i = 0; i < 8; ++i) vnT[(c8 * 8 + i) * 136 + r] = f2bf(v[i] * rstd * lg[i] + lb[i]);
        }
      }
      __syncthreads();
      const int fr = lane & 15, fq = lane >> 4;
      const bf16_t* wsh = wsb + (size_t)hc * 128 * 128;
      f32x4 acc[4][2];
#pragma unroll
      for (int mi = 0; mi < 4; ++mi)
#pragma unroll
        for (int ni = 0; ni < 2; ++ni) acc[mi][ni] = f32x4{0.f, 0.f, 0.f, 0.f};
      const int nkk = (wid < 2) ? 2 : 4;
      for (int kk = 0; kk < nkk; ++kk) {
        bf16x8 af[4], bf_[2];
#pragma unroll
        for (int ni = 0; ni < 2; ++ni) bf_[ni] = *(const bf16x8*)(wsh + (size_t)(wid * 32 + ni * 16 + fr) * 128 + kk * 32 + fq * 8);
#pragma unroll
        for (int mi = 0; mi < 4; ++mi) af[mi] = *(const bf16x8*)(vnT + (mi * 16 + fr) * 136 + kk * 32 + fq * 8);
#pragma unroll
        for (int mi = 0; mi < 4; ++mi)
#pragma unroll
          for (int ni = 0; ni < 2; ++ni)
            acc[mi][ni] = __builtin_amdgcn_mfma_f32_16x16x32_bf16(af[mi], bf_[ni], acc[mi][ni], 0, 0, 0);
      }
#pragma unroll
      for (int ni = 0; ni < 2; ++ni) {
        const int i = wid * 32 + ni * 16 + fr;
        const float bsv = b_s[hc * 128 + i];
#pragma unroll
        for (int mi = 0; mi < 4; ++mi) {
          const int chb = hc * 64 + mi * 16 + fq * 4;
          uint2 uu = *(const uint2*)(z + (size_t)(t0 + i) * INC + 1536 + chb);
          uint2 pk;
          pk.x = pack2(bflo(uu.x) * (acc[mi][ni][0] + bsv), bfhi(uu.x) * (acc[mi][ni][1] + bsv));
          pk.y = pack2(bflo(uu.y) * (acc[mi][ni][2] + bsv), bfhi(uu.y) * (acc[mi][ni][3] + bsv));
          *(uint2*)(y + (size_t)(t0 + i) * D + 640 + chb) = pk;
        }
      }
      __syncthreads();
    }
  }
}

__device__ __forceinline__ void ins16(float (&lv)[16], float v) {
#pragma unroll
  for (int i = 0; i < 16; ++i) {
    float t = fmaxf(lv[i], v);
    v = fminf(lv[i], v);
    lv[i] = t;
  }
}

__device__ __forceinline__ void bitonic_sort16_desc(float (&v)[16]) {
#pragma unroll
  for (int k = 2; k <= 16; k <<= 1) {
#pragma unroll
    for (int j = k >> 1; j > 0; j >>= 1) {
#pragma unroll
      for (int i = 0; i < 16; ++i) {
        const int l = i ^ j;
        if (l > i) {
          const bool desc = ((i & k) == 0);
          const float hi = fmaxf(v[i], v[l]), lo = fminf(v[i], v[l]);
          v[i] = desc ? hi : lo; v[l] = desc ? lo : hi;
        }
      }
    }
  }
}
__device__ __forceinline__ void merge_top16(float (&a)[16], const float (&b)[16]) {
#pragma unroll
  for (int i = 0; i < 16; ++i) a[i] = fmaxf(a[i], b[15 - i]);
#pragma unroll
  for (int j = 8; j > 0; j >>= 1) {
#pragma unroll
    for (int i = 0; i < 16; ++i) {
      const int l = i ^ j;
      if (l > i) {
        const float hi = fmaxf(a[i], a[l]), lo = fminf(a[i], a[l]);
        a[i] = hi; a[l] = lo;
      }
    }
  }
}
__device__ __forceinline__ void phase_scores(const int TIDX, const int BIDX, const bf16_t* __restrict__ q, const bf16_t* __restrict__ keys  ,
                             int* __restrict__ idxo, float* __restrict__ gateo, char* smem) {
  const int tid = TIDX, lane = tid & 63, wid = tid >> 6;
  const int wr = wid >> 1, wc = wid & 1, fr = lane & 15, fq = lane >> 4;
  float* sT = (float*)smem;
  unsigned* slot = (unsigned*)smem;
  const int m = tid & 127, part = (tid >> 7) ^ ((BIDX >= (int)gridDim.x) ? 1 : 0);
  u32x4_k pra[4], prb[4];
  if (BIDX < 512 * 8) gemm_kloop_issue(tid, q + (size_t)(BIDX >> 3) * 128 * 2048 + (BIDX & 7) * 256, 2048, keys + (size_t)((BIDX & 7) * 2) * 128 * 128, 128, pra, prb);
  const int vstep = VGRID;
  for (int item = BIDX; item < 512 * 8; item += vstep) {
    const int tt = item >> 3, hd = item & 7;
    int tid_i = tid;
    asm volatile("" : "+v"(tid_i));
    float v1[16], v2[16];
#pragma unroll
    for (int half = 0; half < 2; ++half) {
      f32x4 acc[4][4];
      gemm_kloop(tid_i, BIDX, q + (size_t)tt * 128 * 2048 + hd * 256 + half * 128, 2048,
                 keys + (size_t)(hd * 2 + half) * 128 * 128, 128, 128, smem, acc, pra, prb);
      if (half == 0) {
        gemm_kloop_issue(tid_i, q + (size_t)tt * 128 * 2048 + hd * 256 + 128, 2048, keys + (size_t)(hd * 2 + 1) * 128 * 128, 128, pra, prb);
      } else if (item + vstep < 512 * 8) {
        const int ni = item + vstep;
        gemm_kloop_issue(tid_i, q + (size_t)(ni >> 3) * 128 * 2048 + (ni & 7) * 256, 2048, keys + (size_t)((ni & 7) * 2) * 128 * 128, 128, pra, prb);
      }
      float* sbase = sT + (wc * 64 + fq * 4) * 128 + wr * 64 + fr;
      float* sb_e = sbase + (fq & 1) * 16;
      float* sb_o = sbase - (fq & 1) * 16;
#pragma unroll
      for (int mi = 0; mi < 4; ++mi)
#pragma unroll
        for (int ni = 0; ni < 4; ++ni)
#pragma unroll
          for (int j = 0; j < 4; ++j)
            ((mi & 1) ? sb_o : sb_e)[ni * 2048 + j * 128 + mi * 16] = acc[mi][ni][j];
      __syncthreads();
      float lv[16];
#pragma unroll
      for (int c = 0; c < 4; ++c) {
        float ck[16];
        int pb = part * 64;
        asm volatile("" : "+v"(pb));
        const float* srow = sT + pb * 128 + m;
        const float* srow_x = sT + pb * 128 + (m ^ 16);
#pragma unroll
        for (int i = 0; i < 16; ++i) {
          const int key = pb + c * 16 + i;
          ck[i] = __uint_as_float((__float_as_uint((((i >> 2) & 1) ? srow_x : srow)[(c * 16 + i) * 128]) & 0xffffff80u) | (unsigned)key);
        }
        bitonic_sort16_desc(ck);
        if (c == 0) {
#pragma unroll
          for (int i = 0; i < 16; ++i) lv[i] = ck[i];
        } else {
          merge_top16(lv, ck);
        }
        __builtin_amdgcn_sched_barrier(0);
      }
      __syncthreads();
      if (part == 1) {
#pragma unroll
        for (int i = 0; i < 16; ++i) sT[i * 128 + m] = lv[i];
      }
      __syncthreads();
      if (part == 0) {
        float ob[16];
#pragma unroll
        for (int i = 0; i < 16; ++i) ob[i] = sT[i * 128 + m];
        merge_top16(lv, ob);
      }
      __syncthreads();
      if (half == 0) {
#pragma unroll
        for (int i = 0; i < 16; ++i) v1[i] = lv[i];
      } else {
#pragma unroll
        for (int i = 0; i < 16; ++i) v2[i] = lv[i];
      }
    }
    if (part == 0) {
#pragma unroll
      for (int i = 0; i < 16; ++i) {
        slot[m * 33 + i] = __float_as_uint(v1[i]);
        slot[m * 33 + 16 + i] = __float_as_uint(v2[i]);
      }
      float fv[16];
#pragma unroll
      for (int i = 0; i < 16; ++i) fv[i] = -3.0e38f;
#pragma unroll
      for (int a = 0; a < 16; ++a)
#pragma unroll
        for (int b = 0; b < 16; ++b)
          if ((a + 1) * (b + 1) <= 16) {
            float sum = __uint_as_float(__float_as_uint(v1[a]) & 0xffffff80u) + __uint_as_float(__float_as_uint(v2[b]) & 0xffffff80u);
            unsigned u = (__float_as_uint(sum) & 0xffffff00u) | (unsigned)(a * 16 + b);
            ins16(fv, __uint_as_float(u));
          }
      float e[16];
      int ex[16];
      float mx = __uint_as_float(__float_as_uint(fv[0]) & 0xffffff00u), sum = 0.f;
#pragma unroll
      for (int i = 0; i < 16; ++i) {
        unsigned u = __float_as_uint(fv[i]);
        int code = (int)(u & 0xffu);
        float val = __uint_as_float(u & 0xffffff00u);
        int k1 = (int)(slot[m * 33 + (code >> 4)] & 127u);
        int k2 = (int)(slot[m * 33 + 16 + (code & 15)] & 127u);
        ex[i] = k1 * 128 + k2;
        e[i] = __expf(val - mx);
        sum += e[i];
      }
      float inv = __builtin_amdgcn_rcpf(sum);
      size_t o = (size_t)(tt * 128 + m) * 128 + hd * 16;
#pragma unroll
      for (int i = 0; i < 16; i += 4) {
        *(int4*)(idxo + o + i) = int4{ex[i], ex[i + 1], ex[i + 2], ex[i + 3]};
        *(float4*)(gateo + o + i) = float4{e[i] * inv, e[i + 1] * inv, e[i + 2] * inv, e[i + 3] * inv};
      }
    }
    __syncthreads();
  }
}

__device__ __forceinline__ void peer_issue(uint4 (&buf)[8], const unsigned char* __restrict__ tab, int idv, int gp, int lane) {
#pragma unroll
  for (int e = 0; e < 8; ++e) {
    const unsigned ex = (unsigned)__builtin_amdgcn_readlane(idv, 8 * e + gp);
    const unsigned char* rowp = tab + ((size_t)ex << 10);
    buf[e] = *(const uint4*)(rowp + (unsigned)(lane << 4));
  }
}
__device__ __forceinline__ float peer_dot(const uint4& r, const f32x2 (&x2)[8]) {
  f32x2 a0 = __builtin_amdgcn_cvt_pk_f32_fp8((int)r.x, false) * x2[0];
  f32x2 a1 = __builtin_amdgcn_cvt_pk_f32_fp8((int)r.x, true) * x2[1];
  a0 += __builtin_amdgcn_cvt_pk_f32_fp8((int)r.y, false) * x2[2];
  a1 += __builtin_amdgcn_cvt_pk_f32_fp8((int)r.y, true) * x2[3];
  a0 += __builtin_amdgcn_cvt_pk_f32_fp8((int)r.z, false) * x2[4];
  a1 += __builtin_amdgcn_cvt_pk_f32_fp8((int)r.z, true) * x2[5];
  a0 += __builtin_amdgcn_cvt_pk_f32_fp8((int)r.w, false) * x2[6];
  a1 += __builtin_amdgcn_cvt_pk_f32_fp8((int)r.w, true) * x2[7];
  a0 += a1;
  return a0.x + a0.y;
}
__device__ __forceinline__ void fmac1(float& o, float a, float x) { asm("v_fmac_f32 %0, %1, %2" : "+v"(o) : "v"(a), "v"(x)); }
__device__ __forceinline__ void peer_axpy(const uint4& r, float a, float (&o)[16]) {
  f32x2 c;
  c = __builtin_amdgcn_cvt_pk_f32_fp8((int)r.x, false); fmac1(o[0], a, c.x); fmac1(o[1], a, c.y);
  c = __builtin_amdgcn_cvt_pk_f32_fp8((int)r.x, true);  fmac1(o[2], a, c.x); fmac1(o[3], a, c.y);
  c = __builtin_amdgcn_cvt_pk_f32_fp8((int)r.y, false); fmac1(o[4], a, c.x); fmac1(o[5], a, c.y);
  c = __builtin_amdgcn_cvt_pk_f32_fp8((int)r.y, true);  fmac1(o[6], a, c.x); fmac1(o[7], a, c.y);
  c = __builtin_amdgcn_cvt_pk_f32_fp8((int)r.z, false); fmac1(o[8], a, c.x); fmac1(o[9], a, c.y);
  c = __builtin_amdgcn_cvt_pk_f32_fp8((int)r.z, true);  fmac1(o[10], a, c.x); fmac1(o[11], a, c.y);
  c = __builtin_amdgcn_cvt_pk_f32_fp8((int)r.w, false); fmac1(o[12], a, c.x); fmac1(o[13], a, c.y);
  c = __builtin_amdgcn_cvt_pk_f32_fp8((int)r.w, true);  fmac1(o[14], a, c.x); fmac1(o[15], a, c.y);
}
__device__ __forceinline__ float reduce8(float (&p)[8], int lane) {
  float q[4];
#pragma unroll
  for (int j = 0; j < 4; ++j) {
    auto r = __builtin_amdgcn_permlane32_swap(__float_as_uint(p[j]), __float_as_uint(p[j + 4]), false, false);
    q[j] = __uint_as_float(r[0]) + __uint_as_float(r[1]);
  }
  float s2[2];
#pragma unroll
  for (int j = 0; j < 2; ++j) {
    auto r = __builtin_amdgcn_permlane16_swap(__float_as_uint(q[j]), __float_as_uint(q[j + 2]), false, false);
    s2[j] = __uint_as_float(r[0]) + __uint_as_float(r[1]);
  }
  const bool b3 = (lane & 8) != 0;
  float keep = b3 ? s2[1] : s2[0];
  float give = b3 ? s2[0] : s2[1];
  float w = keep + dpp_f<0x128>(give);
  w += dpp_f<0xB1>(w);
  w += dpp_f<0x4E>(w);
  w += dpp_f<0x141>(w);
  return w;
}

__device__ __forceinline__ void phase_peer_u(const int TIDX, const int BIDX, const unsigned char* __restrict__ Eu,
                                             const int* __restrict__ idx, const bf16_t* __restrict__ h16, const float* __restrict__ gffn, float* __restrict__ pd, char* smem) {
  const int lane = TIDX & 63, wid = TIDX >> 6;
  const int x = BIDX & 7;
  int nWs = (VGRID >> 3) * 4;
  asm volatile("" : "+s"(nWs));
  const int wslot = __builtin_amdgcn_readfirstlane((BIDX >> 3) * 4 + wid);
  const int g8 = lane >> 3, c8 = lane & 7;
  const int fr = lane & 15, fq = lane >> 4;
  const unsigned char* tabc = Eu + (size_t)x * ((size_t)NEXP * 128) + (unsigned)(c8 * 16);
  const unsigned colq = (unsigned)(x * 128 + fq * 16);
  typedef __attribute__((address_space(3))) char lds_char;
  typedef unsigned u32x4_t __attribute__((ext_vector_type(4)));
  typedef __attribute__((address_space(3))) u32x4_t lds_uint4;
  lds_char* lw = (lds_char*)smem + wid * 9216;
  const int woff = g8 * 144 + c8 * 16;
  const int roff = fr * 144 + fq * 16;
  int t = wslot;
  if (t >= T) return;
  int idn[16];
  u32x4_t r[16];
  float gq8[32];
#pragma unroll
  for (int i = 0; i < 16; ++i) { gq8[i] = gffn[colq + i] * 8.0f; gq8[16 + i] = gffn[colq + 64 + i] * 8.0f; }
  typedef __attribute__((address_space(3))) int lds_i;
  typedef __attribute__((address_space(3))) unsigned lds_u;
  lds_i* li = (lds_i*)((lds_char*)smem + 36864 + wid * 1024);
  lds_u* lh = (lds_u*)((lds_char*)smem + 36864 + wid * 1024 + 512);
  int ri0 = idx[(size_t)t * 128 + lane], ri1 = idx[(size_t)t * 128 + 64 + lane];
  unsigned rh = *(const unsigned*)(h16 + (size_t)t * D + x * 128 + 2 * lane);
  li[lane] = ri0; li[64 + lane] = ri1;
  __builtin_amdgcn_wave_barrier();
#pragma unroll
  for (int j = 0; j < 16; ++j) idn[j] = li[8 * j + g8];
#pragma unroll
  for (int j = 0; j < 16; ++j) r[j] = *(const u32x4_t*)(tabc + ((size_t)(unsigned)idn[j] << 7));
  __builtin_amdgcn_wave_barrier();
  if (t + nWs < T) { ri0 = idx[(size_t)(t + nWs) * 128 + lane]; ri1 = idx[(size_t)(t + nWs) * 128 + 64 + lane]; }
  for (; t < T; t += nWs) {
    const int tn = t + nWs, tnn = t + 2 * nWs;
    const bool hasn = tn < T;
    li[lane] = ri0; li[64 + lane] = ri1;
    lh[lane] = rh;
    __builtin_amdgcn_wave_barrier();
#pragma unroll
    for (int j = 0; j < 16; ++j) idn[j] = li[8 * j + g8];
    u32x4_t nc[4];
    nc[0] = *(const lds_uint4*)(lh + fq * 8); nc[1] = *(const lds_uint4*)(lh + fq * 8 + 4);
    nc[2] = *(const lds_uint4*)(lh + 32 + fq * 8); nc[3] = *(const lds_uint4*)(lh + 32 + fq * 8 + 4);
    __builtin_amdgcn_wave_barrier();
    if (hasn) rh = *(const unsigned*)(h16 + (size_t)tn * D + x * 128 + 2 * lane);
    if (tnn < T) { ri0 = idx[(size_t)tnn * 128 + lane]; ri1 = idx[(size_t)tnn * 128 + 64 + lane]; }
    long b8[4];
#pragma unroll
    for (int hh = 0; hh < 2; ++hh) {
      float fv[16];
      const u32x4_t ua = nc[2 * hh], ub = nc[2 * hh + 1];
      fv[0] = bflo(ua.x); fv[1] = bfhi(ua.x); fv[2] = bflo(ua.y); fv[3] = bfhi(ua.y);
      fv[4] = bflo(ua.z); fv[5] = bfhi(ua.z); fv[6] = bflo(ua.w); fv[7] = bfhi(ua.w);
      fv[8] = bflo(ub.x); fv[9] = bfhi(ub.x); fv[10] = bflo(ub.y); fv[11] = bfhi(ub.y);
      fv[12] = bflo(ub.z); fv[13] = bfhi(ub.z); fv[14] = bflo(ub.w); fv[15] = bfhi(ub.w);
      unsigned w[4];
#pragma unroll
      for (int i = 0; i < 4; ++i) {
        int t8 = __builtin_amdgcn_cvt_pk_fp8_f32(fv[4 * i] * gq8[16 * hh + 4 * i], fv[4 * i + 1] * gq8[16 * hh + 4 * i + 1], 0, false);
        t8 = __builtin_amdgcn_cvt_pk_fp8_f32(fv[4 * i + 2] * gq8[16 * hh + 4 * i + 2], fv[4 * i + 3] * gq8[16 * hh + 4 * i + 3], t8, true);
        w[i] = (unsigned)t8;
      }
      b8[2 * hh] = (long)(((unsigned long)w[1] << 32) | w[0]);
      b8[2 * hh + 1] = (long)(((unsigned long)w[3] << 32) | w[2]);
    }
    f32x4 accs[8];
    __builtin_amdgcn_sched_barrier(0);
#define U_QUARTER(q) { \
      lds_char* lb = lw + ((q) & 1) * 4608; \
      *(lds_uint4*)(lb + woff + 0 * 8 * 144) = r[(q) * 4 + 0]; \
      if (hasn) r[(q) * 4 + 0] = *(const u32x4_t*)(tabc + ((size_t)(unsigned)idn[(q) * 4 + 0] << 7)); \
      *(lds_uint4*)(lb + woff + 1 * 8 * 144) = r[(q) * 4 + 1]; \
      if (hasn) r[(q) * 4 + 1] = *(const u32x4_t*)(tabc + ((size_t)(unsigned)idn[(q) * 4 + 1] << 7)); \
      *(lds_uint4*)(lb + woff + 2 * 8 * 144) = r[(q) * 4 + 2]; \
      if (hasn) r[(q) * 4 + 2] = *(const u32x4_t*)(tabc + ((size_t)(unsigned)idn[(q) * 4 + 2] << 7)); \
      *(lds_uint4*)(lb + woff + 3 * 8 * 144) = r[(q) * 4 + 3]; \
      if (hasn) r[(q) * 4 + 3] = *(const u32x4_t*)(tabc + ((size_t)(unsigned)idn[(q) * 4 + 3] << 7)); \
      _Pragma("unroll") for (int eg = 0; eg < 2; ++eg) { \
        const u32x4_t a0 = *(const lds_uint4*)(lb + roff + eg * 16 * 144); \
        const u32x4_t a1 = *(const lds_uint4*)(lb + roff + eg * 16 * 144 + 64); \
        f32x4 acc = f32x4{0.f, 0.f, 0.f, 0.f}; \
        acc = __builtin_amdgcn_mfma_f32_16x16x32_fp8_fp8((long)(((unsigned long)a0.y << 32) | a0.x), b8[0], acc, 0, 0, 0); \
        acc = __builtin_amdgcn_mfma_f32_16x16x32_fp8_fp8((long)(((unsigned long)a0.w << 32) | a0.z), b8[1], acc, 0, 0, 0); \
        acc = __builtin_amdgcn_mfma_f32_16x16x32_fp8_fp8((long)(((unsigned long)a1.y << 32) | a1.x), b8[2], acc, 0, 0, 0); \
        acc = __builtin_amdgcn_mfma_f32_16x16x32_fp8_fp8((long)(((unsigned long)a1.w << 32) | a1.z), b8[3], acc, 0, 0, 0); \
        accs[(q) * 2 + eg] = acc; \
      } \
      __builtin_amdgcn_sched_barrier(0); }
    U_QUARTER(0) U_QUARTER(1) U_QUARTER(2) U_QUARTER(3)
#undef U_QUARTER
    {
      f32x4 sel = accs[0];
#pragma unroll
      for (int k = 1; k < 8; ++k) sel = (fr == k) ? accs[k] : sel;
      if (fr < 8) { uint2 pk; pk.x = pack2(sel[0], sel[1]); pk.y = pack2(sel[2], sel[3]);
        *(uint2*)((bf16_t*)pd + ((size_t)x * T + t) * 128 + fr * 16 + fq * 4) = pk; }
    }
  }
}

__device__ __forceinline__ void phase_peer_act(const int TIDX, const int BIDX, const float* __restrict__ pd, const int* __restrict__ idx,
                                               const float* __restrict__ gate, const float* __restrict__ su, const float* __restrict__ sv,
                                               const float* __restrict__ ssq, float* __restrict__ act) {
  const size_t gtid = (size_t)BIDX * 256 + TIDX, gsz = (size_t)VGRID * 256;
  constexpr size_t N8 = (size_t)T * 16;
  for (size_t u8 = gtid; u8 < N8; u8 += gsz) {
    uint4 p[8];
#pragma unroll
    for (int x = 0; x < 8; ++x) p[x] = ((const uint4*)((const bf16_t*)pd + (size_t)x * T * 128))[u8];
    const int4 e0 = ((const int4*)idx)[2 * u8], e1 = ((const int4*)idx)[2 * u8 + 1];
    const float4 g0 = ((const float4*)gate)[2 * u8], g1 = ((const float4*)gate)[2 * u8 + 1];
    float suv[8], svv[8];
    suv[0] = su[e0.x]; suv[1] = su[e0.y]; suv[2] = su[e0.z]; suv[3] = su[e0.w];
    suv[4] = su[e1.x]; suv[5] = su[e1.y]; suv[6] = su[e1.z]; suv[7] = su[e1.w];
    svv[0] = sv[e0.x]; svv[1] = sv[e0.y]; svv[2] = sv[e0.z]; svv[3] = sv[e0.w];
    svv[4] = sv[e1.x]; svv[5] = sv[e1.y]; svv[6] = sv[e1.z]; svv[7] = sv[e1.w];
    const float rsq = __builtin_amdgcn_rsqf(ssq[u8 >> 4] * (1.0f / D) + EPS) * 0.125f;
    float d[8];
#pragma unroll
    for (int i = 0; i < 8; ++i) d[i] = 0.f;
#pragma unroll
    for (int x = 0; x < 8; ++x) {
      d[0] += bflo(p[x].x); d[1] += bfhi(p[x].x); d[2] += bflo(p[x].y); d[3] += bfhi(p[x].y);
      d[4] += bflo(p[x].z); d[5] += bfhi(p[x].z); d[6] += bflo(p[x].w); d[7] += bfhi(p[x].w);
    }
    const float gv[8] = {g0.x, g0.y, g0.z, g0.w, g1.x, g1.y, g1.z, g1.w};
    float o[8];
#pragma unroll
    for (int i = 0; i < 8; ++i) o[i] = gelu_tanh(d[i] * suv[i] * rsq) * gv[i] * svv[i];
    ((float4*)act)[2 * u8] = float4{o[0], o[1], o[2], o[3]};
    ((float4*)act)[2 * u8 + 1] = float4{o[4], o[5], o[6], o[7]};
  }
}

__device__ __forceinline__ void phase_peer_v(const int TIDX, const int BIDX, const unsigned char* __restrict__ Ev,
                                             const int* __restrict__ idx, const float* __restrict__ act, bf16_t* h, bf16_t* a3,
                                             float* __restrict__ ssq, char* smem) {
  const int lane = TIDX & 63, wid = TIDX >> 6;
  const int x = BIDX & 7;
  int nWs = (VGRID >> 3) * 4;
  asm volatile("" : "+s"(nWs));
  const int wslot = __builtin_amdgcn_readfirstlane((BIDX >> 3) * 4 + wid);
  const int g = lane >> 3, c8 = lane & 7;
  const unsigned char* tabc = Ev + (size_t)x * ((size_t)NEXP * 128) + (unsigned)(c8 * 16);
  typedef __attribute__((address_space(3))) int lds_i;
  typedef __attribute__((address_space(3))) float lds_f;
  typedef int i32x4_t __attribute__((ext_vector_type(4)));
  typedef float f32x4_t __attribute__((ext_vector_type(4)));
  typedef __attribute__((address_space(3))) i32x4_t lds_i4;
  typedef __attribute__((address_space(3))) f32x4_t lds_f4;
  lds_i* li = (lds_i*)((__attribute__((address_space(3))) char*)smem + wid * 1024);
  lds_f* lf = (lds_f*)((__attribute__((address_space(3))) char*)smem + wid * 1024 + 512);
  int t = wslot;
  if (t >= T) return;
  typedef unsigned u32x4_t __attribute__((ext_vector_type(4)));
  u32x4_t r[16];
  i32x4_t idn[4];
  f32x4_t ac[4];
  int ri0 = idx[(size_t)t * 128 + lane], ri1 = idx[(size_t)t * 128 + 64 + lane];
  float ra0 = act[(size_t)t * 128 + lane], ra1 = act[(size_t)t * 128 + 64 + lane];
  li[lane] = ri0; li[64 + lane] = ri1;
  __builtin_amdgcn_wave_barrier();
#pragma unroll
  for (int q = 0; q < 4; ++q) idn[q] = *(const lds_i4*)(li + g * 16 + q * 4);
#pragma unroll
  for (int j = 0; j < 16; ++j) {
    const unsigned e = (unsigned)idn[j >> 2][j & 3];
    r[j] = *(const u32x4_t*)(tabc + ((size_t)e << 7));
  }
  __builtin_amdgcn_wave_barrier();
  if (t + nWs < T) { ri0 = idx[(size_t)(t + nWs) * 128 + lane]; ri1 = idx[(size_t)(t + nWs) * 128 + 64 + lane]; }
  for (; t < T; t += nWs) {
    const int tn = t + nWs, tnn = t + 2 * nWs;
    const bool hasn = tn < T;
    const int col = x * 128 + c8 * 16 + 2 * g;
    li[lane] = ri0; li[64 + lane] = ri1;
    lf[lane] = ra0; lf[64 + lane] = ra1;
    __builtin_amdgcn_wave_barrier();
#pragma unroll
    for (int q = 0; q < 4; ++q) {
      idn[q] = *(const lds_i4*)(li + g * 16 + q * 4);
      ac[q] = *(const lds_f4*)(lf + g * 16 + q * 4);
    }
    __builtin_amdgcn_wave_barrier();
    const unsigned hp = *(const unsigned*)(h + (size_t)t * D + col);
    float2 hv = float2{bflo(hp), bfhi(hp)};
    if (hasn) { ra0 = act[(size_t)tn * 128 + lane]; ra1 = act[(size_t)tn * 128 + 64 + lane]; }
    if (tnn < T) { ri0 = idx[(size_t)tnn * 128 + lane]; ri1 = idx[(size_t)tnn * 128 + 64 + lane]; }
    __builtin_amdgcn_sched_barrier(0);
    float o[16];
#pragma unroll
    for (int i = 0; i < 16; ++i) o[i] = 0.f;
#pragma unroll
    for (int j = 0; j < 16; ++j) {
      peer_axpy(uint4{r[j].x, r[j].y, r[j].z, r[j].w}, ac[j >> 2][j & 3], o);
      if (hasn) {
        const unsigned e = (unsigned)idn[j >> 2][j & 3];
        r[j] = *(const u32x4_t*)(tabc + ((size_t)e << 7));
      }
      __builtin_amdgcn_sched_barrier(0);
    }
    float q8[8];
#pragma unroll
    for (int i = 0; i < 8; ++i) {
      auto rr = __builtin_amdgcn_permlane32_swap(__float_as_uint(o[i]), __float_as_uint(o[i + 8]), false, false);
      q8[i] = __uint_as_float(rr[0]) + __uint_as_float(rr[1]);
    }
    float s4[4];
#pragma unroll
    for (int i = 0; i < 4; ++i) {
      auto rr = __builtin_amdgcn_permlane16_swap(__float_as_uint(q8[i]), __float_as_uint(q8[i + 4]), false, false);
      s4[i] = __uint_as_float(rr[0]) + __uint_as_float(rr[1]);
    }
    const bool b3 = (lane & 8) != 0;
    float w0 = (b3 ? s4[2] : s4[0]) + dpp_f<0x128>(b3 ? s4[0] : s4[2]);
    float w1 = (b3 ? s4[3] : s4[1]) + dpp_f<0x128>(b3 ? s4[1] : s4[3]);
    hv.x += w0; hv.y += w1;
    float ss = wave_sum(hv.x * hv.x + hv.y * hv.y);
    const unsigned hq = pack2(hv.x, hv.y);
    *(unsigned*)(h + (size_t)t * D + col) = hq;
    *(unsigned*)(a3 + (size_t)t * D + col) = hq;
    if (lane == 0) ssq[(size_t)x * T + t] = ss;
  }
}

#define XB_TMO      128
#define XB_XCNT(j)  (256  + 64 * (j))
#define XB_XSUB(j)  (1280 + 64 * (j))
#define XB_XGEN(j)  (2304 + 64 * (j))
#define XB_TOP      3328
#define XB_TOPGEN   3392
#define XCD_BAR_WORDS 3456
#define XB_SPIN_CAP (1u << 18)
#define LAS __attribute__((address_space(3)))

__device__ __forceinline__ unsigned xb_ld(unsigned* p)              { return __hip_atomic_load(p, __ATOMIC_RELAXED, __HIP_MEMORY_SCOPE_AGENT); }
__device__ __forceinline__ unsigned xb_add(unsigned* p, unsigned v) { return __hip_atomic_fetch_add(p, v, __ATOMIC_RELAXED, __HIP_MEMORY_SCOPE_AGENT); }
__device__ __forceinline__ unsigned xb_xcc_id() { return (unsigned)__builtin_amdgcn_s_getreg((3 << 11) | 20) & 0xFu; }
#define XB_SPIN(cond, bar) do { unsigned _sp = 0; while (cond) { __builtin_amdgcn_s_sleep(1); \
    if ((++_sp & 255u) == 0u) { if (xb_ld(&(bar)[XB_TMO])) break; if (_sp > XB_SPIN_CAP) { atomicAdd(&(bar)[XB_TMO], 1u); break; } } } } while (0)

struct XcdBarrier {
    unsigned* bar; unsigned x;
    volatile LAS unsigned* st;
};

__device__ __forceinline__ XcdBarrier xcd_barrier_post(unsigned* bar, volatile LAS unsigned* st) {
    XcdBarrier b; b.bar = bar; b.x = xb_xcc_id(); b.st = st;
    if (threadIdx.x == 0) (void)xb_add(&bar[XB_XCNT(b.x)], 1u);
    return b;
}
__device__ __forceinline__ void xcd_barrier_complete(unsigned* bar, unsigned x, unsigned& nloc, unsigned& nx) {
    const unsigned G = gridDim.x * gridDim.y * gridDim.z;
    unsigned sum, cnt, mine, sp = 0u;
    for (;;) {
        sum = 0u; cnt = 0u; mine = 0u;
#pragma unroll
        for (unsigned j = 0; j < 16; ++j) { const unsigned c = xb_ld(&bar[XB_XCNT(j)]); sum += c; cnt += (c > 0u) ? 1u : 0u; mine = (j == x) ? c : mine; }
        if (sum == G) break;
        __builtin_amdgcn_s_sleep(1);
        if ((++sp & 255u) == 0u) { if (xb_ld(&bar[XB_TMO])) break; if (sp > XB_SPIN_CAP) { atomicAdd(&bar[XB_TMO], 1u); break; } }
    }
    nloc = mine > 0u ? mine : 1u; nx = cnt > 0u ? cnt : 1u;
}

__device__ __forceinline__ void xcd_barrier(const XcdBarrier& b) {
    asm volatile("s_waitcnt vmcnt(0)" ::: "memory");
    __syncthreads();
    if (threadIdx.x == 0) {
        unsigned* bar = b.bar;
        __builtin_amdgcn_s_waitcnt(0);
        unsigned nloc = b.st[0], nx = b.st[1];
        if (nloc == 0u) { xcd_barrier_complete(bar, b.x, nloc, nx); b.st[0] = nloc; b.st[1] = nx; }
        const unsigned old = xb_add(&bar[XB_XSUB(b.x)], 1u);
        const unsigned gen = old / nloc;
        if (old + 1u == (gen + 1u) * nloc) {
            __builtin_amdgcn_fence(__ATOMIC_RELEASE, "agent");
            asm volatile("s_waitcnt vmcnt(0)" ::: "memory");
            const unsigned og = xb_add(&bar[XB_TOP], 1u);
            const unsigned tg = og / nx;
            if (og + 1u == (tg + 1u) * nx) xb_add(&bar[XB_TOPGEN], 1u);
            else XB_SPIN(xb_ld(&bar[XB_TOPGEN]) == tg, bar);
            __builtin_amdgcn_fence(__ATOMIC_ACQUIRE, "agent");
            xb_add(&bar[XB_XGEN(b.x)], 1u);
            asm volatile("s_waitcnt vmcnt(0)" ::: "memory");
        } else {
            XB_SPIN(xb_ld(&bar[XB_XGEN(b.x)]) == gen, bar);
            __builtin_amdgcn_fence(__ATOMIC_ACQUIRE, "agent");
            asm volatile("s_waitcnt vmcnt(0)" ::: "memory");
        }
    }
    __syncthreads();
}

__device__ __forceinline__ int rebuild_tid(const int wave_id) {
  int lane_id;
  asm volatile("v_mbcnt_lo_u32_b32 %0, -1, 0\n\tv_mbcnt_hi_u32_b32 %0, -1, %0" : "=v"(lane_id));
  return wave_id * 64 + lane_id;
}
__device__ __forceinline__ void run_phase(const int WAVE_ID, const int BL, const Params& P, int ph, char* smem_all) {
  char* ws = P.ws;
  bf16_t* abuf = (bf16_t*)(ws + OFF_ABUF);
  bf16_t* zb = (bf16_t*)(ws + OFF_Z);
  bf16_t* h = (bf16_t*)(ws + OFF_H);
#define VB_PROLOGUE int t2 = rebuild_tid(WAVE_ID); const int TIDX = t2 & 255; const int half_ = __builtin_amdgcn_readfirstlane(t2 >> 8); const int BIDX = BL + half_ * (int)gridDim.x; char* smem = smem_all + half_ * 65536; (void)smem;
  if (ph == 0) { VB_PROLOGUE phase_convert(TIDX, BIDX, P); return; }
  if (ph == NPHASE - 1) { VB_PROLOGUE phase_norm<2, true>(TIDX, BIDX, h, P.in[22], nullptr, P.out); return; }
  const int L = (ph - 1) / 11, s = (ph - 1) % 11;
  const unsigned char* Eu = (const unsigned char*)(ws + OFF_EU) + (size_t)L * NEXP * 1024;
  const unsigned char* Ev = (const unsigned char*)(ws + OFF_EV) + (size_t)L * NEXP * 1024;
  const float* su = (const float*)(ws + OFF_ESC) + L * NEXP;
  const float* sv = (const float*)(ws + OFF_ESC) + (2 + L) * NEXP;
  int* idxb = (int*)(ws + OFF_IDX);
  float* gateb = (float*)(ws + OFF_GATE);
  float* pd = (float*)(ws + OFF_Z);
  float* actb = (float*)(ws + OFF_ACT);
  float* ssq = (float*)(ws + OFF_SSQ);
  float* ssqA = (float*)(ws + OFF_SSQA);
  float* ssqB = (float*)(ws + OFF_SSQB);
  switch (s) {
    case 0: { VB_PROLOGUE phase_norm<0, false>(TIDX, BIDX, P.in[0], nullptr, abuf, nullptr); } break;
    case 1: if (L == 0) run_gemm(rebuild_tid(WAVE_ID), BL, smem_all, abuf, (const bf16_t*)(ws + OFF_WINT), 2304, 1024, pg8::EpiBf16<0>{zb, 2304, nullptr, 0, 0});
            else run_gemm(rebuild_tid(WAVE_ID), BL, smem_all, h, (const bf16_t*)(ws + OFF_WINT) + (size_t)2304 * 1024, 2304, 1024, EpiBf16Rs{zb, 2304, ssqB, WAVE_ID}); break;
    case 2: { VB_PROLOGUE for (int i = BIDX * 256 + TIDX; i < T; i += VGRID * 256) ssqA[i] = 0.f;
      phase_mix(TIDX, BIDX, P, L, zb, abuf, (const bf16_t*)(ws + OFF_WSB) + (size_t)L * 6 * 128 * 128, smem); } break;
    case 3: if (L == 0) run_gemm(rebuild_tid(WAVE_ID), BL, smem_all, abuf, (const bf16_t*)(ws + OFF_WOUTT), 1024, 1024, EpiResid<false>{P.in[0], h, ssqA, WAVE_ID});
            else run_gemm(rebuild_tid(WAVE_ID), BL, smem_all, abuf, (const bf16_t*)(ws + OFF_WOUTT) + (size_t)1024 * 1024, 1024, 1024, EpiResid<true>{h, h, ssqA, WAVE_ID}); break;
    case 4: break;
    case 5: run_gemm(rebuild_tid(WAVE_ID), BL, smem_all, h, (const bf16_t*)(ws + OFF_WQT) + (size_t)L * 2048 * 1024, 2048, 1024, EpiBf16Rs{zb, 2048, ssqA, WAVE_ID}); break;
    case 6: { VB_PROLOGUE
      phase_scores(TIDX, BIDX, zb, (const bf16_t*)(ws + OFF_KEYS) + (size_t)L * 8 * 2 * 128 * 128, idxb, gateb, smem); } break;
    case 7: { VB_PROLOGUE
      phase_peer_u(TIDX, BIDX, Eu, idxb, h, P.in[14] + L * 1024, pd, smem); } break;
    case 8: { VB_PROLOGUE for (int i = BIDX * 256 + TIDX; i < T; i += VGRID * 256) ssqB[i] = 0.f;
      phase_peer_act(TIDX, BIDX, pd, idxb, gateb, su, sv, ssqA, actb); } break;
    case 9: { VB_PROLOGUE phase_peer_v(TIDX, BIDX, Ev, idxb, actb, h, abuf, ssq, smem); } break;
    case 10:
      run_gemm(rebuild_tid(WAVE_ID), BL, smem_all, abuf, (const bf16_t*)(ws + OFF_WPGT) + (size_t)L * 1024 * 1024, 1024, 1024, EpiSig{ssq, zb, WAVE_ID});
      run_gemm(rebuild_tid(WAVE_ID), BL, smem_all, (const bf16_t*)(ws + OFF_PBF) + (size_t)L * T * 256, (const bf16_t*)(ws + OFF_WPET) + (size_t)L * 1024 * 256, 1024, 256, EpiPle{h, zb, ssqB, WAVE_ID});
      break;
  }
}

__global__ void __launch_bounds__(512, 2) peer_trunk_mk(Params P) {
  extern __shared__ __attribute__((aligned(16))) char smem[];
  cg::grid_group grid = cg::this_grid();
  unsigned* bar = (unsigned*)(P.ws + OFF_BAR);
  volatile LAS unsigned* st = (volatile LAS unsigned*)((LAS char*)smem + 131072);
  if (threadIdx.x == 0) { st[0] = 0u; st[1] = 0u; }
  if (blockIdx.x == 0) { for (int i = threadIdx.x; i < XCD_BAR_WORDS; i += 512) bar[i] = 0u; }
  __syncthreads();
  XcdBarrier xb{};
  const int wave_id = __builtin_amdgcn_readfirstlane((int)threadIdx.x >> 6);
  int ph = P.ph_lo;
#ifdef PROBE_DUP
  int dup_left = 1;
#endif
  while (ph < P.ph_hi) {
    int bl = (int)__builtin_amdgcn_workgroup_id_x();
    asm volatile("" : "+s"(bl));
    run_phase(wave_id, bl, P, ph, smem);
    int nph = ph + 1;
    while (nph < NPHASE - 1 && (((nph - 1) % 11) == 4 || nph == 12)) ++nph;
#ifdef PROBE_DUP
    if (ph == 1 + PROBE_DUP && dup_left) { dup_left = 0; nph = ph; }
#endif
    if (nph < P.ph_hi) {
      if (ph == 0) { grid.sync(); xb = xcd_barrier_post(bar, st); }
      else xcd_barrier(xb);
    }
    ph = nph;
  }
}

extern "C" void kernel_launch(void* const* d_in, const int* in_sizes, int n_in, void* d_out, int out_size,
                              void* d_ws, size_t ws_size, hipStream_t stream) {
  static int grid_blocks = 0;
  if (grid_blocks == 0) {
    if (n_in != 23 || ws_size < WS_END) { fprintf(stderr, "kernel_launch: unexpected n_in %d or ws_size %zu (< %zu)\n", n_in, ws_size, (size_t)WS_END); grid_blocks = -1; return; }
    int dev = 0, cus = 0, per_cu = 0;
    hipGetDevice(&dev);
    hipDeviceGetAttribute(&cus, hipDeviceAttributeMultiprocessorCount, dev);
    hipFuncSetAttribute((const void*)peer_trunk_mk, hipFuncAttributeMaxDynamicSharedMemorySize, SMEM_BYTES);
    hipOccupancyMaxActiveBlocksPerMultiprocessor(&per_cu, (const void*)peer_trunk_mk, 512, SMEM_BYTES);
    if (per_cu < 1) per_cu = 1;
    if (per_cu > 1) per_cu = 1;
    grid_blocks = cus * per_cu;
    fprintf(stderr, "kernel_launch: cus %d per_cu %d grid %d\n", cus, per_cu, grid_blocks);
  }
  if (grid_blocks < 0) return;
  Params P{};
  for (int i = 0; i < 23; ++i) P.in[i] = (const float*)d_in[i];
  P.out = (float*)d_out;
  P.ws = (char*)d_ws;
#if ONE_LAUNCH
  P.ph_lo = 0; P.ph_hi = NPHASE;
  void* args[] = {&P};
  hipError_t e = hipLaunchCooperativeKernel((void*)peer_trunk_mk, dim3(grid_blocks), dim3(512), args, SMEM_BYTES, stream);
  if (e != hipSuccess) fprintf(stderr, "cooperative launch failed: %s (grid %d)\n", hipGetErrorString(e), grid_blocks);
#else
  for (int ph = 0; ph < NPHASE; ++ph) {
    P.ph_lo = ph; P.ph_hi = ph + 1;
    hipLaunchKernelGGL(peer_trunk_mk, dim3(grid_blocks), dim3(512), SMEM_BYTES, stream, P);
  }
#endif
}
```

```cpp
#include <hip/hip_runtime.h>
#include <hip/hip_bf16.h>
#include <hip/hip_cooperative_groups.h>
#include <cstdio>
namespace cg = cooperative_groups;

#ifndef ONE_LAUNCH
#define ONE_LAUNCH 1
#endif

typedef unsigned short bf16_t;
using bf16x8 = __attribute__((ext_vector_type(8))) short;
using f32x4 = __attribute__((ext_vector_type(4))) float;

constexpr int T = 65536;
constexpr int D = 1024;
constexpr int SEQ = 8192;
constexpr int INC = 2304;
constexpr int NEXP = 16384;
constexpr float EPS = 1e-6f;
constexpr int SMEM_BYTES = 131072 + 16;
__device__ __forceinline__ int launder_s(int x) { asm volatile("" : "+s"(x)); return x; }
#define VGRID (launder_s((int)gridDim.x * 2))
constexpr int NPHASE = 24;

constexpr size_t OFF_WINT = 0;
constexpr size_t OFF_WOUTT = OFF_WINT + (size_t)2 * 2304 * 1024 * 2;
constexpr size_t OFF_WQT = OFF_WOUTT + (size_t)2 * 1024 * 1024 * 2;
constexpr size_t OFF_WPGT = OFF_WQT + (size_t)2 * 2048 * 1024 * 2;
constexpr size_t OFF_WPET = OFF_WPGT + (size_t)2 * 1024 * 1024 * 2;
constexpr size_t OFF_KEYS = OFF_WPET + (size_t)2 * 1024 * 256 * 2;
constexpr size_t OFF_EU = OFF_KEYS + (size_t)2 * 8 * 2 * 128 * 128 * 2;
constexpr size_t OFF_EV = OFF_EU + (size_t)2 * NEXP * 1024;
constexpr size_t OFF_ESC = OFF_EV + (size_t)2 * NEXP * 1024;
constexpr size_t OFF_PBF = OFF_ESC + (size_t)4 * NEXP * 4;
constexpr size_t OFF_ABUF = OFF_PBF + (size_t)2 * T * 256 * 2;
constexpr size_t OFF_Z = OFF_ABUF + (size_t)T * 1024 * 2;
constexpr size_t OFF_IDX = OFF_Z + (size_t)T * 2304 * 2;
constexpr size_t OFF_GATE = OFF_IDX + (size_t)T * 128 * 4;
constexpr size_t OFF_WSB = OFF_GATE + (size_t)T * 128 * 4;
constexpr size_t OFF_ACT = OFF_WSB + (size_t)2 * 6 * 128 * 128 * 2;
constexpr size_t OFF_SSQ = OFF_ACT + (size_t)T * 128 * 4;
constexpr size_t OFF_N8 = OFF_SSQ + (size_t)8 * T * 4;
constexpr size_t OFF_BAR = OFF_N8 + (size_t)T * 1024;
constexpr size_t OFF_H = OFF_BAR + 16384;
constexpr size_t OFF_SSQA = OFF_H + (size_t)T * 1024 * 2;
constexpr size_t OFF_SSQB = OFF_SSQA + (size_t)T * 4;
constexpr size_t WS_END = OFF_SSQB + (size_t)T * 4;

struct Params {
  const float* in[23];
  float* out;
  char* ws;
  int ph_lo, ph_hi;
};

typedef float cvt_f2 __attribute__((ext_vector_type(2)));
typedef __bf16 cvt_b2 __attribute__((ext_vector_type(2)));
__device__ __forceinline__ unsigned pack2(float a, float b) {
  const cvt_f2 v = {a, b};
  return __builtin_bit_cast(unsigned, __builtin_convertvector(v, cvt_b2));
}
__device__ __forceinline__ unsigned short f2bf(float f) { return (unsigned short)(pack2(f, f) & 0xffffu); }
__device__ __forceinline__ float bf2f(unsigned short b) { return __uint_as_float(((unsigned)b) << 16); }
__device__ __forceinline__ float bflo(unsigned u) { return __uint_as_float(u << 16); }
__device__ __forceinline__ float bfhi(unsigned u) { return __uint_as_float(u & 0xffff0000u); }
__device__ __forceinline__ float sigmoidf_(float x) { return __builtin_amdgcn_rcpf(1.0f + __builtin_amdgcn_exp2f(x * -1.4426950408889634f)); }
__device__ __forceinline__ float gelu_tanh(float x) {
  float u = 0.7978845608028654f * (x + 0.044715f * x * x * x);
  float e = __builtin_amdgcn_exp2f(u * 2.8853900817779268f);
  float th = 1.0f - 2.0f * __builtin_amdgcn_rcpf(e + 1.0f);
  return 0.5f * x * (1.0f + th);
}
template <int CTRL>
__device__ __forceinline__ float dpp_f(float v) {
  return __int_as_float(__builtin_amdgcn_update_dpp(0, __float_as_int(v), CTRL, 0xF, 0xF, true));
}
__device__ __forceinline__ float wave_sum(float v) {
  v += dpp_f<0xB1>(v);
  v += dpp_f<0x4E>(v);
  v += dpp_f<0x141>(v);
  v += dpp_f<0x140>(v);
  float s = __int_as_float(__builtin_amdgcn_readlane(__float_as_int(v), 0)) +
            __int_as_float(__builtin_amdgcn_readlane(__float_as_int(v), 16)) +
            __int_as_float(__builtin_amdgcn_readlane(__float_as_int(v), 32)) +
            __int_as_float(__builtin_amdgcn_readlane(__float_as_int(v), 48));
  return s;
}

__device__ __forceinline__ float wave_max(float v) {
  v = fmaxf(v, dpp_f<0xB1>(v));
  v = fmaxf(v, dpp_f<0x4E>(v));
  v = fmaxf(v, dpp_f<0x141>(v));
  v = fmaxf(v, dpp_f<0x140>(v));
  float s = fmaxf(fmaxf(__int_as_float(__builtin_amdgcn_readlane(__float_as_int(v), 0)),
                        __int_as_float(__builtin_amdgcn_readlane(__float_as_int(v), 16))),
                  fmaxf(__int_as_float(__builtin_amdgcn_readlane(__float_as_int(v), 32)),
                        __int_as_float(__builtin_amdgcn_readlane(__float_as_int(v), 48))));
  return s;
}
typedef float f32x2 __attribute__((ext_vector_type(2)));
__device__ __forceinline__ float group8_sum(float v) {
  v += dpp_f<0xB1>(v);
  v += dpp_f<0x4E>(v);
  v += dpp_f<0x141>(v);
  return v;
}

__device__ __forceinline__ int lds_off(int r, int c) { return r * 128 + ((c ^ ((r >> 1) & 7)) << 4); }

typedef unsigned u32x4_k __attribute__((ext_vector_type(4)));
__device__ __forceinline__ void gemm_kloop_issue(const int TIDX, const bf16_t* __restrict__ A, int lda, const bf16_t* __restrict__ Bt, int ldb,
                                                 u32x4_k (&ra)[4], u32x4_k (&rb)[4]) {
  const int sr = TIDX >> 3, sc = TIDX & 7;
  const bf16_t* ga = A + (size_t)sr * lda + sc * 8;
  const bf16_t* gb = Bt + (size_t)sr * ldb + sc * 8;
#pragma unroll
  for (int i = 0; i < 4; ++i) {
    ra[i] = *(const u32x4_k*)(ga + (size_t)(32 * i) * lda);
    rb[i] = *(const u32x4_k*)(gb + (size_t)(32 * i) * ldb);
  }
}
__device__ __forceinline__ void gemm_kloop(const int TIDX, const int BIDX, const bf16_t* __restrict__ A, int lda,
                                           const bf16_t* __restrict__ Bt, int ldb, int K,
                                           char* smem, f32x4 (&acc)[4][4], u32x4_k (&ra)[4], u32x4_k (&rb)[4]) {
  const int tid = TIDX, lane = tid & 63, wid = tid >> 6;
  const int wr = wid >> 1, wc = wid & 1;
  const int fr = lane & 15, fq = lane >> 4;
  const int sr = tid >> 3, sc = tid & 7;
  const bf16_t* ga = A + (size_t)sr * lda + sc * 8;
  const bf16_t* gb = Bt + (size_t)sr * ldb + sc * 8;
#pragma unroll
  for (int mi = 0; mi < 4; ++mi)
#pragma unroll
    for (int ni = 0; ni < 4; ++ni) acc[mi][ni] = f32x4{0.f, 0.f, 0.f, 0.f};
#pragma unroll
  for (int i = 0; i < 4; ++i) {
    *(u32x4_k*)(smem + lds_off(sr + 32 * i, sc)) = ra[i];
    *(u32x4_k*)(smem + 16384 + lds_off(sr + 32 * i, sc)) = rb[i];
  }
  __syncthreads();
  const int nt = K >> 6;
  for (int kt = 0; kt < nt; ++kt) {
    char* bufp = smem + (kt & 1) * 32768;
    const bool more = (kt + 1 < nt);
    if (more) {
#pragma unroll
      for (int i = 0; i < 4; ++i) {
        ra[i] = *(const u32x4_k*)(ga + (size_t)(32 * i) * lda + (kt + 1) * 64);
        rb[i] = *(const u32x4_k*)(gb + (size_t)(32 * i) * ldb + (kt + 1) * 64);
      }
    }
#pragma unroll
    for (int kk = 0; kk < 2; ++kk) {
      bf16x8 af[4], bfr[4];
#pragma unroll
      for (int mi = 0; mi < 4; ++mi) af[mi] = *(const bf16x8*)(bufp + lds_off(wr * 64 + mi * 16 + fr, kk * 4 + fq));
#pragma unroll
      for (int ni = 0; ni < 4; ++ni) bfr[ni] = *(const bf16x8*)(bufp + 16384 + lds_off(wc * 64 + ni * 16 + fr, kk * 4 + fq));
#pragma unroll
      for (int mi = 0; mi < 4; ++mi)
#pragma unroll
        for (int ni = 0; ni < 4; ++ni)
          acc[mi][ni] = __builtin_amdgcn_mfma_f32_16x16x32_bf16(bfr[ni], af[mi], acc[mi][ni], 0, 0, 0);
    }
    if (more) {
      char* nb = smem + ((kt + 1) & 1) * 32768;
#pragma unroll
      for (int i = 0; i < 4; ++i) {
        *(u32x4_k*)(nb + lds_off(sr + 32 * i, sc)) = ra[i];
        *(u32x4_k*)(nb + 16384 + lds_off(sr + 32 * i, sc)) = rb[i];
      }
    }
    __syncthreads();
  }
}

__device__ __forceinline__ void transpose_convert(const float* __restrict__ src, const float* __restrict__ g, bf16_t* __restrict__ dst,
                                  int Lc, int K, int N, size_t gtid, size_t gsz) {
  const int K8 = K >> 3;
  const size_t total = (size_t)Lc * K8 * N;
  for (size_t u = gtid; u < total; u += gsz) {
    int n = (int)(u % N);
    size_t r = u / N;
    int kc = (int)(r % K8);
    int l = (int)(r / K8);
    float v[8];
#pragma unroll
    for (int i = 0; i < 8; ++i) {
      int k = kc * 8 + i;
      float w = src[((size_t)l * K + k) * N + n];
      if (g) w *= g[l * K + k];
      v[i] = w;
    }
    uint4 o;
    o.x = pack2(v[0], v[1]); o.y = pack2(v[2], v[3]); o.z = pack2(v[4], v[5]); o.w = pack2(v[6], v[7]);
    *(uint4*)(dst + ((size_t)l * N + n) * K + kc * 8) = o;
  }
}
__device__ __forceinline__ void convert_flat(const float* __restrict__ src, bf16_t* __restrict__ dst, size_t n8, size_t gtid, size_t gsz) {
  for (size_t u = gtid; u < n8; u += gsz) {
    float4 a = ((const float4*)src)[2 * u], b = ((const float4*)src)[2 * u + 1];
    uint4 o;
    o.x = pack2(a.x, a.y); o.y = pack2(a.z, a.w); o.z = pack2(b.x, b.y); o.w = pack2(b.z, b.w);
    ((uint4*)dst)[u] = o;
  }
}
__device__ __forceinline__ void phase_convert(const int TIDX, const int BIDX, const Params& P) {
  const size_t gtid = (size_t)BIDX * 256 + TIDX;
  const size_t gsz = (size_t)VGRID * 256;
  char* ws = P.ws;
  transpose_convert(P.in[3], P.in[2], (bf16_t*)(ws + OFF_WINT), 2, 1024, 2304, gtid, gsz);
  transpose_convert(P.in[13], nullptr, (bf16_t*)(ws + OFF_WOUTT), 2, 1024, 1024, gtid, gsz);
  transpose_convert(P.in[15], P.in[14], (bf16_t*)(ws + OFF_WQT), 2, 1024, 2048, gtid, gsz);
  transpose_convert(P.in[21], P.in[19], (bf16_t*)(ws + OFF_WPGT), 2, 1024, 1024, gtid, gsz);
  transpose_convert(P.in[20], nullptr, (bf16_t*)(ws + OFF_WPET), 2, 256, 1024, gtid, gsz);
  convert_flat(P.in[16], (bf16_t*)(ws + OFF_KEYS), (size_t)2 * 8 * 2 * 128 * 128 / 8, gtid, gsz);
  {
    const int lane = TIDX & 63;
    const int gw = BIDX * 4 + (TIDX >> 6), nW = VGRID * 4;
    float* esc = (float*)(ws + OFF_ESC);
    for (int row0 = gw * 2; row0 < 4 * NEXP; row0 += nW * 2) {
      float4 v[2][4];
#pragma unroll
      for (int rr = 0; rr < 2; ++rr) {
        const int row = row0 + rr;
        const float* src = (row < 2 * NEXP) ? (P.in[17] + (size_t)row * 1024) : (P.in[18] + (size_t)(row - 2 * NEXP) * 1024);
#pragma unroll
        for (int i = 0; i < 4; ++i) v[rr][i] = ((const float4*)src)[lane * 4 + i];
      }
#pragma unroll
      for (int rr = 0; rr < 2; ++rr) {
        const int row = row0 + rr;
        float m = 0.f;
#pragma unroll
        for (int i = 0; i < 4; ++i) m = fmaxf(m, fmaxf(fmaxf(fabsf(v[rr][i].x), fabsf(v[rr][i].y)), fmaxf(fabsf(v[rr][i].z), fabsf(v[rr][i].w))));
        m = wave_max(m);
        const float sc = (m > 0.f) ? 224.0f * __builtin_amdgcn_rcpf(m) : 0.f;
        uint4 o;
        unsigned w[4];
#pragma unroll
        for (int i = 0; i < 4; ++i) {
          int t = __builtin_amdgcn_cvt_pk_fp8_f32(v[rr][i].x * sc, v[rr][i].y * sc, 0, false);
          t = __builtin_amdgcn_cvt_pk_fp8_f32(v[rr][i].z * sc, v[rr][i].w * sc, t, true);
          w[i] = (unsigned)t;
        }
        o.x = w[0]; o.y = w[1]; o.z = w[2]; o.w = w[3];
        *(uint4*)(ws + OFF_EU + (size_t)(row / NEXP) * ((size_t)NEXP * 1024) + (size_t)(lane >> 3) * ((size_t)NEXP * 128) + (size_t)(row % NEXP) * 128 + (lane & 7) * 16) = o;
        if (lane == 0) esc[row] = m * (1.0f / 224.0f);
      }
    }
  }
  {
    bf16_t* wsb = (bf16_t*)(ws + OFF_WSB);
    for (size_t u = gtid; u < (size_t)2 * 6 * 128 * 128; u += gsz) {
      int j = (int)(u & 127), i = (int)((u >> 7) & 127);
      float w = P.in[11][u];
      wsb[u] = ((j >> 6) <= (i >> 6)) ? f2bf(w) : (bf16_t)0;
    }
  }
  convert_flat(P.in[1], (bf16_t*)(ws + OFF_PBF), (size_t)2 * T * 256 / 8, gtid, gsz);
}

template <int MODE, bool INB>
__device__ __forceinline__ void phase_norm(const int TIDX, const int BIDX, const void* __restrict__ hraw, const float* __restrict__ g, bf16_t* __restrict__ abuf, float* __restrict__ outp, unsigned char* __restrict__ n8 = nullptr) {
  const int lane = TIDX & 63, wid = TIDX >> 6;
  const int gw = BIDX * 4 + wid, nW = VGRID * 4;
  float4 gv[4];
  if (MODE != 0) {
#pragma unroll
    for (int i = 0; i < 4; ++i) gv[i] = ((const float4*)g)[lane + 64 * i];
  }
  for (int t0 = gw * 4; t0 < T; t0 += nW * 4) {
    float4 v[4][4];
#pragma unroll
    for (int rr = 0; rr < 4; ++rr)
#pragma unroll
      for (int i = 0; i < 4; ++i) {
        if (INB) {
          const uint2 pk = ((const uint2*)((const bf16_t*)hraw + (size_t)(t0 + rr) * D))[lane + 64 * i];
          v[rr][i] = float4{bflo(pk.x), bfhi(pk.x), bflo(pk.y), bfhi(pk.y)};
        } else {
          v[rr][i] = ((const float4*)((const float*)hraw + (size_t)(t0 + rr) * D))[lane + 64 * i];
        }
      }
#pragma unroll
    for (int rr = 0; rr < 4; ++rr) {
      const int t = t0 + rr;
      float ss = 0.f;
#pragma unroll
      for (int i = 0; i < 4; ++i) ss += v[rr][i].x * v[rr][i].x + v[rr][i].y * v[rr][i].y + v[rr][i].z * v[rr][i].z + v[rr][i].w * v[rr][i].w;
      ss = wave_sum(ss);
      float rs = __builtin_amdgcn_rsqf(ss * (1.0f / D) + EPS);
#pragma unroll
      for (int i = 0; i < 4; ++i) {
        float4 o = v[rr][i];
        o.x *= rs; o.y *= rs; o.z *= rs; o.w *= rs;
        if (MODE != 0) { o.x *= gv[i].x; o.y *= gv[i].y; o.z *= gv[i].z; o.w *= gv[i].w; }
        if (MODE == 2) {
          ((float4*)(outp + (size_t)t * D))[lane + 64 * i] = o;
        } else {
          uint2 pk; pk.x = pack2(o.x, o.y); pk.y = pack2(o.z, o.w);
          ((uint2*)(abuf + (size_t)t * D))[lane + 64 * i] = pk;
          if (MODE == 1) {
            const float c0 = fminf(fmaxf(o.x * 16.0f, -440.f), 440.f), c1 = fminf(fmaxf(o.y * 16.0f, -440.f), 440.f);
            const float c2 = fminf(fmaxf(o.z * 16.0f, -440.f), 440.f), c3 = fminf(fmaxf(o.w * 16.0f, -440.f), 440.f);
            int w8 = __builtin_amdgcn_cvt_pk_fp8_f32(c0, c1, 0, false);
            w8 = __builtin_amdgcn_cvt_pk_fp8_f32(c2, c3, w8, true);
            ((int*)(n8 + (size_t)t * D))[lane + 64 * i] = w8;
          }
        }
      }
    }
  }
}

namespace pg8 {
#define PG8_LAS __attribute__((address_space(3)))
typedef unsigned short bf16_t;
typedef short bf16x8 __attribute__((ext_vector_type(8)));
typedef float f32x4 __attribute__((ext_vector_type(4)));
typedef unsigned u32x4 __attribute__((ext_vector_type(4)));
constexpr int BM = 256, BK = 64, HALF = 128, HTB = HALF * BK * 2  , STAGE_BYTES = 8 * HTB, NXCD = 8, WGM = 8;

__host__ __device__ __forceinline__ int lds_byte(int r, int c) { const int st = (r >> 4) * 2 + (c >> 5), rr = r & 15, cc = c & 31, ob = rr * 64 + cc * 2; return st * 1024 + (ob ^ (((ob >> 9) & 1) << 5)); }
__host__ __device__ __forceinline__ void stage_rc(int b, int& R, int& C) { const int st = b / 1024, sb = b % 1024, swz = sb ^ (((sb >> 9) & 1) << 5); R = (st >> 1) * 16 + swz / 64; C = (st & 1) * 32 + (swz % 64) / 2; }
__host__ __device__ __forceinline__ int perm32(int rho) { const int n = rho >> 4, i = rho & 15; return 8 * (i >> 2) + 4 * n + (i & 3); }

struct Unit { int pm, pn; };
struct Gemm { const bf16_t* A; const bf16_t* Bt; int M, N, K; };

struct StaticOrder {
    int nM, nN, nwg, G, c;
    __host__ __device__ void init(int M, int N, int G_, int c_) { nM = M / BM; nN = N / BM; nwg = nM * nN; G = G_; c = c_; }
    __host__ __device__ bool next(int i, Unit& u) const {
        const long L = (long)i * G + c; if (L >= nwg) return false;
        int wgid = (int)L; { const int q = nwg / NXCD, r = nwg % NXCD, xcd = wgid % NXCD, off = wgid / NXCD; wgid = (xcd < r ? xcd * (q + 1) : r * (q + 1) + (xcd - r) * q) + off; }
        const int nig = WGM * nN, gid = wgid / nig, fm = gid * WGM, gsz = (nM - fm) < WGM ? (nM - fm) : WGM;
        u.pm = fm + ((wgid % nig) % gsz); u.pn = (wgid % nig) / gsz; return true;
    }
    __device__ __forceinline__ void a_ready(const Unit&) const {}
    __device__ __forceinline__ void done(const Unit&) const {}
};
__device__ __forceinline__ unsigned cvt_pk_bf16(float lo, float hi) { unsigned r; asm volatile("v_cvt_pk_bf16_f32 %0, %1, %2" : "=v"(r) : "v"(lo), "v"(hi)); return r; }
typedef float f32x2 __attribute__((ext_vector_type(2)));
__device__ __forceinline__ f32x2 gelu_pk(f32x2 v) {
    const f32x2 av = __builtin_elementwise_abs(v), d = av * 0.2316418882f + 1.0f;
    f32x2 t; t.x = __builtin_amdgcn_rcpf(d.x); t.y = __builtin_amdgcn_rcpf(d.y);
    f32x2 q = t * 0.5307027145f + (-0.7265760135f); q = q * t + 0.7107068705f; q = q * t + (-0.142248368f); q = q * t + 0.127414796f; q = q * t;
    const f32x2 s = (v * v) * (-0.72134752044f);
    f32x2 e; e.x = __builtin_amdgcn_exp2f(s.x); e.y = __builtin_amdgcn_exp2f(s.y);
    const f32x2 m = v * (q * e), r = v - m;
    f32x2 o; o.x = v.x < 0.f ? m.x : r.x; o.y = v.y < 0.f ? m.y : r.y; return o;
}
template <int ACT  > struct EpiBf16 {
    static constexpr bool PERM = true, AFTER_DRAIN = false;
    bf16_t* O; int ldc; const float* bias; int split_cols; size_t split_stride;
    __device__ __forceinline__ void operator()(const f32x4 (&acc)[2][2][4][2], const Unit& u, int wr, int wc, int fr, int fq) const {
        const int row0 = u.pm * BM + wr * 64 + fr; int colt = u.pn * BM; bf16_t* base = O;
        if (split_cols) { const int t = colt / split_cols; base += (size_t)t * split_stride; colt -= t * split_cols; }
        const int col0 = colt + wc * 32 + 8 * fq, bcol0 = u.pn * BM + wc * 32 + 8 * fq;
        f32x4 bv[2][2];
#pragma unroll
        for (int bj = 0; bj < 2; ++bj)
#pragma unroll
            for (int n = 0; n < 2; ++n) bv[bj][n] = bias ? *(const f32x4*)(bias + bcol0 + bj * HALF + 4 * n) : (f32x4){0.f, 0.f, 0.f, 0.f};
#pragma unroll
        for (int ai = 0; ai < 2; ++ai)
#pragma unroll
            for (int m = 0; m < 4; ++m) { bf16_t* rowp = base + (size_t)(row0 + ai * HALF + m * 16) * ldc + col0;
#pragma unroll
                for (int bj = 0; bj < 2; ++bj) { f32x4 v0 = acc[ai][bj][m][0] + bv[bj][0], v1 = acc[ai][bj][m][1] + bv[bj][1];
                    if (ACT == 1) { f32x2 a = gelu_pk((f32x2){v0[0], v0[1]}), b = gelu_pk((f32x2){v0[2], v0[3]}), c = gelu_pk((f32x2){v1[0], v1[1]}), d = gelu_pk((f32x2){v1[2], v1[3]});
                        v0 = (f32x4){a.x, a.y, b.x, b.y}; v1 = (f32x4){c.x, c.y, d.x, d.y}; }
                    if (ACT == 2) {
#pragma unroll
                        for (int j = 0; j < 4; ++j) { v0[j] = 0.5f * v0[j] * (1.0f + erff(v0[j] * 0.70710678f)); v1[j] = 0.5f * v1[j] * (1.0f + erff(v1[j] * 0.70710678f)); } }
                    u32x4 w; w.x = cvt_pk_bf16(v0[0], v0[1]); w.y = cvt_pk_bf16(v0[2], v0[3]); w.z = cvt_pk_bf16(v1[0], v1[1]); w.w = cvt_pk_bf16(v1[2], v1[3]);
                    *(u32x4*)(rowp + bj * HALF) = w; } }
    }
};
template <class Epi, class Sched, bool STAMP = false>
__device__ __forceinline__ void gemm_phase(const int TL, PG8_LAS unsigned char* lds, const Gemm g, const Sched& S, const Epi& E, unsigned long long* stamps) {
    const int tid = TL, wid = __builtin_amdgcn_readfirstlane(tid >> 6), lane = tid & 63, wr = wid >> 2, wc = wid & 3, fr = lane & 15, fq = lane >> 4;
    const int K = g.K, nt = K / BK;
    int ts_lo = 0, ts_hi = 0, nts = 0; const unsigned long long rt_entry = STAMP ? (unsigned long long)wall_clock64() : 0ull;
#define PG8_STAMP() do { if (STAMP && wid == 0 && nts < 64) { const unsigned long long _c = (unsigned long long)clock64(); \
        ts_lo = (lane == nts) ? (int)(unsigned)_c : ts_lo; ts_hi = (lane == nts) ? (int)(unsigned)(_c >> 32) : ts_hi; ++nts; } } while (0)
    PG8_STAMP();
    unsigned voffA[2], voffB[2];
#pragma unroll
    for (int i = 0; i < 2; ++i) { int R, C; stage_rc(tid * 16 + i * 8192, R, C); const int Rb = Epi::PERM ? ((R & ~31) + perm32(R & 31)) : R;
        voffA[i] = (unsigned)(R * K + C) * 2u; voffB[i] = (unsigned)(Rb * K + C) * 2u; }
    const size_t kstep = (size_t)(BK * 2);
    const size_t hstep = (size_t)HALF * K * 2;
    const size_t tstep = 2 * hstep;
    const unsigned ldsw = (unsigned)wid * 1024u;
    const int aoff = lds_byte(wr * 64 + fr, fq * 8), boff = lds_byte(wc * 32 + fr, fq * 8);
#define PG8_SA(b, h) (((b) * 2 + (h)) * HTB)
#define PG8_SB(b, h) ((4 + (b) * 2 + (h)) * HTB)
#define PG8_STAGE(bufoff, gbase, voff) do { _Pragma("unroll") for (int _i = 0; _i < 2; ++_i) \
        __builtin_amdgcn_global_load_lds((const unsigned*)((const char*)(gbase) + (voff)[_i]), (PG8_LAS unsigned*)(lds + (bufoff) + ldsw + _i * 8192), 16, 0, 0); } while (0)
#define PG8_LDA(dst, b, h) do { _Pragma("unroll") for (int m = 0; m < 4; ++m) _Pragma("unroll") for (int k = 0; k < 2; ++k) dst[m][k] = *(const PG8_LAS bf16x8*)(lds + PG8_SA(b, h) + aoff + m * 2048 + k * 1024); } while (0)
#define PG8_LDB(dst, b, h) do { _Pragma("unroll") for (int n = 0; n < 2; ++n) _Pragma("unroll") for (int k = 0; k < 2; ++k) dst[n][k] = *(const PG8_LAS bf16x8*)(lds + PG8_SB(b, h) + boff + n * 2048 + k * 1024); } while (0)
#define PG8_MMA(ai, bj, At, Bt) do { __builtin_amdgcn_s_setprio(1); _Pragma("unroll") for (int m = 0; m < 4; ++m) _Pragma("unroll") for (int n = 0; n < 2; ++n) _Pragma("unroll") for (int k = 0; k < 2; ++k) \
        acc[ai][bj][m][n] = __builtin_amdgcn_mfma_f32_16x16x32_bf16(Bt[n][k], At[m][k], acc[ai][bj][m][n], 0, 0, 0); __builtin_amdgcn_s_setprio(0); } while (0)
#define PG8_WAIT_V(n) asm volatile("s_waitcnt vmcnt(" #n ")" ::: "memory")
#define PG8_WAIT_L(n) asm volatile("s_waitcnt lgkmcnt(" #n ")" ::: "memory")
#define PG8_BAR __builtin_amdgcn_s_barrier()
#define PG8_SCHED __builtin_amdgcn_sched_barrier(0)
    Unit cur, nxt; int ui = 0;
    if (!S.next(0, cur)) return;
    f32x4 acc[2][2][4][2];
#pragma unroll
    for (int a = 0; a < 2; ++a)
#pragma unroll
        for (int b = 0; b < 2; ++b)
#pragma unroll
            for (int m = 0; m < 4; ++m)
#pragma unroll
                for (int n = 0; n < 2; ++n) acc[a][b][m][n] = (f32x4){0.f, 0.f, 0.f, 0.f};
    bf16x8 At[4][2], B0[2][2], B1[2][2];
    const char* cA = (const char*)g.A + (size_t)cur.pm * tstep; const char* cB = (const char*)g.Bt + (size_t)cur.pn * tstep;
    S.a_ready(cur);
    PG8_STAGE(PG8_SB(0, 0), cB, voffB); PG8_STAGE(PG8_SA(0, 0), cA, voffA); PG8_STAGE(PG8_SB(0, 1), cB + hstep, voffB); PG8_STAGE(PG8_SA(0, 1), cA + hstep, voffA);
    if (wr == 1) PG8_BAR;
    PG8_WAIT_V(4); PG8_BAR;
    PG8_STAGE(PG8_SB(1, 0), cB + kstep, voffB); PG8_STAGE(PG8_SA(1, 0), cA + kstep, voffA); PG8_STAGE(PG8_SB(1, 1), cB + hstep + kstep, voffB);
    PG8_WAIT_V(6); PG8_BAR;
    PG8_STAMP();
    for (;;) {
        const bool has_next = S.next(ui + 1, nxt);
        const char* nA = has_next ? (const char*)g.A + (size_t)nxt.pm * tstep : cA; const char* nB = has_next ? (const char*)g.Bt + (size_t)nxt.pn * tstep : cB;
        for (int t = 0; t < nt; t += 2) {
            const bool last = (t == nt - 2);
            const char* a1 = cA + (size_t)(t + 1) * kstep;
            const char* a2 = last ? nA : cA + (size_t)(t + 2) * kstep; const char* b2 = last ? nB : cB + (size_t)(t + 2) * kstep;
            const char* a3 = a2 + kstep; const char* b3 = b2 + kstep;
            if (last && has_next) S.a_ready(nxt);
            PG8_LDB(B0, 0, 0); PG8_SCHED; PG8_LDA(At, 0, 0); PG8_STAGE(PG8_SA(1, 1), a1 + hstep, voffA);
            PG8_WAIT_L(8); PG8_BAR; PG8_WAIT_L(0); PG8_MMA(0, 0, At, B0); PG8_BAR; PG8_SCHED;
            PG8_LDB(B1, 0, 1); PG8_STAGE(PG8_SB(0, 0), b2, voffB);
            PG8_BAR; PG8_WAIT_L(0); PG8_MMA(0, 1, At, B1); PG8_BAR;
            PG8_LDA(At, 0, 1); PG8_STAGE(PG8_SA(0, 0), a2, voffA);
            PG8_BAR; PG8_WAIT_L(0); PG8_MMA(1, 0, At, B0); PG8_BAR; PG8_SCHED;
            PG8_STAGE(PG8_SB(0, 1), b2 + hstep, voffB);
            PG8_WAIT_V(6); PG8_BAR; PG8_MMA(1, 1, At, B1); PG8_BAR;
            PG8_LDB(B0, 1, 0); PG8_SCHED; PG8_LDA(At, 1, 0); PG8_STAGE(PG8_SA(0, 1), a2 + hstep, voffA);
            PG8_WAIT_L(8); PG8_BAR; PG8_WAIT_L(0); PG8_MMA(0, 0, At, B0); PG8_BAR; PG8_SCHED;
            PG8_LDB(B1, 1, 1); PG8_STAGE(PG8_SB(1, 0), b3, voffB);
            PG8_BAR; PG8_WAIT_L(0); PG8_MMA(0, 1, At, B1); PG8_BAR;
            PG8_LDA(At, 1, 1); PG8_STAGE(PG8_SA(1, 0), a3, voffA);
            PG8_BAR; PG8_WAIT_L(0); PG8_MMA(1, 0, At, B0); PG8_BAR; PG8_SCHED;
            PG8_STAGE(PG8_SB(1, 1), b3 + hstep, voffB);
            PG8_WAIT_V(6); PG8_BAR; PG8_MMA(1, 1, At, B1); PG8_BAR;
        }
        PG8_STAMP();
        if constexpr (!Epi::AFTER_DRAIN) { E(acc, cur, wr, wc, fr, fq); S.done(cur); }
        PG8_STAMP();
        if (!has_next) break;
#pragma unroll
        for (int a = 0; a < 2; ++a)
#pragma unroll
            for (int b = 0; b < 2; ++b)
#pragma unroll
                for (int m = 0; m < 4; ++m)
#pragma unroll
                    for (int n = 0; n < 2; ++n) acc[a][b][m][n] = (f32x4){0.f, 0.f, 0.f, 0.f};
        cur = nxt; cA = nA; cB = nB; ++ui;
    }
    PG8_WAIT_V(0);
    if (wr == 0) PG8_BAR;
    PG8_BAR;
    if constexpr (Epi::AFTER_DRAIN) { E.fused(acc, cur, wr, wc, fr, fq, lds, wid, lane); S.done(cur); }
    PG8_STAMP();
    if (STAMP && wid == 0) { stamps[lane] = lane < nts ? (((unsigned long long)(unsigned)ts_hi << 32) | (unsigned)ts_lo) : 0ull;
        if (lane == 62) stamps[62] = rt_entry; if (lane == 63) stamps[63] = (unsigned long long)wall_clock64(); }
#undef PG8_STAMP
#undef PG8_SA
#undef PG8_SB
#undef PG8_STAGE
#undef PG8_LDA
#undef PG8_LDB
#undef PG8_MMA
#undef PG8_WAIT_V
#undef PG8_WAIT_L
#undef PG8_BAR
#undef PG8_SCHED
}
}

template <bool INB>
struct EpiResid {
  static constexpr bool PERM = true, AFTER_DRAIN = false;
  const void* hin; bf16_t* hout; float* ssq; int wave_id;
  __device__ __forceinline__ void operator()(const pg8::f32x4 (&acc)[2][2][4][2], const pg8::Unit& u, int, int, int, int) const {
    int lane_id;
    asm volatile("v_mbcnt_lo_u32_b32 %0, -1, 0\n\tv_mbcnt_hi_u32_b32 %0, -1, %0" : "=v"(lane_id));
    const int wr = wave_id >> 2, wc = wave_id & 3, fr = lane_id & 15, fq = lane_id >> 4;
    const int row0 = u.pm * 256 + wr * 64 + fr, col0 = u.pn * 256 + wc * 32 + 8 * fq;
#pragma unroll
    for (int ai = 0; ai < 2; ++ai)
#pragma unroll
      for (int m = 0; m < 4; ++m) {
        const int row = row0 + ai * 128 + m * 16;
        const size_t ro = (size_t)row * D + col0;
        float sq = 0.f;
#pragma unroll
        for (int bj = 0; bj < 2; ++bj)
#pragma unroll
          for (int n = 0; n < 2; ++n) {
            const size_t o = ro + bj * 128 + n * 4;
            pg8::f32x4 v;
            if (INB) { const uint2 pk = *(const uint2*)((const bf16_t*)hin + o); v = pg8::f32x4{bflo(pk.x), bfhi(pk.x), bflo(pk.y), bfhi(pk.y)}; }
            else v = *(const pg8::f32x4*)((const float*)hin + o);
            v = v + acc[ai][bj][m][n];
            uint2 w; w.x = pack2(v[0], v[1]); w.y = pack2(v[2], v[3]);
            *(uint2*)(hout + o) = w;
            const float r0 = bflo(w.x), r1 = bfhi(w.x), r2 = bflo(w.y), r3 = bfhi(w.y);
            sq += r0 * r0 + r1 * r1 + r2 * r2 + r3 * r3;
          }
        sq += __shfl_xor(sq, 16);
        sq += __shfl_xor(sq, 32);
        if (fq == 0) atomicAdd(ssq + row, sq);
      }
  }
};
struct EpiBf16Rs {
  static constexpr bool PERM = true, AFTER_DRAIN = false;
  bf16_t* O; int ldc; const float* ssq; int wave_id;
  __device__ __forceinline__ void operator()(const pg8::f32x4 (&acc)[2][2][4][2], const pg8::Unit& u, int, int, int, int) const {
    int lane_id;
    asm volatile("v_mbcnt_lo_u32_b32 %0, -1, 0\n\tv_mbcnt_hi_u32_b32 %0, -1, %0" : "=v"(lane_id));
    const int wr = wave_id >> 2, wc = wave_id & 3, fr = lane_id & 15, fq = lane_id >> 4;
    const int row0 = u.pm * 256 + wr * 64 + fr, col0 = u.pn * 256 + wc * 32 + 8 * fq;
#pragma unroll
    for (int ai = 0; ai < 2; ++ai)
#pragma unroll
      for (int m = 0; m < 4; ++m) {
        const int row = row0 + ai * 128 + m * 16;
        const float rs = __builtin_amdgcn_rsqf(ssq[row] * (1.0f / D) + EPS);
        bf16_t* rowp = O + (size_t)row * ldc + col0;
#pragma unroll
        for (int bj = 0; bj < 2; ++bj) {
          const pg8::f32x4 v0 = acc[ai][bj][m][0], v1 = acc[ai][bj][m][1];
          pg8::u32x4 w;
          w.x = pack2(v0[0] * rs, v0[1] * rs); w.y = pack2(v0[2] * rs, v0[3] * rs);
          w.z = pack2(v1[0] * rs, v1[1] * rs); w.w = pack2(v1[2] * rs, v1[3] * rs);
          *(pg8::u32x4*)(rowp + bj * 128) = w;
        }
      }
  }
};
struct EpiSig {
  static constexpr bool PERM = true, AFTER_DRAIN = false;
  const float* ssq; bf16_t* sg; int wave_id;
  __device__ __forceinline__ void operator()(const pg8::f32x4 (&acc)[2][2][4][2], const pg8::Unit& u, int, int, int, int) const {
    int lane_id;
    asm volatile("v_mbcnt_lo_u32_b32 %0, -1, 0\n\tv_mbcnt_hi_u32_b32 %0, -1, %0" : "=v"(lane_id));
    const int wr = wave_id >> 2, wc = wave_id & 3, fr = lane_id & 15, fq = lane_id >> 4;
    const int row0 = u.pm * 256 + wr * 64 + fr, col0 = u.pn * 256 + wc * 32 + 8 * fq;
#pragma unroll
    for (int ai = 0; ai < 2; ++ai)
#pragma unroll
      for (int m = 0; m < 4; ++m) {
        const int row = row0 + ai * 128 + m * 16;
        float sq = 0.f;
#pragma unroll
        for (int xx = 0; xx < 8; ++xx) sq += ssq[(size_t)xx * T + row];
        const float rs = __builtin_amdgcn_rsqf(sq * (1.0f / D) + EPS);
        const size_t ro = (size_t)row * D + col0;
#pragma unroll
        for (int bj = 0; bj < 2; ++bj)
#pragma unroll
          for (int n = 0; n < 2; ++n) {
            const pg8::f32x4 a = acc[ai][bj][m][n];
            uint2 pk;
            pk.x = pack2(sigmoidf_(rs * a[0]), sigmoidf_(rs * a[1]));
            pk.y = pack2(sigmoidf_(rs * a[2]), sigmoidf_(rs * a[3]));
            *(uint2*)(sg + ro + bj * 128 + n * 4) = pk;
          }
      }
  }
};
struct EpiPle {
  static constexpr bool PERM = true, AFTER_DRAIN = false;
  bf16_t* h; const bf16_t* sg; float* ssq; int wave_id;
  __device__ __forceinline__ void operator()(const pg8::f32x4 (&acc)[2][2][4][2], const pg8::Unit& u, int, int, int, int) const {
    int lane_id;
    asm volatile("v_mbcnt_lo_u32_b32 %0, -1, 0\n\tv_mbcnt_hi_u32_b32 %0, -1, %0" : "=v"(lane_id));
    const int wr = wave_id >> 2, wc = wave_id & 3, fr = lane_id & 15, fq = lane_id >> 4;
    const int row0 = u.pm * 256 + wr * 64 + fr, col0 = u.pn * 256 + wc * 32 + 8 * fq;
#pragma unroll
    for (int ai = 0; ai < 2; ++ai)
#pragma unroll
      for (int m = 0; m < 4; ++m) {
        const int row = row0 + ai * 128 + m * 16;
        const size_t ro = (size_t)row * D + col0;
        float sq = 0.f;
#pragma unroll
        for (int bj = 0; bj < 2; ++bj)
#pragma unroll
          for (int n = 0; n < 2; ++n) {
            const size_t o = ro + bj * 128 + n * 4;
            const uint2 pk = *(const uint2*)(sg + o);
            const uint2 hp = *(const uint2*)(h + o);
            const pg8::f32x4 a = acc[ai][bj][m][n];
            uint2 w;
            w.x = pack2(bflo(hp.x) + a[0] * bflo(pk.x), bfhi(hp.x) + a[1] * bfhi(pk.x));
            w.y = pack2(bflo(hp.y) + a[2] * bflo(pk.y), bfhi(hp.y) + a[3] * bfhi(pk.y));
            *(uint2*)(h + o) = w;
            const float r0 = bflo(w.x), r1 = bfhi(w.x), r2 = bflo(w.y), r3 = bfhi(w.y);
            sq += r0 * r0 + r1 * r1 + r2 * r2 + r3 * r3;
          }
        sq += __shfl_xor(sq, 16);
        sq += __shfl_xor(sq, 32);
        if (fq == 0) atomicAdd(ssq + row, sq);
      }
  }
};
template <class Epi>
__device__ __forceinline__ void run_gemm(const int TL, const int BL, char* smem, const bf16_t* A, const bf16_t* Bt, int N, int K, const Epi& E) {
  pg8::Gemm g{A, Bt, T, N, K};
  pg8::StaticOrder S; S.init(T, N, (int)gridDim.x, BL);
  pg8::gemm_phase<Epi, pg8::StaticOrder, false>(TL, (PG8_LAS unsigned char*)smem, g, S, E, nullptr);
}

__device__ __forceinline__ void unpack8(const uint4& u, float (&f)[8]) {
  f[0] = bflo(u.x); f[1] = bfhi(u.x); f[2] = bflo(u.y); f[3] = bfhi(u.y);
  f[4] = bflo(u.z); f[5] = bfhi(u.z); f[6] = bflo(u.w); f[7] = bfhi(u.w);
}
__device__ __forceinline__ void phase_mix(const int TIDX, const int BIDX, const Params& P, int L, const bf16_t* __restrict__ z, bf16_t* __restrict__ y,
                                          const bf16_t* __restrict__ wsb, char* smem) {
  const int tid = TIDX, lane = tid & 63, wid = tid >> 6;
  const int r8 = tid >> 3, c8 = tid & 7;
  const float* conv_a_w = P.in[4] + (size_t)L * 31 * 384;
  const float* conv_a_b = P.in[5] + L * 384;
  const float* ln_a_g = P.in[6] + L * 384;
  const float* ln_a_b = P.in[7] + L * 384;
  const float* conv_b_w = P.in[8] + L * 3 * 256;
  const float* ln_c_g = P.in[9] + L * 384;
  const float* ln_c_b = P.in[10] + L * 384;
  const float* b_s = P.in[12] + L * 6 * 128;
  float* fs = (float*)smem;
  for (int item = BIDX; item < 512 * 16; item += VGRID) {
    const int tb = item >> 4, part = (item ^ (item >> 9)) & 15;
    const int t0 = tb * 128;
    const int s0 = t0 & (SEQ - 1);
    if (part < 6) {
      {
        const int ch0 = part * 64 + c8 * 8;
        uint4 vv[5], gg[5];
#pragma unroll
        for (int p = 0; p < 5; ++p) {
          const int r = r8 + 32 * p;
          vv[p] = uint4{0, 0, 0, 0}; gg[p] = uint4{0, 0, 0, 0};
          if (r < 158 && (r >= 30 || s0 > 0)) {
            const bf16_t* zr = z + (size_t)(t0 - 30 + r) * INC + ch0;
            vv[p] = *(const uint4*)zr;
            gg[p] = *(const uint4*)(zr + 384);
          }
        }
#pragma unroll
        for (int p = 0; p < 5; ++p) {
          const int r = r8 + 32 * p;
          if (r < 158) {
            float a[8], g[8];
            unpack8(vv[p], a); unpack8(gg[p], g);
            float4 o0, o1;
            o0.x = a[0] * sigmoidf_(g[0]); o0.y = a[1] * sigmoidf_(g[1]); o0.z = a[2] * sigmoidf_(g[2]); o0.w = a[3] * sigmoidf_(g[3]);
            o1.x = a[4] * sigmoidf_(g[4]); o1.y = a[5] * sigmoidf_(g[5]); o1.z = a[6] * sigmoidf_(g[6]); o1.w = a[7] * sigmoidf_(g[7]);
            *(float4*)(fs + r * 64 + c8 * 8) = o0;
            *(float4*)(fs + r * 64 + c8 * 8 + 4) = o1;
          }
        }
      }
      const int ch = part * 64 + lane;
      float wk[31];
#pragma unroll
      for (int k = 0; k < 31; ++k) wk[k] = conv_a_w[k * 384 + ch];
      const float cb = conv_a_b[ch], lg = ln_a_g[ch], lb = ln_a_b[ch];
      __syncthreads();
      for (int g4 = 0; g4 < 8; ++g4) {
        const int tl = wid * 32 + g4 * 4;
        float yv[34];
#pragma unroll
        for (int k = 0; k < 34; ++k) yv[k] = fs[(tl + k) * 64 + lane];
#pragma unroll
        for (int q = 0; q < 4; ++q) {
          float a = cb;
#pragma unroll
          for (int k = 0; k < 31; ++k) a += wk[k] * yv[q + k];
          float mean = wave_sum(a) * (1.0f / 64);
          float d = a - mean;
          float var = wave_sum(d * d) * (1.0f / 64);
          float yn = d * __builtin_amdgcn_rsqf(var + EPS) * lg + lb;
          float o = yn * sigmoidf_(yn);
          y[(size_t)(t0 + tl + q) * D + ch] = f2bf(o);
        }
      }
      __syncthreads();
    } else if (part < 10) {
      const int cbn = (part - 6) * 64 + c8 * 8;
      float w0[8], w1[8], w2[8];
#pragma unroll
      for (int i = 0; i < 8; ++i) { w0[i] = conv_b_w[cbn + i]; w1[i] = conv_b_w[256 + cbn + i]; w2[i] = conv_b_w[512 + cbn + i]; }
      const int tl0 = r8 * 4;
      uint4 cgv[6], xbv[6], bgv[4];
#pragma unroll
      for (int k = 0; k < 6; ++k) {
        cgv[k] = uint4{0, 0, 0, 0}; xbv[k] = uint4{0, 0, 0, 0};
        if (k >= 2 || (s0 + tl0) > 0) {
          const bf16_t* zr = z + (size_t)(t0 + tl0 - 2 + k) * INC + cbn;
          cgv[k] = *(const uint4*)(zr + 1024);
          xbv[k] = *(const uint4*)(zr + 1280);
        }
      }
#pragma unroll
      for (int k = 0; k < 4; ++k) bgv[k] = *(const uint4*)(z + (size_t)(t0 + tl0 + k) * INC + 768 + cbn);
      float pr[6][8];
#pragma unroll
      for (int k = 0; k < 6; ++k) {
        float a[8], b[8];
        unpack8(cgv[k], a); unpack8(xbv[k], b);
#pragma unroll
        for (int i = 0; i < 8; ++i) pr[k][i] = a[i] * b[i];
      }
#pragma unroll
      for (int k = 0; k < 4; ++k) {
        float bg[8], o[8];
        unpack8(bgv[k], bg);
#pragma unroll
        for (int i = 0; i < 8; ++i) o[i] = bg[i] * (w0[i] * pr[k][i] + w1[i] * pr[k + 1][i] + w2[i] * pr[k + 2][i]);
        uint4 pk; pk.x = pack2(o[0], o[1]); pk.y = pack2(o[2], o[3]); pk.z = pack2(o[4], o[5]); pk.w = pack2(o[6], o[7]);
        *(uint4*)(y + (size_t)(t0 + tl0 + k) * D + 384 + cbn) = pk;
      }
    } else {
      const int hc = part - 10;
      const int ch0 = hc * 64 + c8 * 8;
      bf16_t* vnT = (bf16_t*)smem;
      {
        float lg[8], lb[8];
#pragma unroll
        for (int i = 0; i < 8; ++i) { lg[i] = ln_c_g[ch0 + i]; lb[i] = ln_c_b[ch0 + i]; }
        uint4 vv[4];
#pragma unroll
        for (int p = 0; p < 4; ++p) vv[p] = *(const uint4*)(z + (size_t)(t0 + r8 + 32 * p) * INC + 1920 + ch0);
#pragma unroll
        for (int p = 0; p < 4; ++p) {
          float v[8];
          unpack8(vv[p], v);
          float sm = ((v[0] + v[1]) + (v[2] + v[3])) + ((v[4] + v[5]) + (v[6] + v[7]));
          float mean = group8_sum(sm) * (1.0f / 64);
          float sq = 0.f;
#pragma unroll
          for (int i = 0; i < 8; ++i) { v[i] -= mean; sq += v[i] * v[i]; }
          float rstd = __builtin_amdgcn_rsqf(group8_sum(sq) * (1.0f / 64) + EPS);
          const int r = r8 + 32 * p;
#pragma unroll
          for (int i = 0; i < 8; ++i) vnT[(c8 * 8 + i) * 136 + r] = f2bf(v[i] * rstd * lg[i] + lb[i]);
        }
      }
      __syncthreads();
      const int fr = lane & 15, fq = lane >> 4;
      const bf16_t* wsh = wsb + (size_t)hc * 128 * 128;
      f32x4 acc[4][2];
#pragma unroll
      for (int mi = 0; mi < 4; ++mi)
#pragma unroll
        for (int ni = 0; ni < 2; ++ni) acc[mi][ni] = f32x4{0.f, 0.f, 0.f, 0.f};
      const int nkk = (wid < 2) ? 2 : 4;
      for (int kk = 0; kk < nkk; ++kk) {
        bf16x8 af[4], bf_[2];
#pragma unroll
        for (int ni = 0; ni < 2; ++ni) bf_[ni] = *(const bf16x8*)(wsh + (size_t)(wid * 32 + ni * 16 + fr) * 128 + kk * 32 + fq * 8);
#pragma unroll
        for (int mi = 0; mi < 4; ++mi) af[mi] = *(const bf16x8*)(vnT + (mi * 16 + fr) * 136 + kk * 32 + fq * 8);
#pragma unroll
        for (int mi = 0; mi < 4; ++mi)
#pragma unroll
          for (int ni = 0; ni < 2; ++ni)
            acc[mi][ni] = __builtin_amdgcn_mfma_f32_16x16x32_bf16(af[mi], bf_[ni], acc[mi][ni], 0, 0, 0);
      }
#pragma unroll
      for (int ni = 0; ni < 2; ++ni) {
        const int i = wid * 32 + ni * 16 + fr;
        const float bsv = b_s[hc * 128 + i];
#pragma unroll
        for (int mi = 0; mi < 4; ++mi) {
          const int chb = hc * 64 + mi * 16 + fq * 4;
          uint2 uu = *(const uint2*)(z + (size_t)(t0 + i) * INC + 1536 + chb);
          uint2 pk;
          pk.x = pack2(bflo(uu.x) * (acc[mi][ni][0] + bsv), bfhi(uu.x) * (acc[mi][ni][1] + bsv));
          pk.y = pack2(bflo(uu.y) * (acc[mi][ni][2] + bsv), bfhi(uu.y) * (acc[mi][ni][3] + bsv));
          *(uint2*)(y + (size_t)(t0 + i) * D + 640 + chb) = pk;
        }
      }
      __syncthreads();
    }
  }
}

__device__ __forceinline__ void ins16(float (&lv)[16], float v) {
#pragma unroll
  for (int i = 0; i < 16; ++i) {
    float t = fmaxf(lv[i], v);
    v = fminf(lv[i], v);
    lv[i] = t;
  }
}

__device__ __forceinline__ void bitonic_sort16_desc(float (&v)[16]) {
#pragma unroll
  for (int k = 2; k <= 16; k <<= 1) {
#pragma unroll
    for (int j = k >> 1; j > 0; j >>= 1) {
#pragma unroll
      for (int i = 0; i < 16; ++i) {
        const int l = i ^ j;
        if (l > i) {
          const bool desc = ((i & k) == 0);
          const float hi = fmaxf(v[i], v[l]), lo = fminf(v[i], v[l]);
          v[i] = desc ? hi : lo; v[l] = desc ? lo : hi;
        }
      }
    }
  }
}
__device__ __forceinline__ void merge_top16(float (&a)[16], const float (&b)[16]) {
#pragma unroll
  for (int i = 0; i < 16; ++i) a[i] = fmaxf(a[i], b[15 - i]);
#pragma unroll
  for (int j = 8; j > 0; j >>= 1) {
#pragma unroll
    for (int i = 0; i < 16; ++i) {
      const int l = i ^ j;
      if (l > i) {
        const float hi = fmaxf(a[i], a[l]), lo = fminf(a[i], a[l]);
        a[i] = hi; a[l] = lo;
      }
    }
  }
}
__device__ __forceinline__ void phase_scores(const int TIDX, const int BIDX, const bf16_t* __restrict__ q, const bf16_t* __restrict__ keys  ,
                             int* __restrict__ idxo, float* __restrict__ gateo, char* smem) {
  const int tid = TIDX, lane = tid & 63, wid = tid >> 6;
  const int wr = wid >> 1, wc = wid & 1, fr = lane & 15, fq = lane >> 4;
  float* sT = (float*)smem;
  unsigned* slot = (unsigned*)smem;
  const int m = tid & 127, part = (tid >> 7) ^ ((BIDX >= (int)gridDim.x) ? 1 : 0);
  u32x4_k pra[4], prb[4];
  if (BIDX < 512 * 8) gemm_kloop_issue(tid, q + (size_t)(BIDX >> 3) * 128 * 2048 + (BIDX & 7) * 256, 2048, keys + (size_t)((BIDX & 7) * 2) * 128 * 128, 128, pra, prb);
  const int vstep = VGRID;
  for (int item = BIDX; item < 512 * 8; item += vstep) {
    const int tt = item >> 3, hd = item & 7;
    int tid_i = tid;
    asm volatile("" : "+v"(tid_i));
    float v1[16], v2[16];
#pragma unroll
    for (int half = 0; half < 2; ++half) {
      f32x4 acc[4][4];
      gemm_kloop(tid_i, BIDX, q + (size_t)tt * 128 * 2048 + hd * 256 + half * 128, 2048,
                 keys + (size_t)(hd * 2 + half) * 128 * 128, 128, 128, smem, acc, pra, prb);
      if (half == 0) {
        gemm_kloop_issue(tid_i, q + (size_t)tt * 128 * 2048 + hd * 256 + 128, 2048, keys + (size_t)(hd * 2 + 1) * 128 * 128, 128, pra, prb);
      } else if (item + vstep < 512 * 8) {
        const int ni = item + vstep;
        gemm_kloop_issue(tid_i, q + (size_t)(ni >> 3) * 128 * 2048 + (ni & 7) * 256, 2048, keys + (size_t)((ni & 7) * 2) * 128 * 128, 128, pra, prb);
      }
      float* sbase = sT + (wc * 64 + fq * 4) * 128 + wr * 64 + fr;
#pragma unroll
      for (int mi = 0; mi < 4; ++mi)
#pragma unroll
        for (int ni = 0; ni < 4; ++ni)
#pragma unroll
          for (int j = 0; j < 4; ++j)
            sbase[ni * 2048 + j * 128 + mi * 16] = acc[mi][ni][j];
      __syncthreads();
      float lv[16];
#pragma unroll
      for (int c = 0; c < 4; ++c) {
        float ck[16];
        int pb = part * 64;
        asm volatile("" : "+v"(pb));
        const float* srow = sT + pb * 128 + m;
#pragma unroll
        for (int i = 0; i < 16; ++i) {
          const int key = pb + c * 16 + i;
          ck[i] = __uint_as_float((__float_as_uint(srow[(c * 16 + i) * 128]) & 0xffffff80u) | (unsigned)key);
        }
        bitonic_sort16_desc(ck);
        if (c == 0) {
#pragma unroll
          for (int i = 0; i < 16; ++i) lv[i] = ck[i];
        } else {
          merge_top16(lv, ck);
        }
        __builtin_amdgcn_sched_barrier(0);
      }
      __syncthreads();
      if (part == 1) {
#pragma unroll
        for (int i = 0; i < 16; ++i) sT[i * 128 + m] = lv[i];
      }
      __syncthreads();
      if (part == 0) {
        float ob[16];
#pragma unroll
        for (int i = 0; i < 16; ++i) ob[i] = sT[i * 128 + m];
        merge_top16(lv, ob);
      }
      __syncthreads();
      if (half == 0) {
#pragma unroll
        for (int i = 0; i < 16; ++i) v1[i] = lv[i];
      } else {
#pragma unroll
        for (int i = 0; i < 16; ++i) v2[i] = lv[i];
      }
    }
    if (part == 0) {
#pragma unroll
      for (int i = 0; i < 16; ++i) {
        slot[m * 33 + i] = __float_as_uint(v1[i]);
        slot[m * 33 + 16 + i] = __float_as_uint(v2[i]);
      }
      float fv[16];
#pragma unroll
      for (int i = 0; i < 16; ++i) fv[i] = -3.0e38f;
#pragma unroll
      for (int a = 0; a < 16; ++a)
#pragma unroll
        for (int b = 0; b < 16; ++b)
          if ((a + 1) * (b + 1) <= 16) {
            float sum = __uint_as_float(__float_as_uint(v1[a]) & 0xffffff80u) + __uint_as_float(__float_as_uint(v2[b]) & 0xffffff80u);
            unsigned u = (__float_as_uint(sum) & 0xffffff00u) | (unsigned)(a * 16 + b);
            ins16(fv, __uint_as_float(u));
          }
      float e[16];
      int ex[16];
      float mx = __uint_as_float(__float_as_uint(fv[0]) & 0xffffff00u), sum = 0.f;
#pragma unroll
      for (int i = 0; i < 16; ++i) {
        unsigned u = __float_as_uint(fv[i]);
        int code = (int)(u & 0xffu);
        float val = __uint_as_float(u & 0xffffff00u);
        int k1 = (int)(slot[m * 33 + (code >> 4)] & 127u);
        int k2 = (int)(slot[m * 33 + 16 + (code & 15)] & 127u);
        ex[i] = k1 * 128 + k2;
        e[i] = __expf(val - mx);
        sum += e[i];
      }
      float inv = __builtin_amdgcn_rcpf(sum);
      size_t o = (size_t)(tt * 128 + m) * 128 + hd * 16;
#pragma unroll
      for (int i = 0; i < 16; i += 4) {
        *(int4*)(idxo + o + i) = int4{ex[i], ex[i + 1], ex[i + 2], ex[i + 3]};
        *(float4*)(gateo + o + i) = float4{e[i] * inv, e[i + 1] * inv, e[i + 2] * inv, e[i + 3] * inv};
      }
    }
    __syncthreads();
  }
}

__device__ __forceinline__ void peer_issue(uint4 (&buf)[8], const unsigned char* __restrict__ tab, int idv, int gp, int lane) {
#pragma unroll
  for (int e = 0; e < 8; ++e) {
    const unsigned ex = (unsigned)__builtin_amdgcn_readlane(idv, 8 * e + gp);
    const unsigned char* rowp = tab + ((size_t)ex << 10);
    buf[e] = *(const uint4*)(rowp + (unsigned)(lane << 4));
  }
}
__device__ __forceinline__ float peer_dot(const uint4& r, const f32x2 (&x2)[8]) {
  f32x2 a0 = __builtin_amdgcn_cvt_pk_f32_fp8((int)r.x, false) * x2[0];
  f32x2 a1 = __builtin_amdgcn_cvt_pk_f32_fp8((int)r.x, true) * x2[1];
  a0 += __builtin_amdgcn_cvt_pk_f32_fp8((int)r.y, false) * x2[2];
  a1 += __builtin_amdgcn_cvt_pk_f32_fp8((int)r.y, true) * x2[3];
  a0 += __builtin_amdgcn_cvt_pk_f32_fp8((int)r.z, false) * x2[4];
  a1 += __builtin_amdgcn_cvt_pk_f32_fp8((int)r.z, true) * x2[5];
  a0 += __builtin_amdgcn_cvt_pk_f32_fp8((int)r.w, false) * x2[6];
  a1 += __builtin_amdgcn_cvt_pk_f32_fp8((int)r.w, true) * x2[7];
  a0 += a1;
  return a0.x + a0.y;
}
__device__ __forceinline__ void fmac1(float& o, float a, float x) { asm("v_fmac_f32 %0, %1, %2" : "+v"(o) : "v"(a), "v"(x)); }
__device__ __forceinline__ void peer_axpy(const uint4& r, float a, float (&o)[16]) {
  f32x2 c;
  c = __builtin_amdgcn_cvt_pk_f32_fp8((int)r.x, false); fmac1(o[0], a, c.x); fmac1(o[1], a, c.y);
  c = __builtin_amdgcn_cvt_pk_f32_fp8((int)r.x, true);  fmac1(o[2], a, c.x); fmac1(o[3], a, c.y);
  c = __builtin_amdgcn_cvt_pk_f32_fp8((int)r.y, false); fmac1(o[4], a, c.x); fmac1(o[5], a, c.y);
  c = __builtin_amdgcn_cvt_pk_f32_fp8((int)r.y, true);  fmac1(o[6], a, c.x); fmac1(o[7], a, c.y);
  c = __builtin_amdgcn_cvt_pk_f32_fp8((int)r.z, false); fmac1(o[8], a, c.x); fmac1(o[9], a, c.y);
  c = __builtin_amdgcn_cvt_pk_f32_fp8((int)r.z, true);  fmac1(o[10], a, c.x); fmac1(o[11], a, c.y);
  c = __builtin_amdgcn_cvt_pk_f32_fp8((int)r.w, false); fmac1(o[12], a, c.x); fmac1(o[13], a, c.y);
  c = __builtin_amdgcn_cvt_pk_f32_fp8((int)r.w, true);  fmac1(o[14], a, c.x); fmac1(o[15], a, c.y);
}
__device__ __forceinline__ float reduce8(float (&p)[8], int lane) {
  float q[4];
#pragma unroll
  for (int j = 0; j < 4; ++j) {
    auto r = __builtin_amdgcn_permlane32_swap(__float_as_uint(p[j]), __float_as_uint(p[j + 4]), false, false);
    q[j] = __uint_as_float(r[0]) + __uint_as_float(r[1]);
  }
  float s2[2];
#pragma unroll
  for (int j = 0; j < 2; ++j) {
    auto r = __builtin_amdgcn_permlane16_swap(__float_as_uint(q[j]), __float_as_uint(q[j + 2]), false, false);
    s2[j] = __uint_as_float(r[0]) + __uint_as_float(r[1]);
  }
  const bool b3 = (lane & 8) != 0;
  float keep = b3 ? s2[1] : s2[0];
  float give = b3 ? s2[0] : s2[1];
  float w = keep + dpp_f<0x128>(give);
  w += dpp_f<0xB1>(w);
  w += dpp_f<0x4E>(w);
  w += dpp_f<0x141>(w);
  return w;
}

__device__ __forceinline__ void phase_peer_u(const int TIDX, const int BIDX, const unsigned char* __restrict__ Eu,
                                             const int* __restrict__ idx, const bf16_t* __restrict__ h16, const float* __restrict__ gffn, float* __restrict__ pd, char* smem) {
  const int lane = TIDX & 63, wid = TIDX >> 6;
  const int x = BIDX & 7;
  int nWs = (VGRID >> 3) * 4;
  asm volatile("" : "+s"(nWs));
  const int wslot = __builtin_amdgcn_readfirstlane((BIDX >> 3) * 4 + wid);
  const int g8 = lane >> 3, c8 = lane & 7;
  const int fr = lane & 15, fq = lane >> 4;
  const unsigned char* tabc = Eu + (size_t)x * ((size_t)NEXP * 128) + (unsigned)(c8 * 16);
  const unsigned colq = (unsigned)(x * 128 + fq * 16);
  typedef __attribute__((address_space(3))) char lds_char;
  typedef unsigned u32x4_t __attribute__((ext_vector_type(4)));
  typedef __attribute__((address_space(3))) u32x4_t lds_uint4;
  lds_char* lw = (lds_char*)smem + wid * 9216;
  const int woff = g8 * 144 + c8 * 16;
  const int roff = fr * 144 + fq * 16;
  int t = wslot;
  if (t >= T) return;
  int idn[16];
  u32x4_t r[16];
  float gq8[32];
#pragma unroll
  for (int i = 0; i < 16; ++i) { gq8[i] = gffn[colq + i] * 8.0f; gq8[16 + i] = gffn[colq + 64 + i] * 8.0f; }
  typedef __attribute__((address_space(3))) int lds_i;
  typedef __attribute__((address_space(3))) unsigned lds_u;
  lds_i* li = (lds_i*)((lds_char*)smem + 36864 + wid * 1024);
  lds_u* lh = (lds_u*)((lds_char*)smem + 36864 + wid * 1024 + 512);
  int ri0 = idx[(size_t)t * 128 + lane], ri1 = idx[(size_t)t * 128 + 64 + lane];
  unsigned rh = *(const unsigned*)(h16 + (size_t)t * D + x * 128 + 2 * lane);
  li[lane] = ri0; li[64 + lane] = ri1;
  __builtin_amdgcn_wave_barrier();
#pragma unroll
  for (int j = 0; j < 16; ++j) idn[j] = li[8 * j + g8];
#pragma unroll
  for (int j = 0; j < 16; ++j) r[j] = *(const u32x4_t*)(tabc + ((size_t)(unsigned)idn[j] << 7));
  __builtin_amdgcn_wave_barrier();
  if (t + nWs < T) { ri0 = idx[(size_t)(t + nWs) * 128 + lane]; ri1 = idx[(size_t)(t + nWs) * 128 + 64 + lane]; }
  for (; t < T; t += nWs) {
    const int tn = t + nWs, tnn = t + 2 * nWs;
    const bool hasn = tn < T;
    li[lane] = ri0; li[64 + lane] = ri1;
    lh[lane] = rh;
    __builtin_amdgcn_wave_barrier();
#pragma unroll
    for (int j = 0; j < 16; ++j) idn[j] = li[8 * j + g8];
    u32x4_t nc[4];
    nc[0] = *(const lds_uint4*)(lh + fq * 8); nc[1] = *(const lds_uint4*)(lh + fq * 8 + 4);
    nc[2] = *(const lds_uint4*)(lh + 32 + fq * 8); nc[3] = *(const lds_uint4*)(lh + 32 + fq * 8 + 4);
    __builtin_amdgcn_wave_barrier();
    if (hasn) rh = *(const unsigned*)(h16 + (size_t)tn * D + x * 128 + 2 * lane);
    if (tnn < T) { ri0 = idx[(size_t)tnn * 128 + lane]; ri1 = idx[(size_t)tnn * 128 + 64 + lane]; }
    long b8[4];
#pragma unroll
    for (int hh = 0; hh < 2; ++hh) {
      float fv[16];
      const u32x4_t ua = nc[2 * hh], ub = nc[2 * hh + 1];
      fv[0] = bflo(ua.x); fv[1] = bfhi(ua.x); fv[2] = bflo(ua.y); fv[3] = bfhi(ua.y);
      fv[4] = bflo(ua.z); fv[5] = bfhi(ua.z); fv[6] = bflo(ua.w); fv[7] = bfhi(ua.w);
      fv[8] = bflo(ub.x); fv[9] = bfhi(ub.x); fv[10] = bflo(ub.y); fv[11] = bfhi(ub.y);
      fv[12] = bflo(ub.z); fv[13] = bfhi(ub.z); fv[14] = bflo(ub.w); fv[15] = bfhi(ub.w);
      unsigned w[4];
#pragma unroll
      for (int i = 0; i < 4; ++i) {
        int t8 = __builtin_amdgcn_cvt_pk_fp8_f32(fv[4 * i] * gq8[16 * hh + 4 * i], fv[4 * i + 1] * gq8[16 * hh + 4 * i + 1], 0, false);
        t8 = __builtin_amdgcn_cvt_pk_fp8_f32(fv[4 * i + 2] * gq8[16 * hh + 4 * i + 2], fv[4 * i + 3] * gq8[16 * hh + 4 * i + 3], t8, true);
        w[i] = (unsigned)t8;
      }
      b8[2 * hh] = (long)(((unsigned long)w[1] << 32) | w[0]);
      b8[2 * hh + 1] = (long)(((unsigned long)w[3] << 32) | w[2]);
    }
    f32x4 accs[8];
    __builtin_amdgcn_sched_barrier(0);
#define U_QUARTER(q) { \
      lds_char* lb = lw + ((q) & 1) * 4608; \
      *(lds_uint4*)(lb + woff + 0 * 8 * 144) = r[(q) * 4 + 0]; \
      if (hasn) r[(q) * 4 + 0] = *(const u32x4_t*)(tabc + ((size_t)(unsigned)idn[(q) * 4 + 0] << 7)); \
      *(lds_uint4*)(lb + woff + 1 * 8 * 144) = r[(q) * 4 + 1]; \
      if (hasn) r[(q) * 4 + 1] = *(const u32x4_t*)(tabc + ((size_t)(unsigned)idn[(q) * 4 + 1] << 7)); \
      *(lds_uint4*)(lb + woff + 2 * 8 * 144) = r[(q) * 4 + 2]; \
      if (hasn) r[(q) * 4 + 2] = *(const u32x4_t*)(tabc + ((size_t)(unsigned)idn[(q) * 4 + 2] << 7)); \
      *(lds_uint4*)(lb + woff + 3 * 8 * 144) = r[(q) * 4 + 3]; \
      if (hasn) r[(q) * 4 + 3] = *(const u32x4_t*)(tabc + ((size_t)(unsigned)idn[(q) * 4 + 3] << 7)); \
      _Pragma("unroll") for (int eg = 0; eg < 2; ++eg) { \
        const u32x4_t a0 = *(const lds_uint4*)(lb + roff + eg * 16 * 144); \
        const u32x4_t a1 = *(const lds_uint4*)(lb + roff + eg * 16 * 144 + 64); \
        f32x4 acc = f32x4{0.f, 0.f, 0.f, 0.f}; \
        acc = __builtin_amdgcn_mfma_f32_16x16x32_fp8_fp8((long)(((unsigned long)a0.y << 32) | a0.x), b8[0], acc, 0, 0, 0); \
        acc = __builtin_amdgcn_mfma_f32_16x16x32_fp8_fp8((long)(((unsigned long)a0.w << 32) | a0.z), b8[1], acc, 0, 0, 0); \
        acc = __builtin_amdgcn_mfma_f32_16x16x32_fp8_fp8((long)(((unsigned long)a1.y << 32) | a1.x), b8[2], acc, 0, 0, 0); \
        acc = __builtin_amdgcn_mfma_f32_16x16x32_fp8_fp8((long)(((unsigned long)a1.w << 32) | a1.z), b8[3], acc, 0, 0, 0); \
        accs[(q) * 2 + eg] = acc; \
      } \
      __builtin_amdgcn_sched_barrier(0); }
    U_QUARTER(0) U_QUARTER(1) U_QUARTER(2) U_QUARTER(3)
#undef U_QUARTER
    {
      f32x4 sel = accs[0];
#pragma unroll
      for (int k = 1; k < 8; ++k) sel = (fr == k) ? accs[k] : sel;
      if (fr < 8) { uint2 pk; pk.x = pack2(sel[0], sel[1]); pk.y = pack2(sel[2], sel[3]);
        *(uint2*)((bf16_t*)pd + ((size_t)x * T + t) * 128 + fr * 16 + fq * 4) = pk; }
    }
  }
}

__device__ __forceinline__ void phase_peer_act(const int TIDX, const int BIDX, const float* __restrict__ pd, const int* __restrict__ idx,
                                               const float* __restrict__ gate, const float* __restrict__ su, const float* __restrict__ sv,
                                               const float* __restrict__ ssq, float* __restrict__ act) {
  const size_t gtid = (size_t)BIDX * 256 + TIDX, gsz = (size_t)VGRID * 256;
  constexpr size_t N8 = (size_t)T * 16;
  for (size_t u8 = gtid; u8 < N8; u8 += gsz) {
    uint4 p[8];
#pragma unroll
    for (int x = 0; x < 8; ++x) p[x] = ((const uint4*)((const bf16_t*)pd + (size_t)x * T * 128))[u8];
    const int4 e0 = ((const int4*)idx)[2 * u8], e1 = ((const int4*)idx)[2 * u8 + 1];
    const float4 g0 = ((const float4*)gate)[2 * u8], g1 = ((const float4*)gate)[2 * u8 + 1];
    float suv[8], svv[8];
    suv[0] = su[e0.x]; suv[1] = su[e0.y]; suv[2] = su[e0.z]; suv[3] = su[e0.w];
    suv[4] = su[e1.x]; suv[5] = su[e1.y]; suv[6] = su[e1.z]; suv[7] = su[e1.w];
    svv[0] = sv[e0.x]; svv[1] = sv[e0.y]; svv[2] = sv[e0.z]; svv[3] = sv[e0.w];
    svv[4] = sv[e1.x]; svv[5] = sv[e1.y]; svv[6] = sv[e1.z]; svv[7] = sv[e1.w];
    const float rsq = __builtin_amdgcn_rsqf(ssq[u8 >> 4] * (1.0f / D) + EPS) * 0.125f;
    float d[8];
#pragma unroll
    for (int i = 0; i < 8; ++i) d[i] = 0.f;
#pragma unroll
    for (int x = 0; x < 8; ++x) {
      d[0] += bflo(p[x].x); d[1] += bfhi(p[x].x); d[2] += bflo(p[x].y); d[3] += bfhi(p[x].y);
      d[4] += bflo(p[x].z); d[5] += bfhi(p[x].z); d[6] += bflo(p[x].w); d[7] += bfhi(p[x].w);
    }
    const float gv[8] = {g0.x, g0.y, g0.z, g0.w, g1.x, g1.y, g1.z, g1.w};
    float o[8];
#pragma unroll
    for (int i = 0; i < 8; ++i) o[i] = gelu_tanh(d[i] * suv[i] * rsq) * gv[i] * svv[i];
    uint4 ob; ob.x = pack2(o[0], o[1]); ob.y = pack2(o[2], o[3]); ob.z = pack2(o[4], o[5]); ob.w = pack2(o[6], o[7]);
    ((uint4*)act)[u8] = ob;
  }
}

__device__ __forceinline__ void phase_peer_v(const int TIDX, const int BIDX, const unsigned char* __restrict__ Ev,
                                             const int* __restrict__ idx, const float* __restrict__ act, bf16_t* h, bf16_t* a3,
                                             float* __restrict__ ssq, char* smem) {
  const int lane = TIDX & 63, wid = TIDX >> 6;
  const int x = BIDX & 7;
  int nWs = (VGRID >> 3) * 4;
  asm volatile("" : "+s"(nWs));
  const int wslot = __builtin_amdgcn_readfirstlane((BIDX >> 3) * 4 + wid);
  const int g = lane >> 3, c8 = lane & 7;
  const unsigned char* tabc = Ev + (size_t)x * ((size_t)NEXP * 128) + (unsigned)(c8 * 16);
  typedef __attribute__((address_space(3))) int lds_i;
  typedef __attribute__((address_space(3))) float lds_f;
  typedef int i32x4_t __attribute__((ext_vector_type(4)));
  typedef float f32x4_t __attribute__((ext_vector_type(4)));
  typedef __attribute__((address_space(3))) i32x4_t lds_i4;
  typedef __attribute__((address_space(3))) f32x4_t lds_f4;
  lds_i* li = (lds_i*)((__attribute__((address_space(3))) char*)smem + wid * 1024);
  typedef __attribute__((address_space(3))) unsigned lds_u;
  typedef unsigned u32x4_a __attribute__((ext_vector_type(4)));
  typedef __attribute__((address_space(3))) u32x4_a lds_u4;
  lds_u* lf = (lds_u*)((__attribute__((address_space(3))) char*)smem + wid * 1024 + 512);
  int t = wslot;
  if (t >= T) return;
  typedef unsigned u32x4_t __attribute__((ext_vector_type(4)));
  u32x4_t r[16];
  i32x4_t idn[4];
  float ac[16];
  int ri0 = idx[(size_t)t * 128 + lane], ri1 = idx[(size_t)t * 128 + 64 + lane];
  unsigned ra = ((const unsigned*)act)[(size_t)t * 64 + lane];
  li[lane] = ri0; li[64 + lane] = ri1;
  __builtin_amdgcn_wave_barrier();
#pragma unroll
  for (int q = 0; q < 4; ++q) idn[q] = *(const lds_i4*)(li + g * 16 + q * 4);
#pragma unroll
  for (int j = 0; j < 16; ++j) {
    const unsigned e = (unsigned)idn[j >> 2][j & 3];
    r[j] = *(const u32x4_t*)(tabc + ((size_t)e << 7));
  }
  __builtin_amdgcn_wave_barrier();
  if (t + nWs < T) { ri0 = idx[(size_t)(t + nWs) * 128 + lane]; ri1 = idx[(size_t)(t + nWs) * 128 + 64 + lane]; }
  for (; t < T; t += nWs) {
    const int tn = t + nWs, tnn = t + 2 * nWs;
    const bool hasn = tn < T;
    const int col = x * 128 + c8 * 16 + 2 * g;
    li[lane] = ri0; li[64 + lane] = ri1;
    lf[lane] = ra;
    __builtin_amdgcn_wave_barrier();
#pragma unroll
    for (int q = 0; q < 4; ++q) {
      idn[q] = *(const lds_i4*)(li + g * 16 + q * 4);
    }
    {
      const u32x4_a a0 = *(const lds_u4*)(lf + g * 8), a1 = *(const lds_u4*)(lf + g * 8 + 4);
      ac[0] = bflo(a0.x); ac[1] = bfhi(a0.x); ac[2] = bflo(a0.y); ac[3] = bfhi(a0.y);
      ac[4] = bflo(a0.z); ac[5] = bfhi(a0.z); ac[6] = bflo(a0.w); ac[7] = bfhi(a0.w);
      ac[8] = bflo(a1.x); ac[9] = bfhi(a1.x); ac[10] = bflo(a1.y); ac[11] = bfhi(a1.y);
      ac[12] = bflo(a1.z); ac[13] = bfhi(a1.z); ac[14] = bflo(a1.w); ac[15] = bfhi(a1.w);
    }
    __builtin_amdgcn_wave_barrier();
    const unsigned hp = *(const unsigned*)(h + (size_t)t * D + col);
    float2 hv = float2{bflo(hp), bfhi(hp)};
    if (hasn) ra = ((const unsigned*)act)[(size_t)tn * 64 + lane];
    if (tnn < T) { ri0 = idx[(size_t)tnn * 128 + lane]; ri1 = idx[(size_t)tnn * 128 + 64 + lane]; }
    __builtin_amdgcn_sched_barrier(0);
    float o[16];
#pragma unroll
    for (int i = 0; i < 16; ++i) o[i] = 0.f;
#pragma unroll
    for (int j = 0; j < 16; ++j) {
      peer_axpy(uint4{r[j].x, r[j].y, r[j].z, r[j].w}, ac[j], o);
      if (hasn) {
        const unsigned e = (unsigned)idn[j >> 2][j & 3];
        r[j] = *(const u32x4_t*)(tabc + ((size_t)e << 7));
      }
      __builtin_amdgcn_sched_barrier(0);
    }
    float q8[8];
#pragma unroll
    for (int i = 0; i < 8; ++i) {
      auto rr = __builtin_amdgcn_permlane32_swap(__float_as_uint(o[i]), __float_as_uint(o[i + 8]), false, false);
      q8[i] = __uint_as_float(rr[0]) + __uint_as_float(rr[1]);
    }
    float s4[4];
#pragma unroll
    for (int i = 0; i < 4; ++i) {
      auto rr = __builtin_amdgcn_permlane16_swap(__float_as_uint(q8[i]), __float_as_uint(q8[i + 4]), false, false);
      s4[i] = __uint_as_float(rr[0]) + __uint_as_float(rr[1]);
    }
    const bool b3 = (lane & 8) != 0;
    float w0 = (b3 ? s4[2] : s4[0]) + dpp_f<0x128>(b3 ? s4[0] : s4[2]);
    float w1 = (b3 ? s4[3] : s4[1]) + dpp_f<0x128>(b3 ? s4[1] : s4[3]);
    hv.x += w0; hv.y += w1;
    float ss = wave_sum(hv.x * hv.x + hv.y * hv.y);
    const unsigned hq = pack2(hv.x, hv.y);
    *(unsigned*)(h + (size_t)t * D + col) = hq;
    *(unsigned*)(a3 + (size_t)t * D + col) = hq;
    if (lane == 0) ssq[(size_t)x * T + t] = ss;
  }
}

#define XB_TMO      128
#define XB_XCNT(j)  (256  + 64 * (j))
#define XB_XSUB(j)  (1280 + 64 * (j))
#define XB_XGEN(j)  (2304 + 64 * (j))
#define XB_TOP      3328
#define XB_TOPGEN   3392
#define XCD_BAR_WORDS 3456
#define XB_SPIN_CAP (1u << 18)
#define LAS __attribute__((address_space(3)))

__device__ __forceinline__ unsigned xb_ld(unsigned* p)              { return __hip_atomic_load(p, __ATOMIC_RELAXED, __HIP_MEMORY_SCOPE_AGENT); }
__device__ __forceinline__ unsigned xb_add(unsigned* p, unsigned v) { return __hip_atomic_fetch_add(p, v, __ATOMIC_RELAXED, __HIP_MEMORY_SCOPE_AGENT); }
__device__ __forceinline__ unsigned xb_xcc_id() { return (unsigned)__builtin_amdgcn_s_getreg((3 << 11) | 20) & 0xFu; }
#define XB_SPIN(cond, bar) do { unsigned _sp = 0; while (cond) { __builtin_amdgcn_s_sleep(1); \
    if ((++_sp & 255u) == 0u) { if (xb_ld(&(bar)[XB_TMO])) break; if (_sp > XB_SPIN_CAP) { atomicAdd(&(bar)[XB_TMO], 1u); break; } } } } while (0)

struct XcdBarrier {
    unsigned* bar; unsigned x;
    volatile LAS unsigned* st;
};

__device__ __forceinline__ XcdBarrier xcd_barrier_post(unsigned* bar, volatile LAS unsigned* st) {
    XcdBarrier b; b.bar = bar; b.x = xb_xcc_id(); b.st = st;
    if (threadIdx.x == 0) (void)xb_add(&bar[XB_XCNT(b.x)], 1u);
    return b;
}
__device__ __forceinline__ void xcd_barrier_complete(unsigned* bar, unsigned x, unsigned& nloc, unsigned& nx) {
    const unsigned G = gridDim.x * gridDim.y * gridDim.z;
    unsigned sum, cnt, mine, sp = 0u;
    for (;;) {
        sum = 0u; cnt = 0u; mine = 0u;
#pragma unroll
        for (unsigned j = 0; j < 16; ++j) { const unsigned c = xb_ld(&bar[XB_XCNT(j)]); sum += c; cnt += (c > 0u) ? 1u : 0u; mine = (j == x) ? c : mine; }
        if (sum == G) break;
        __builtin_amdgcn_s_sleep(1);
        if ((++sp & 255u) == 0u) { if (xb_ld(&bar[XB_TMO])) break; if (sp > XB_SPIN_CAP) { atomicAdd(&bar[XB_TMO], 1u); break; } }
    }
    nloc = mine > 0u ? mine : 1u; nx = cnt > 0u ? cnt : 1u;
}

__device__ __forceinline__ void xcd_barrier(const XcdBarrier& b) {
    asm volatile("s_waitcnt vmcnt(0)" ::: "memory");
    __syncthreads();
    if (threadIdx.x == 0) {
        unsigned* bar = b.bar;
        __builtin_amdgcn_s_waitcnt(0);
        unsigned nloc = b.st[0], nx = b.st[1];
        if (nloc == 0u) { xcd_barrier_complete(bar, b.x, nloc, nx); b.st[0] = nloc; b.st[1] = nx; }
        const unsigned old = xb_add(&bar[XB_XSUB(b.x)], 1u);
        const unsigned gen = old / nloc;
        if (old + 1u == (gen + 1u) * nloc) {
            __builtin_amdgcn_fence(__ATOMIC_RELEASE, "agent");
            asm volatile("s_waitcnt vmcnt(0)" ::: "memory");
            const unsigned og = xb_add(&bar[XB_TOP], 1u);
            const unsigned tg = og / nx;
            if (og + 1u == (tg + 1u) * nx) xb_add(&bar[XB_TOPGEN], 1u);
            else XB_SPIN(xb_ld(&bar[XB_TOPGEN]) == tg, bar);
            __builtin_amdgcn_fence(__ATOMIC_ACQUIRE, "agent");
            xb_add(&bar[XB_XGEN(b.x)], 1u);
            asm volatile("s_waitcnt vmcnt(0)" ::: "memory");
        } else {
            XB_SPIN(xb_ld(&bar[XB_XGEN(b.x)]) == gen, bar);
            __builtin_amdgcn_fence(__ATOMIC_ACQUIRE, "agent");
            asm volatile("s_waitcnt vmcnt(0)" ::: "memory");
        }
    }
    __syncthreads();
}

__device__ __forceinline__ int rebuild_tid(const int wave_id) {
  int lane_id;
  asm volatile("v_mbcnt_lo_u32_b32 %0, -1, 0\n\tv_mbcnt_hi_u32_b32 %0, -1, %0" : "=v"(lane_id));
  return wave_id * 64 + lane_id;
}
__device__ __forceinline__ void run_phase(const int WAVE_ID, const int BL, const Params& P, int ph, char* smem_all) {
  char* ws = P.ws;
  bf16_t* abuf = (bf16_t*)(ws + OFF_ABUF);
  bf16_t* zb = (bf16_t*)(ws + OFF_Z);
  bf16_t* h = (bf16_t*)(ws + OFF_H);
#define VB_PROLOGUE int t2 = rebuild_tid(WAVE_ID); const int TIDX = t2 & 255; const int half_ = __builtin_amdgcn_readfirstlane(t2 >> 8); const int BIDX = BL + half_ * (int)gridDim.x; char* smem = smem_all + half_ * 65536; (void)smem;
  if (ph == 0) { VB_PROLOGUE phase_convert(TIDX, BIDX, P); return; }
  if (ph == NPHASE - 1) { VB_PROLOGUE phase_norm<2, true>(TIDX, BIDX, h, P.in[22], nullptr, P.out); return; }
  const int L = (ph - 1) / 11, s = (ph - 1) % 11;
  const unsigned char* Eu = (const unsigned char*)(ws + OFF_EU) + (size_t)L * NEXP * 1024;
  const unsigned char* Ev = (const unsigned char*)(ws + OFF_EV) + (size_t)L * NEXP * 1024;
  const float* su = (const float*)(ws + OFF_ESC) + L * NEXP;
  const float* sv = (const float*)(ws + OFF_ESC) + (2 + L) * NEXP;
  int* idxb = (int*)(ws + OFF_IDX);
  float* gateb = (float*)(ws + OFF_GATE);
  float* pd = (float*)(ws + OFF_Z);
  float* actb = (float*)(ws + OFF_ACT);
  float* ssq = (float*)(ws + OFF_SSQ);
  float* ssqA = (float*)(ws + OFF_SSQA);
  float* ssqB = (float*)(ws + OFF_SSQB);
  switch (s) {
    case 0: { VB_PROLOGUE phase_norm<0, false>(TIDX, BIDX, P.in[0], nullptr, abuf, nullptr); } break;
    case 1: if (L == 0) run_gemm(rebuild_tid(WAVE_ID), BL, smem_all, abuf, (const bf16_t*)(ws + OFF_WINT), 2304, 1024, pg8::EpiBf16<0>{zb, 2304, nullptr, 0, 0});
            else run_gemm(rebuild_tid(WAVE_ID), BL, smem_all, h, (const bf16_t*)(ws + OFF_WINT) + (size_t)2304 * 1024, 2304, 1024, EpiBf16Rs{zb, 2304, ssqB, WAVE_ID}); break;
    case 2: { VB_PROLOGUE for (int i = BIDX * 256 + TIDX; i < T; i += VGRID * 256) ssqA[i] = 0.f;
      phase_mix(TIDX, BIDX, P, L, zb, abuf, (const bf16_t*)(ws + OFF_WSB) + (size_t)L * 6 * 128 * 128, smem); } break;
    case 3: if (L == 0) run_gemm(rebuild_tid(WAVE_ID), BL, smem_all, abuf, (const bf16_t*)(ws + OFF_WOUTT), 1024, 1024, EpiResid<false>{P.in[0], h, ssqA, WAVE_ID});
            else run_gemm(rebuild_tid(WAVE_ID), BL, smem_all, abuf, (const bf16_t*)(ws + OFF_WOUTT) + (size_t)1024 * 1024, 1024, 1024, EpiResid<true>{h, h, ssqA, WAVE_ID}); break;
    case 4: break;
    case 5: run_gemm(rebuild_tid(WAVE_ID), BL, smem_all, h, (const bf16_t*)(ws + OFF_WQT) + (size_t)L * 2048 * 1024, 2048, 1024, EpiBf16Rs{zb, 2048, ssqA, WAVE_ID}); break;
    case 6: { VB_PROLOGUE
      phase_scores(TIDX, BIDX, zb, (const bf16_t*)(ws + OFF_KEYS) + (size_t)L * 8 * 2 * 128 * 128, idxb, gateb, smem); } break;
    case 7: { VB_PROLOGUE
      phase_peer_u(TIDX, BIDX, Eu, idxb, h, P.in[14] + L * 1024, pd, smem); } break;
    case 8: { VB_PROLOGUE for (int i = BIDX * 256 + TIDX; i < T; i += VGRID * 256) ssqB[i] = 0.f;
      phase_peer_act(TIDX, BIDX, pd, idxb, gateb, su, sv, ssqA, actb); } break;
    case 9: { VB_PROLOGUE phase_peer_v(TIDX, BIDX, Ev, idxb, actb, h, abuf, ssq, smem); } break;
    case 10:
      run_gemm(rebuild_tid(WAVE_ID), BL, smem_all, abuf, (const bf16_t*)(ws + OFF_WPGT) + (size_t)L * 1024 * 1024, 1024, 1024, EpiSig{ssq, zb, WAVE_ID});
      run_gemm(rebuild_tid(WAVE_ID), BL, smem_all, (const bf16_t*)(ws + OFF_PBF) + (size_t)L * T * 256, (const bf16_t*)(ws + OFF_WPET) + (size_t)L * 1024 * 256, 1024, 256, EpiPle{h, zb, ssqB, WAVE_ID});
      break;
  }
}

__global__ void __launch_bounds__(512, 2) peer_trunk_mk(Params P) {
  extern __shared__ __attribute__((aligned(16))) char smem[];
  cg::grid_group grid = cg::this_grid();
  unsigned* bar = (unsigned*)(P.ws + OFF_BAR);
  volatile LAS unsigned* st = (volatile LAS unsigned*)((LAS char*)smem + 131072);
  if (threadIdx.x == 0) { st[0] = 0u; st[1] = 0u; }
  if (blockIdx.x == 0) { for (int i = threadIdx.x; i < XCD_BAR_WORDS; i += 512) bar[i] = 0u; }
  __syncthreads();
  XcdBarrier xb{};
  const int wave_id = __builtin_amdgcn_readfirstlane((int)threadIdx.x >> 6);
  int ph = P.ph_lo;
#ifdef PROBE_DUP
  int dup_left = 1;
#endif
  while (ph < P.ph_hi) {
    int bl = (int)__builtin_amdgcn_workgroup_id_x();
    asm volatile("" : "+s"(bl));
    run_phase(wave_id, bl, P, ph, smem);
    int nph = ph + 1;
    while (nph < NPHASE - 1 && (((nph - 1) % 11) == 4 || nph == 12)) ++nph;
#ifdef PROBE_DUP
    if (ph == 1 + PROBE_DUP && dup_left) { dup_left = 0; nph = ph; }
#endif
    if (nph < P.ph_hi) {
      if (ph == 0) { grid.sync(); xb = xcd_barrier_post(bar, st); }
      else xcd_barrier(xb);
    }
    ph = nph;
  }
}

extern "C" void kernel_launch(void* const* d_in, const int* in_sizes, int n_in, void* d_out, int out_size,
                              void* d_ws, size_t ws_size, hipStream_t stream) {
  static int grid_blocks = 0;
  if (grid_blocks == 0) {
    if (n_in != 23 || ws_size < WS_END) { fprintf(stderr, "kernel_launch: unexpected n_in %d or ws_size %zu (< %zu)\n", n_in, ws_size, (size_t)WS_END); grid_blocks = -1; return; }
    int dev = 0, cus = 0, per_cu = 0;
    hipGetDevice(&dev);
    hipDeviceGetAttribute(&cus, hipDeviceAttributeMultiprocessorCount, dev);
    hipFuncSetAttribute((const void*)peer_trunk_mk, hipFuncAttributeMaxDynamicSharedMemorySize, SMEM_BYTES);
    hipOccupancyMaxActiveBlocksPerMultiprocessor(&per_cu, (const void*)peer_trunk_mk, 512, SMEM_BYTES);
    if (per_cu < 1) per_cu = 1;
    if (per_cu > 1) per_cu = 1;
    grid_blocks = cus * per_cu;
    fprintf(stderr, "kernel_launch: cus %d per_cu %d grid %d\n", cus, per_cu, grid_blocks);
  }
  if (grid_blocks < 0) return;
  Params P{};
  for (int i = 0; i < 23; ++i) P.in[i] = (const float*)d_in[i];
  P.out = (float*)d_out;
  P.ws = (char*)d_ws;
#if ONE_LAUNCH
  P.ph_lo = 0; P.ph_hi = NPHASE;
  void* args[] = {&P};
  hipError_t e = hipLaunchCooperativeKernel((void*)peer_trunk_mk, dim3(grid_blocks), dim3(512), args, SMEM_BYTES, stream);
  if (e != hipSuccess) fprintf(stderr, "cooperative launch failed: %s (grid %d)\n", hipGetErrorString(e), grid_blocks);
#else
  for (int ph = 0; ph < NPHASE; ++ph) {
    P.ph_lo = ph; P.ph_hi = ph + 1;
    hipLaunchKernelGGL(peer_trunk_mk, dim3(grid_blocks), dim3(512), SMEM_BYTES, stream, P);
  }
#endif
}
```

```cpp
#include <hip/hip_runtime.h>
#include <hip/hip_bf16.h>
#include <hip/hip_cooperative_groups.h>
#include <cstdio>
namespace cg = cooperative_groups;

#ifndef ONE_LAUNCH
#define ONE_LAUNCH 1
#endif

typedef unsigned short bf16_t;
using bf16x8 = __attribute__((ext_vector_type(8))) short;
using f32x4 = __attribute__((ext_vector_type(4))) float;

constexpr int T = 65536;
constexpr int D = 1024;
constexpr int SEQ = 8192;
constexpr int INC = 2304;
constexpr int NEXP = 16384;
constexpr float EPS = 1e-6f;
constexpr int SMEM_BYTES = 131072 + 16;
__device__ __forceinline__ int launder_s(int x) { asm volatile("" : "+s"(x)); return x; }
#define VGRID (launder_s((int)gridDim.x * 2))
constexpr int NPHASE = 24;

constexpr size_t OFF_WINT = 0;
constexpr size_t OFF_WOUTT = OFF_WINT + (size_t)2 * 2304 * 1024 * 2;
constexpr size_t OFF_WQT = OFF_WOUTT + (size_t)2 * 1024 * 1024 * 2;
constexpr size_t OFF_WPGT = OFF_WQT + (size_t)2 * 2048 * 1024 * 2;
constexpr size_t OFF_WPET = OFF_WPGT + (size_t)2 * 1024 * 1024 * 2;
constexpr size_t OFF_KEYS = OFF_WPET + (size_t)2 * 1024 * 256 * 2;
constexpr size_t OFF_EU = OFF_KEYS + (size_t)2 * 8 * 2 * 128 * 128 * 2;
constexpr size_t OFF_EV = OFF_EU + (size_t)2 * NEXP * 1024;
constexpr size_t OFF_ESC = OFF_EV + (size_t)2 * NEXP * 1024;
constexpr size_t OFF_PBF = OFF_ESC + (size_t)4 * NEXP * 4;
constexpr size_t OFF_ABUF = OFF_PBF + (size_t)2 * T * 256 * 2;
constexpr size_t OFF_Z = OFF_ABUF + (size_t)T * 1024 * 2;
constexpr size_t OFF_IDX = OFF_Z + (size_t)T * 2304 * 2;
constexpr size_t OFF_GATE = OFF_IDX + (size_t)T * 128 * 4;
constexpr size_t OFF_WSB = OFF_GATE + (size_t)T * 128 * 4;
constexpr size_t OFF_ACT = OFF_WSB + (size_t)2 * 6 * 128 * 128 * 2;
constexpr size_t OFF_SSQ = OFF_ACT + (size_t)T * 128 * 4;
constexpr size_t OFF_N8 = OFF_SSQ + (size_t)8 * T * 4;
constexpr size_t OFF_BAR = OFF_N8 + (size_t)T * 1024;
constexpr size_t OFF_H = OFF_BAR + 16384;
constexpr size_t OFF_SSQA = OFF_H + (size_t)T * 1024 * 2;
constexpr size_t OFF_SSQB = OFF_SSQA + (size_t)T * 4;
constexpr size_t WS_END = OFF_SSQB + (size_t)T * 4;

struct Params {
  const float* in[23];
  float* out;
  char* ws;
  int ph_lo, ph_hi;
};

typedef float cvt_f2 __attribute__((ext_vector_type(2)));
typedef __bf16 cvt_b2 __attribute__((ext_vector_type(2)));
__device__ __forceinline__ unsigned pack2(float a, float b) {
  const cvt_f2 v = {a, b};
  return __builtin_bit_cast(unsigned, __builtin_convertvector(v, cvt_b2));
}
__device__ __forceinline__ unsigned short f2bf(float f) { return (unsigned short)(pack2(f, f) & 0xffffu); }
__device__ __forceinline__ float bf2f(unsigned short b) { return __uint_as_float(((unsigned)b) << 16); }
__device__ __forceinline__ float bflo(unsigned u) { return __uint_as_float(u << 16); }
__device__ __forceinline__ float bfhi(unsigned u) { return __uint_as_float(u & 0xffff0000u); }
__device__ __forceinline__ float sigmoidf_(float x) { return __builtin_amdgcn_rcpf(1.0f + __builtin_amdgcn_exp2f(x * -1.4426950408889634f)); }
__device__ __forceinline__ float gelu_tanh(float x) {
  float u = 0.7978845608028654f * (x + 0.044715f * x * x * x);
  float e = __builtin_amdgcn_exp2f(u * 2.8853900817779268f);
  float th = 1.0f - 2.0f * __builtin_amdgcn_rcpf(e + 1.0f);
  return 0.5f * x * (1.0f + th);
}
template <int CTRL>
__device__ __forceinline__ float dpp_f(float v) {
  return __int_as_float(__builtin_amdgcn_update_dpp(0, __float_as_int(v), CTRL, 0xF, 0xF, true));
}
__device__ __forceinline__ float wave_sum(float v) {
  v += dpp_f<0xB1>(v);
  v += dpp_f<0x4E>(v);
  v += dpp_f<0x141>(v);
  v += dpp_f<0x140>(v);
  float s = __int_as_float(__builtin_amdgcn_readlane(__float_as_int(v), 0)) +
            __int_as_float(__builtin_amdgcn_readlane(__float_as_int(v), 16)) +
            __int_as_float(__builtin_amdgcn_readlane(__float_as_int(v), 32)) +
            __int_as_float(__builtin_amdgcn_readlane(__float_as_int(v), 48));
  return s;
}

__device__ __forceinline__ float wave_max(float v) {
  v = fmaxf(v, dpp_f<0xB1>(v));
  v = fmaxf(v, dpp_f<0x4E>(v));
  v = fmaxf(v, dpp_f<0x141>(v));
  v = fmaxf(v, dpp_f<0x140>(v));
  float s = fmaxf(fmaxf(__int_as_float(__builtin_amdgcn_readlane(__float_as_int(v), 0)),
                        __int_as_float(__builtin_amdgcn_readlane(__float_as_int(v), 16))),
                  fmaxf(__int_as_float(__builtin_amdgcn_readlane(__float_as_int(v), 32)),
                        __int_as_float(__builtin_amdgcn_readlane(__float_as_int(v), 48))));
  return s;
}
typedef float f32x2 __attribute__((ext_vector_type(2)));
__device__ __forceinline__ float group8_sum(float v) {
  v += dpp_f<0xB1>(v);
  v += dpp_f<0x4E>(v);
  v += dpp_f<0x141>(v);
  return v;
}

__device__ __forceinline__ int lds_off(int r, int c) { return r * 128 + ((c ^ ((r >> 1) & 7)) << 4); }

typedef unsigned u32x4_k __attribute__((ext_vector_type(4)));
__device__ __forceinline__ void gemm_kloop_issue(const int TIDX, const bf16_t* __restrict__ A, int lda, const bf16_t* __restrict__ Bt, int ldb,
                                                 u32x4_k (&ra)[4], u32x4_k (&rb)[4]) {
  const int sr = TIDX >> 3, sc = TIDX & 7;
  const bf16_t* ga = A + (size_t)sr * lda + sc * 8;
  const bf16_t* gb = Bt + (size_t)sr * ldb + sc * 8;
#pragma unroll
  for (int i = 0; i < 4; ++i) {
    ra[i] = *(const u32x4_k*)(ga + (size_t)(32 * i) * lda);
    rb[i] = *(const u32x4_k*)(gb + (size_t)(32 * i) * ldb);
  }
}
__device__ __forceinline__ void gemm_kloop(const int TIDX, const int BIDX, const bf16_t* __restrict__ A, int lda,
                                           const bf16_t* __restrict__ Bt, int ldb, int K,
                                           char* smem, f32x4 (&acc)[4][4], u32x4_k (&ra)[4], u32x4_k (&rb)[4]) {
  const int tid = TIDX, lane = tid & 63, wid = tid >> 6;
  const int wr = wid >> 1, wc = wid & 1;
  const int fr = lane & 15, fq = lane >> 4;
  const int sr = tid >> 3, sc = tid & 7;
  const bf16_t* ga = A + (size_t)sr * lda + sc * 8;
  const bf16_t* gb = Bt + (size_t)sr * ldb + sc * 8;
#pragma unroll
  for (int mi = 0; mi < 4; ++mi)
#pragma unroll
    for (int ni = 0; ni < 4; ++ni) acc[mi][ni] = f32x4{0.f, 0.f, 0.f, 0.f};
#pragma unroll
  for (int i = 0; i < 4; ++i) {
    *(u32x4_k*)(smem + lds_off(sr + 32 * i, sc)) = ra[i];
    *(u32x4_k*)(smem + 16384 + lds_off(sr + 32 * i, sc)) = rb[i];
  }
  __syncthreads();
  const int nt = K >> 6;
  for (int kt = 0; kt < nt; ++kt) {
    char* bufp = smem + (kt & 1) * 32768;
    const bool more = (kt + 1 < nt);
    if (more) {
#pragma unroll
      for (int i = 0; i < 4; ++i) {
        ra[i] = *(const u32x4_k*)(ga + (size_t)(32 * i) * lda + (kt + 1) * 64);
        rb[i] = *(const u32x4_k*)(gb + (size_t)(32 * i) * ldb + (kt + 1) * 64);
      }
    }
#pragma unroll
    for (int kk = 0; kk < 2; ++kk) {
      bf16x8 af[4], bfr[4];
#pragma unroll
      for (int mi = 0; mi < 4; ++mi) af[mi] = *(const bf16x8*)(bufp + lds_off(wr * 64 + mi * 16 + fr, kk * 4 + fq));
#pragma unroll
      for (int ni = 0; ni < 4; ++ni) bfr[ni] = *(const bf16x8*)(bufp + 16384 + lds_off(wc * 64 + ni * 16 + fr, kk * 4 + fq));
#pragma unroll
      for (int mi = 0; mi < 4; ++mi)
#pragma unroll
        for (int ni = 0; ni < 4; ++ni)
          acc[mi][ni] = __builtin_amdgcn_mfma_f32_16x16x32_bf16(bfr[ni], af[mi], acc[mi][ni], 0, 0, 0);
    }
    if (more) {
      char* nb = smem + ((kt + 1) & 1) * 32768;
#pragma unroll
      for (int i = 0; i < 4; ++i) {
        *(u32x4_k*)(nb + lds_off(sr + 32 * i, sc)) = ra[i];
        *(u32x4_k*)(nb + 16384 + lds_off(sr + 32 * i, sc)) = rb[i];
      }
    }
    __syncthreads();
  }
}

__device__ __forceinline__ void transpose_convert(const float* __restrict__ src, const float* __restrict__ g, bf16_t* __restrict__ dst,
                                  int Lc, int K, int N, size_t gtid, size_t gsz) {
  const int K8 = K >> 3;
  const size_t total = (size_t)Lc * K8 * N;
  for (size_t u = gtid; u < total; u += gsz) {
    int n = (int)(u % N);
    size_t r = u / N;
    int kc = (int)(r % K8);
    int l = (int)(r / K8);
    float v[8];
#pragma unroll
    for (int i = 0; i < 8; ++i) {
      int k = kc * 8 + i;
      float w = src[((size_t)l * K + k) * N + n];
      if (g) w *= g[l * K + k];
      v[i] = w;
    }
    uint4 o;
    o.x = pack2(v[0], v[1]); o.y = pack2(v[2], v[3]); o.z = pack2(v[4], v[5]); o.w = pack2(v[6], v[7]);
    *(uint4*)(dst + ((size_t)l * N + n) * K + kc * 8) = o;
  }
}
__device__ __forceinline__ void convert_flat(const float* __restrict__ src, bf16_t* __restrict__ dst, size_t n8, size_t gtid, size_t gsz) {
  for (size_t u = gtid; u < n8; u += gsz) {
    float4 a = ((const float4*)src)[2 * u], b = ((const float4*)src)[2 * u + 1];
    uint4 o;
    o.x = pack2(a.x, a.y); o.y = pack2(a.z, a.w); o.z = pack2(b.x, b.y); o.w = pack2(b.z, b.w);
    ((uint4*)dst)[u] = o;
  }
}
__device__ __forceinline__ void phase_convert(const int TIDX, const int BIDX, const Params& P) {
  const size_t gtid = (size_t)BIDX * 256 + TIDX;
  const size_t gsz = (size_t)VGRID * 256;
  char* ws = P.ws;
  transpose_convert(P.in[3], P.in[2], (bf16_t*)(ws + OFF_WINT), 2, 1024, 2304, gtid, gsz);
  transpose_convert(P.in[13], nullptr, (bf16_t*)(ws + OFF_WOUTT), 2, 1024, 1024, gtid, gsz);
  transpose_convert(P.in[15], P.in[14], (bf16_t*)(ws + OFF_WQT), 2, 1024, 2048, gtid, gsz);
  transpose_convert(P.in[21], P.in[19], (bf16_t*)(ws + OFF_WPGT), 2, 1024, 1024, gtid, gsz);
  transpose_convert(P.in[20], nullptr, (bf16_t*)(ws + OFF_WPET), 2, 256, 1024, gtid, gsz);
  convert_flat(P.in[16], (bf16_t*)(ws + OFF_KEYS), (size_t)2 * 8 * 2 * 128 * 128 / 8, gtid, gsz);
  {
    const int lane = TIDX & 63;
    const int gw = BIDX * 4 + (TIDX >> 6), nW = VGRID * 4;
    float* esc = (float*)(ws + OFF_ESC);
    for (int row0 = gw * 2; row0 < 4 * NEXP; row0 += nW * 2) {
      float4 v[2][4];
#pragma unroll
      for (int rr = 0; rr < 2; ++rr) {
        const int row = row0 + rr;
        const float* src = (row < 2 * NEXP) ? (P.in[17] + (size_t)row * 1024) : (P.in[18] + (size_t)(row - 2 * NEXP) * 1024);
#pragma unroll
        for (int i = 0; i < 4; ++i) v[rr][i] = ((const float4*)src)[lane * 4 + i];
      }
#pragma unroll
      for (int rr = 0; rr < 2; ++rr) {
        const int row = row0 + rr;
        float m = 0.f;
#pragma unroll
        for (int i = 0; i < 4; ++i) m = fmaxf(m, fmaxf(fmaxf(fabsf(v[rr][i].x), fabsf(v[rr][i].y)), fmaxf(fabsf(v[rr][i].z), fabsf(v[rr][i].w))));
        m = wave_max(m);
        const float sc = (m > 0.f) ? 224.0f * __builtin_amdgcn_rcpf(m) : 0.f;
        uint4 o;
        unsigned w[4];
#pragma unroll
        for (int i = 0; i < 4; ++i) {
          int t = __builtin_amdgcn_cvt_pk_fp8_f32(v[rr][i].x * sc, v[rr][i].y * sc, 0, false);
          t = __builtin_amdgcn_cvt_pk_fp8_f32(v[rr][i].z * sc, v[rr][i].w * sc, t, true);
          w[i] = (unsigned)t;
        }
        o.x = w[0]; o.y = w[1]; o.z = w[2]; o.w = w[3];
        *(uint4*)(ws + OFF_EU + (size_t)(row / NEXP) * ((size_t)NEXP * 1024) + (size_t)(lane >> 3) * ((size_t)NEXP * 128) + (size_t)(row % NEXP) * 128 + (lane & 7) * 16) = o;
        if (lane == 0) esc[row] = m * (1.0f / 224.0f);
      }
    }
  }
  {
    bf16_t* wsb = (bf16_t*)(ws + OFF_WSB);
    for (size_t u = gtid; u < (size_t)2 * 6 * 128 * 128; u += gsz) {
      int j = (int)(u & 127), i = (int)((u >> 7) & 127);
      float w = P.in[11][u];
      wsb[u] = ((j >> 6) <= (i >> 6)) ? f2bf(w) : (bf16_t)0;
    }
  }
  convert_flat(P.in[1], (bf16_t*)(ws + OFF_PBF), (size_t)2 * T * 256 / 8, gtid, gsz);
}

template <int MODE, bool INB>
__device__ __forceinline__ void phase_norm(const int TIDX, const int BIDX, const void* __restrict__ hraw, const float* __restrict__ g, bf16_t* __restrict__ abuf, float* __restrict__ outp, unsigned char* __restrict__ n8 = nullptr) {
  const int lane = TIDX & 63, wid = TIDX >> 6;
  const int gw = BIDX * 4 + wid, nW = VGRID * 4;
  float4 gv[4];
  if (MODE != 0) {
#pragma unroll
    for (int i = 0; i < 4; ++i) gv[i] = ((const float4*)g)[lane + 64 * i];
  }
  for (int t0 = gw * 4; t0 < T; t0 += nW * 4) {
    float4 v[4][4];
#pragma unroll
    for (int rr = 0; rr < 4; ++rr)
#pragma unroll
      for (int i = 0; i < 4; ++i) {
        if (INB) {
          const uint2 pk = ((const uint2*)((const bf16_t*)hraw + (size_t)(t0 + rr) * D))[lane + 64 * i];
          v[rr][i] = float4{bflo(pk.x), bfhi(pk.x), bflo(pk.y), bfhi(pk.y)};
        } else {
          v[rr][i] = ((const float4*)((const float*)hraw + (size_t)(t0 + rr) * D))[lane + 64 * i];
        }
      }
#pragma unroll
    for (int rr = 0; rr < 4; ++rr) {
      const int t = t0 + rr;
      float ss = 0.f;
#pragma unroll
      for (int i = 0; i < 4; ++i) ss += v[rr][i].x * v[rr][i].x + v[rr][i].y * v[rr][i].y + v[rr][i].z * v[rr][i].z + v[rr][i].w * v[rr][i].w;
      ss = wave_sum(ss);
      float rs = __builtin_amdgcn_rsqf(ss * (1.0f / D) + EPS);
#pragma unroll
      for (int i = 0; i < 4; ++i) {
        float4 o = v[rr][i];
        o.x *= rs; o.y *= rs; o.z *= rs; o.w *= rs;
        if (MODE != 0) { o.x *= gv[i].x; o.y *= gv[i].y; o.z *= gv[i].z; o.w *= gv[i].w; }
        if (MODE == 2) {
          ((float4*)(outp + (size_t)t * D))[lane + 64 * i] = o;
        } else {
          uint2 pk; pk.x = pack2(o.x, o.y); pk.y = pack2(o.z, o.w);
          ((uint2*)(abuf + (size_t)t * D))[lane + 64 * i] = pk;
          if (MODE == 1) {
            const float c0 = fminf(fmaxf(o.x * 16.0f, -440.f), 440.f), c1 = fminf(fmaxf(o.y * 16.0f, -440.f), 440.f);
            const float c2 = fminf(fmaxf(o.z * 16.0f, -440.f), 440.f), c3 = fminf(fmaxf(o.w * 16.0f, -440.f), 440.f);
            int w8 = __builtin_amdgcn_cvt_pk_fp8_f32(c0, c1, 0, false);
            w8 = __builtin_amdgcn_cvt_pk_fp8_f32(c2, c3, w8, true);
            ((int*)(n8 + (size_t)t * D))[lane + 64 * i] = w8;
          }
        }
      }
    }
  }
}

namespace pg8 {
#define PG8_LAS __attribute__((address_space(3)))
typedef unsigned short bf16_t;
typedef short bf16x8 __attribute__((ext_vector_type(8)));
typedef float f32x4 __attribute__((ext_vector_type(4)));
typedef unsigned u32x4 __attribute__((ext_vector_type(4)));
constexpr int BM = 256, BK = 64, HALF = 128, HTB = HALF * BK * 2  , STAGE_BYTES = 8 * HTB, NXCD = 8, WGM = 8;

__host__ __device__ __forceinline__ int lds_byte(int r, int c) { const int st = (r >> 4) * 2 + (c >> 5), rr = r & 15, cc = c & 31, ob = rr * 64 + cc * 2; return st * 1024 + (ob ^ (((ob >> 9) & 1) << 5)); }
__host__ __device__ __forceinline__ void stage_rc(int b, int& R, int& C) { const int st = b / 1024, sb = b % 1024, swz = sb ^ (((sb >> 9) & 1) << 5); R = (st >> 1) * 16 + swz / 64; C = (st & 1) * 32 + (swz % 64) / 2; }
__host__ __device__ __forceinline__ int perm32(int rho) { const int n = rho >> 4, i = rho & 15; return 8 * (i >> 2) + 4 * n + (i & 3); }

struct Unit { int pm, pn; };
struct Gemm { const bf16_t* A; const bf16_t* Bt; int M, N, K; };

struct StaticOrder {
    int nM, nN, nwg, G, c;
    __host__ __device__ void init(int M, int N, int G_, int c_) { nM = M / BM; nN = N / BM; nwg = nM * nN; G = G_; c = c_; }
    __host__ __device__ bool next(int i, Unit& u) const {
        const long L = (long)i * G + c; if (L >= nwg) return false;
        int wgid = (int)L; { const int q = nwg / NXCD, r = nwg % NXCD, xcd = wgid % NXCD, off = wgid / NXCD; wgid = (xcd < r ? xcd * (q + 1) : r * (q + 1) + (xcd - r) * q) + off; }
        const int nig = WGM * nN, gid = wgid / nig, fm = gid * WGM, gsz = (nM - fm) < WGM ? (nM - fm) : WGM;
        u.pm = fm + ((wgid % nig) % gsz); u.pn = (wgid % nig) / gsz; return true;
    }
    __device__ __forceinline__ void a_ready(const Unit&) const {}
    __device__ __forceinline__ void done(const Unit&) const {}
};
__device__ __forceinline__ unsigned cvt_pk_bf16(float lo, float hi) { unsigned r; asm volatile("v_cvt_pk_bf16_f32 %0, %1, %2" : "=v"(r) : "v"(lo), "v"(hi)); return r; }
typedef float f32x2 __attribute__((ext_vector_type(2)));
__device__ __forceinline__ f32x2 gelu_pk(f32x2 v) {
    const f32x2 av = __builtin_elementwise_abs(v), d = av * 0.2316418882f + 1.0f;
    f32x2 t; t.x = __builtin_amdgcn_rcpf(d.x); t.y = __builtin_amdgcn_rcpf(d.y);
    f32x2 q = t * 0.5307027145f + (-0.7265760135f); q = q * t + 0.7107068705f; q = q * t + (-0.142248368f); q = q * t + 0.127414796f; q = q * t;
    const f32x2 s = (v * v) * (-0.72134752044f);
    f32x2 e; e.x = __builtin_amdgcn_exp2f(s.x); e.y = __builtin_amdgcn_exp2f(s.y);
    const f32x2 m = v * (q * e), r = v - m;
    f32x2 o; o.x = v.x < 0.f ? m.x : r.x; o.y = v.y < 0.f ? m.y : r.y; return o;
}
template <int ACT  > struct EpiBf16 {
    static constexpr bool PERM = true, AFTER_DRAIN = false;
    bf16_t* O; int ldc; const float* bias; int split_cols; size_t split_stride;
    __device__ __forceinline__ void operator()(const f32x4 (&acc)[2][2][4][2], const Unit& u, int wr, int wc, int fr, int fq) const {
        const int row0 = u.pm * BM + wr * 64 + fr; int colt = u.pn * BM; bf16_t* base = O;
        if (split_cols) { const int t = colt / split_cols; base += (size_t)t * split_stride; colt -= t * split_cols; }
        const int col0 = colt + wc * 32 + 8 * fq, bcol0 = u.pn * BM + wc * 32 + 8 * fq;
        f32x4 bv[2][2];
#pragma unroll
        for (int bj = 0; bj < 2; ++bj)
#pragma unroll
            for (int n = 0; n < 2; ++n) bv[bj][n] = bias ? *(const f32x4*)(bias + bcol0 + bj * HALF + 4 * n) : (f32x4){0.f, 0.f, 0.f, 0.f};
#pragma unroll
        for (int ai = 0; ai < 2; ++ai)
#pragma unroll
            for (int m = 0; m < 4; ++m) { bf16_t* rowp = base + (size_t)(row0 + ai * HALF + m * 16) * ldc + col0;
#pragma unroll
                for (int bj = 0; bj < 2; ++bj) { f32x4 v0 = acc[ai][bj][m][0] + bv[bj][0], v1 = acc[ai][bj][m][1] + bv[bj][1];
                    if (ACT == 1) { f32x2 a = gelu_pk((f32x2){v0[0], v0[1]}), b = gelu_pk((f32x2){v0[2], v0[3]}), c = gelu_pk((f32x2){v1[0], v1[1]}), d = gelu_pk((f32x2){v1[2], v1[3]});
                        v0 = (f32x4){a.x, a.y, b.x, b.y}; v1 = (f32x4){c.x, c.y, d.x, d.y}; }
                    if (ACT == 2) {
#pragma unroll
                        for (int j = 0; j < 4; ++j) { v0[j] = 0.5f * v0[j] * (1.0f + erff(v0[j] * 0.70710678f)); v1[j] = 0.5f * v1[j] * (1.0f + erff(v1[j] * 0.70710678f)); } }
                    u32x4 w; w.x = cvt_pk_bf16(v0[0], v0[1]); w.y = cvt_pk_bf16(v0[2], v0[3]); w.z = cvt_pk_bf16(v1[0], v1[1]); w.w = cvt_pk_bf16(v1[2], v1[3]);
                    *(u32x4*)(rowp + bj * HALF) = w; } }
    }
};
template <class Epi, class Sched, bool STAMP = false>
__device__ __forceinline__ void gemm_phase(const int TL, PG8_LAS unsigned char* lds, const Gemm g, const Sched& S, const Epi& E, unsigned long long* stamps) {
    const int tid = TL, wid = __builtin_amdgcn_readfirstlane(tid >> 6), lane = tid & 63, wr = wid >> 2, wc = wid & 3, fr = lane & 15, fq = lane >> 4;
    const int K = g.K, nt = K / BK;
    int ts_lo = 0, ts_hi = 0, nts = 0; const unsigned long long rt_entry = STAMP ? (unsigned long long)wall_clock64() : 0ull;
#define PG8_STAMP() do { if (STAMP && wid == 0 && nts < 64) { const unsigned long long _c = (unsigned long long)clock64(); \
        ts_lo = (lane == nts) ? (int)(unsigned)_c : ts_lo; ts_hi = (lane == nts) ? (int)(unsigned)(_c >> 32) : ts_hi; ++nts; } } while (0)
    PG8_STAMP();
    unsigned voffA[2], voffB[2];
#pragma unroll
    for (int i = 0; i < 2; ++i) { int R, C; stage_rc(tid * 16 + i * 8192, R, C); const int Rb = Epi::PERM ? ((R & ~31) + perm32(R & 31)) : R;
        voffA[i] = (unsigned)(R * K + C) * 2u; voffB[i] = (unsigned)(Rb * K + C) * 2u; }
    const size_t kstep = (size_t)(BK * 2);
    const size_t hstep = (size_t)HALF * K * 2;
    const size_t tstep = 2 * hstep;
    const unsigned ldsw = (unsigned)wid * 1024u;
    const int aoff = lds_byte(wr * 64 + fr, fq * 8), boff = lds_byte(wc * 32 + fr, fq * 8);
#define PG8_SA(b, h) (((b) * 2 + (h)) * HTB)
#define PG8_SB(b, h) ((4 + (b) * 2 + (h)) * HTB)
#define PG8_STAGE(bufoff, gbase, voff) do { _Pragma("unroll") for (int _i = 0; _i < 2; ++_i) \
        __builtin_amdgcn_global_load_lds((const unsigned*)((const char*)(gbase) + (voff)[_i]), (PG8_LAS unsigned*)(lds + (bufoff) + ldsw + _i * 8192), 16, 0, 0); } while (0)
#define PG8_LDA(dst, b, h) do { _Pragma("unroll") for (int m = 0; m < 4; ++m) _Pragma("unroll") for (int k = 0; k < 2; ++k) dst[m][k] = *(const PG8_LAS bf16x8*)(lds + PG8_SA(b, h) + aoff + m * 2048 + k * 1024); } while (0)
#define PG8_LDB(dst, b, h) do { _Pragma("unroll") for (int n = 0; n < 2; ++n) _Pragma("unroll") for (int k = 0; k < 2; ++k) dst[n][k] = *(const PG8_LAS bf16x8*)(lds + PG8_SB(b, h) + boff + n * 2048 + k * 1024); } while (0)
#define PG8_MMA(ai, bj, At, Bt) do { __builtin_amdgcn_s_setprio(1); _Pragma("unroll") for (int m = 0; m < 4; ++m) _Pragma("unroll") for (int n = 0; n < 2; ++n) _Pragma("unroll") for (int k = 0; k < 2; ++k) \
        acc[ai][bj][m][n] = __builtin_amdgcn_mfma_f32_16x16x32_bf16(Bt[n][k], At[m][k], acc[ai][bj][m][n], 0, 0, 0); __builtin_amdgcn_s_setprio(0); } while (0)
#define PG8_WAIT_V(n) asm volatile("s_waitcnt vmcnt(" #n ")" ::: "memory")
#define PG8_WAIT_L(n) asm volatile("s_waitcnt lgkmcnt(" #n ")" ::: "memory")
#define PG8_BAR __builtin_amdgcn_s_barrier()
#define PG8_SCHED __builtin_amdgcn_sched_barrier(0)
    Unit cur, nxt; int ui = 0;
    if (!S.next(0, cur)) return;
    f32x4 acc[2][2][4][2];
#pragma unroll
    for (int a = 0; a < 2; ++a)
#pragma unroll
        for (int b = 0; b < 2; ++b)
#pragma unroll
            for (int m = 0; m < 4; ++m)
#pragma unroll
                for (int n = 0; n < 2; ++n) acc[a][b][m][n] = (f32x4){0.f, 0.f, 0.f, 0.f};
    bf16x8 At[4][2], B0[2][2], B1[2][2];
    const char* cA = (const char*)g.A + (size_t)cur.pm * tstep; const char* cB = (const char*)g.Bt + (size_t)cur.pn * tstep;
    S.a_ready(cur);
    PG8_STAGE(PG8_SB(0, 0), cB, voffB); PG8_STAGE(PG8_SA(0, 0), cA, voffA); PG8_STAGE(PG8_SB(0, 1), cB + hstep, voffB); PG8_STAGE(PG8_SA(0, 1), cA + hstep, voffA);
    if (wr == 1) PG8_BAR;
    PG8_WAIT_V(4); PG8_BAR;
    PG8_STAGE(PG8_SB(1, 0), cB + kstep, voffB); PG8_STAGE(PG8_SA(1, 0), cA + kstep, voffA); PG8_STAGE(PG8_SB(1, 1), cB + hstep + kstep, voffB);
    PG8_WAIT_V(6); PG8_BAR;
    PG8_STAMP();
    for (;;) {
        const bool has_next = S.next(ui + 1, nxt);
        const char* nA = has_next ? (const char*)g.A + (size_t)nxt.pm * tstep : cA; const char* nB = has_next ? (const char*)g.Bt + (size_t)nxt.pn * tstep : cB;
        for (int t = 0; t < nt; t += 2) {
            const bool last = (t == nt - 2);
            const char* a1 = cA + (size_t)(t + 1) * kstep;
            const char* a2 = last ? nA : cA + (size_t)(t + 2) * kstep; const char* b2 = last ? nB : cB + (size_t)(t + 2) * kstep;
            const char* a3 = a2 + kstep; const char* b3 = b2 + kstep;
            if (last && has_next) S.a_ready(nxt);
            PG8_LDB(B0, 0, 0); PG8_SCHED; PG8_LDA(At, 0, 0); PG8_STAGE(PG8_SA(1, 1), a1 + hstep, voffA);
            PG8_WAIT_L(8); PG8_BAR; PG8_WAIT_L(0); PG8_MMA(0, 0, At, B0); PG8_BAR; PG8_SCHED;
            PG8_LDB(B1, 0, 1); PG8_STAGE(PG8_SB(0, 0), b2, voffB);
            PG8_BAR; PG8_WAIT_L(0); PG8_MMA(0, 1, At, B1); PG8_BAR;
            PG8_LDA(At, 0, 1); PG8_STAGE(PG8_SA(0, 0), a2, voffA);
            PG8_BAR; PG8_WAIT_L(0); PG8_MMA(1, 0, At, B0); PG8_BAR; PG8_SCHED;
            PG8_STAGE(PG8_SB(0, 1), b2 + hstep, voffB);
            PG8_WAIT_V(6); PG8_BAR; PG8_MMA(1, 1, At, B1); PG8_BAR;
            PG8_LDB(B0, 1, 0); PG8_SCHED; PG8_LDA(At, 1, 0); PG8_STAGE(PG8_SA(0, 1), a2 + hstep, voffA);
            PG8_WAIT_L(8); PG8_BAR; PG8_WAIT_L(0); PG8_MMA(0, 0, At, B0); PG8_BAR; PG8_SCHED;
            PG8_LDB(B1, 1, 1); PG8_STAGE(PG8_SB(1, 0), b3, voffB);
            PG8_BAR; PG8_WAIT_L(0); PG8_MMA(0, 1, At, B1); PG8_BAR;
            PG8_LDA(At, 1, 1); PG8_STAGE(PG8_SA(1, 0), a3, voffA);
            PG8_BAR; PG8_WAIT_L(0); PG8_MMA(1, 0, At, B0); PG8_BAR; PG8_SCHED;
            PG8_STAGE(PG8_SB(1, 1), b3 + hstep, voffB);
            PG8_WAIT_V(6); PG8_BAR; PG8_MMA(1, 1, At, B1); PG8_BAR;
        }
        PG8_STAMP();
        if constexpr (!Epi::AFTER_DRAIN) { E(acc, cur, wr, wc, fr, fq); S.done(cur); }
        PG8_STAMP();
        if (!has_next) break;
#pragma unroll
        for (int a = 0; a < 2; ++a)
#pragma unroll
            for (int b = 0; b < 2; ++b)
#pragma unroll
                for (int m = 0; m < 4; ++m)
#pragma unroll
                    for (int n = 0; n < 2; ++n) acc[a][b][m][n] = (f32x4){0.f, 0.f, 0.f, 0.f};
        cur = nxt; cA = nA; cB = nB; ++ui;
    }
    PG8_WAIT_V(0);
    if (wr == 0) PG8_BAR;
    PG8_BAR;
    if constexpr (Epi::AFTER_DRAIN) { E.fused(acc, cur, wr, wc, fr, fq, lds, wid, lane); S.done(cur); }
    PG8_STAMP();
    if (STAMP && wid == 0) { stamps[lane] = lane < nts ? (((unsigned long long)(unsigned)ts_hi << 32) | (unsigned)ts_lo) : 0ull;
        if (lane == 62) stamps[62] = rt_entry; if (lane == 63) stamps[63] = (unsigned long long)wall_clock64(); }
#undef PG8_STAMP
#undef PG8_SA
#undef PG8_SB
#undef PG8_STAGE
#undef PG8_LDA
#undef PG8_LDB
#undef PG8_MMA
#undef PG8_WAIT_V
#undef PG8_WAIT_L
#undef PG8_BAR
#undef PG8_SCHED
}
}

template <bool INB>
struct EpiResid {
  static constexpr bool PERM = true, AFTER_DRAIN = false;
  const void* hin; bf16_t* hout; float* ssq; int wave_id;
  __device__ __forceinline__ void operator()(const pg8::f32x4 (&acc)[2][2][4][2], const pg8::Unit& u, int, int, int, int) const {
    int lane_id;
    asm volatile("v_mbcnt_lo_u32_b32 %0, -1, 0\n\tv_mbcnt_hi_u32_b32 %0, -1, %0" : "=v"(lane_id));
    const int wr = wave_id >> 2, wc = wave_id & 3, fr = lane_id & 15, fq = lane_id >> 4;
    const int row0 = u.pm * 256 + wr * 64 + fr, col0 = u.pn * 256 + wc * 32 + 8 * fq;
#pragma unroll
    for (int ai = 0; ai < 2; ++ai)
#pragma unroll
      for (int m = 0; m < 4; ++m) {
        const int row = row0 + ai * 128 + m * 16;
        const size_t ro = (size_t)row * D + col0;
        float sq = 0.f;
#pragma unroll
        for (int bj = 0; bj < 2; ++bj)
#pragma unroll
          for (int n = 0; n < 2; ++n) {
            const size_t o = ro + bj * 128 + n * 4;
            pg8::f32x4 v;
            if (INB) { const uint2 pk = *(const uint2*)((const bf16_t*)hin + o); v = pg8::f32x4{bflo(pk.x), bfhi(pk.x), bflo(pk.y), bfhi(pk.y)}; }
            else v = *(const pg8::f32x4*)((const float*)hin + o);
            v = v + acc[ai][bj][m][n];
            uint2 w; w.x = pack2(v[0], v[1]); w.y = pack2(v[2], v[3]);
            *(uint2*)(hout + o) = w;
            const float r0 = bflo(w.x), r1 = bfhi(w.x), r2 = bflo(w.y), r3 = bfhi(w.y);
            sq += r0 * r0 + r1 * r1 + r2 * r2 + r3 * r3;
          }
        sq += __shfl_xor(sq, 16);
        sq += __shfl_xor(sq, 32);
        if (fq == 0) atomicAdd(ssq + row, sq);
      }
  }
};
struct EpiBf16Rs {
  static constexpr bool PERM = true, AFTER_DRAIN = false;
  bf16_t* O; int ldc; const float* ssq; int wave_id;
  __device__ __forceinline__ void operator()(const pg8::f32x4 (&acc)[2][2][4][2], const pg8::Unit& u, int, int, int, int) const {
    int lane_id;
    asm volatile("v_mbcnt_lo_u32_b32 %0, -1, 0\n\tv_mbcnt_hi_u32_b32 %0, -1, %0" : "=v"(lane_id));
    const int wr = wave_id >> 2, wc = wave_id & 3, fr = lane_id & 15, fq = lane_id >> 4;
    const int row0 = u.pm * 256 + wr * 64 + fr, col0 = u.pn * 256 + wc * 32 + 8 * fq;
#pragma unroll
    for (int ai = 0; ai < 2; ++ai)
#pragma unroll
      for (int m = 0; m < 4; ++m) {
        const int row = row0 + ai * 128 + m * 16;
        const float rs = __builtin_amdgcn_rsqf(ssq[row] * (1.0f / D) + EPS);
        bf16_t* rowp = O + (size_t)row * ldc + col0;
#pragma unroll
        for (int bj = 0; bj < 2; ++bj) {
          const pg8::f32x4 v0 = acc[ai][bj][m][0], v1 = acc[ai][bj][m][1];
          pg8::u32x4 w;
          w.x = pack2(v0[0] * rs, v0[1] * rs); w.y = pack2(v0[2] * rs, v0[3] * rs);
          w.z = pack2(v1[0] * rs, v1[1] * rs); w.w = pack2(v1[2] * rs, v1[3] * rs);
          *(pg8::u32x4*)(rowp + bj * 128) = w;
        }
      }
  }
};
struct EpiSig {
  static constexpr bool PERM = true, AFTER_DRAIN = false;
  const float* ssq; bf16_t* sg; int wave_id;
  __device__ __forceinline__ void operator()(const pg8::f32x4 (&acc)[2][2][4][2], const pg8::Unit& u, int, int, int, int) const {
    int lane_id;
    asm volatile("v_mbcnt_lo_u32_b32 %0, -1, 0\n\tv_mbcnt_hi_u32_b32 %0, -1, %0" : "=v"(lane_id));
    const int wr = wave_id >> 2, wc = wave_id & 3, fr = lane_id & 15, fq = lane_id >> 4;
    const int row0 = u.pm * 256 + wr * 64 + fr, col0 = u.pn * 256 + wc * 32 + 8 * fq;
#pragma unroll
    for (int ai = 0; ai < 2; ++ai)
#pragma unroll
      for (int m = 0; m < 4; ++m) {
        const int row = row0 + ai * 128 + m * 16;
        float sq = 0.f;
#pragma unroll
        for (int xx = 0; xx < 8; ++xx) sq += ssq[(size_t)xx * T + row];
        const float rs = __builtin_amdgcn_rsqf(sq * (1.0f / D) + EPS);
        const size_t ro = (size_t)row * D + col0;
#pragma unroll
        for (int bj = 0; bj < 2; ++bj)
#pragma unroll
          for (int n = 0; n < 2; ++n) {
            const pg8::f32x4 a = acc[ai][bj][m][n];
            uint2 pk;
            pk.x = pack2(sigmoidf_(rs * a[0]), sigmoidf_(rs * a[1]));
            pk.y = pack2(sigmoidf_(rs * a[2]), sigmoidf_(rs * a[3]));
            *(uint2*)(sg + ro + bj * 128 + n * 4) = pk;
          }
      }
  }
};
struct EpiPle {
  static constexpr bool PERM = true, AFTER_DRAIN = false;
  bf16_t* h; const bf16_t* sg; float* ssq; int wave_id;
  __device__ __forceinline__ void operator()(const pg8::f32x4 (&acc)[2][2][4][2], const pg8::Unit& u, int, int, int, int) const {
    int lane_id;
    asm volatile("v_mbcnt_lo_u32_b32 %0, -1, 0\n\tv_mbcnt_hi_u32_b32 %0, -1, %0" : "=v"(lane_id));
    const int wr = wave_id >> 2, wc = wave_id & 3, fr = lane_id & 15, fq = lane_id >> 4;
    const int row0 = u.pm * 256 + wr * 64 + fr, col0 = u.pn * 256 + wc * 32 + 8 * fq;
#pragma unroll
    for (int ai = 0; ai < 2; ++ai)
#pragma unroll
      for (int m = 0; m < 4; ++m) {
        const int row = row0 + ai * 128 + m * 16;
        const size_t ro = (size_t)row * D + col0;
        float sq = 0.f;
#pragma unroll
        for (int bj = 0; bj < 2; ++bj)
#pragma unroll
          for (int n = 0; n < 2; ++n) {
            const size_t o = ro + bj * 128 + n * 4;
            const uint2 pk = *(const uint2*)(sg + o);
            const uint2 hp = *(const uint2*)(h + o);
            const pg8::f32x4 a = acc[ai][bj][m][n];
            uint2 w;
            w.x = pack2(bflo(hp.x) + a[0] * bflo(pk.x), bfhi(hp.x) + a[1] * bfhi(pk.x));
            w.y = pack2(bflo(hp.y) + a[2] * bflo(pk.y), bfhi(hp.y) + a[3] * bfhi(pk.y));
            *(uint2*)(h + o) = w;
            const float r0 = bflo(w.x), r1 = bfhi(w.x), r2 = bflo(w.y), r3 = bfhi(w.y);
            sq += r0 * r0 + r1 * r1 + r2 * r2 + r3 * r3;
          }
        sq += __shfl_xor(sq, 16);
        sq += __shfl_xor(sq, 32);
        if (fq == 0) atomicAdd(ssq + row, sq);
      }
  }
};
template <class Epi>
__device__ __forceinline__ void run_gemm(const int TL, const int BL, char* smem, const bf16_t* A, const bf16_t* Bt, int N, int K, const Epi& E) {
  pg8::Gemm g{A, Bt, T, N, K};
  pg8::StaticOrder S; S.init(T, N, (int)gridDim.x, BL);
  pg8::gemm_phase<Epi, pg8::StaticOrder, false>(TL, (PG8_LAS unsigned char*)smem, g, S, E, nullptr);
}

__device__ __forceinline__ void unpack8(const uint4& u, float (&f)[8]) {
  f[0] = bflo(u.x); f[1] = bfhi(u.x); f[2] = bflo(u.y); f[3] = bfhi(u.y);
  f[4] = bflo(u.z); f[5] = bfhi(u.z); f[6] = bflo(u.w); f[7] = bfhi(u.w);
}
__device__ __forceinline__ void phase_mix(const int TIDX, const int BIDX, const Params& P, int L, const bf16_t* __restrict__ z, bf16_t* __restrict__ y,
                                          const bf16_t* __restrict__ wsb, char* smem) {
  const int tid = TIDX, lane = tid & 63, wid = tid >> 6;
  const int r8 = tid >> 3, c8 = tid & 7;
  const float* conv_a_w = P.in[4] + (size_t)L * 31 * 384;
  const float* conv_a_b = P.in[5] + L * 384;
  const float* ln_a_g = P.in[6] + L * 384;
  const float* ln_a_b = P.in[7] + L * 384;
  const float* conv_b_w = P.in[8] + L * 3 * 256;
  const float* ln_c_g = P.in[9] + L * 384;
  const float* ln_c_b = P.in[10] + L * 384;
  const float* b_s = P.in[12] + L * 6 * 128;
  float* fs = (float*)smem;
  for (int item = BIDX; item < 512 * 16; item += VGRID) {
    const int tb = item >> 4, part = (item ^ (item >> 9)) & 15;
    const int t0 = tb * 128;
    const int s0 = t0 & (SEQ - 1);
    if (part < 6) {
      {
        const int ch0 = part * 64 + c8 * 8;
        uint4 vv[5], gg[5];
#pragma unroll
        for (int p = 0; p < 5; ++p) {
          const int r = r8 + 32 * p;
          vv[p] = uint4{0, 0, 0, 0}; gg[p] = uint4{0, 0, 0, 0};
          if (r < 158 && (r >= 30 || s0 > 0)) {
            const bf16_t* zr = z + (size_t)(t0 - 30 + r) * INC + ch0;
            vv[p] = *(const uint4*)zr;
            gg[p] = *(const uint4*)(zr + 384);
          }
        }
#pragma unroll
        for (int p = 0; p < 5; ++p) {
          const int r = r8 + 32 * p;
          if (r < 158) {
            float a[8], g[8];
            unpack8(vv[p], a); unpack8(gg[p], g);
            float4 o0, o1;
            o0.x = a[0] * sigmoidf_(g[0]); o0.y = a[1] * sigmoidf_(g[1]); o0.z = a[2] * sigmoidf_(g[2]); o0.w = a[3] * sigmoidf_(g[3]);
            o1.x = a[4] * sigmoidf_(g[4]); o1.y = a[5] * sigmoidf_(g[5]); o1.z = a[6] * sigmoidf_(g[6]); o1.w = a[7] * sigmoidf_(g[7]);
            *(float4*)(fs + r * 64 + c8 * 8) = o0;
            *(float4*)(fs + r * 64 + c8 * 8 + 4) = o1;
          }
        }
      }
      const int ch = part * 64 + lane;
      float wk[31];
#pragma unroll
      for (int k = 0; k < 31; ++k) wk[k] = conv_a_w[k * 384 + ch];
      const float cb = conv_a_b[ch], lg = ln_a_g[ch], lb = ln_a_b[ch];
      __syncthreads();
      for (int g4 = 0; g4 < 8; ++g4) {
        const int tl = wid * 32 + g4 * 4;
        float yv[34];
#pragma unroll
        for (int k = 0; k < 34; ++k) yv[k] = fs[(tl + k) * 64 + lane];
#pragma unroll
        for (int q = 0; q < 4; ++q) {
          float a = cb;
#pragma unroll
          for (int k = 0; k < 31; ++k) a += wk[k] * yv[q + k];
          float mean = wave_sum(a) * (1.0f / 64);
          float d = a - mean;
          float var = wave_sum(d * d) * (1.0f / 64);
          float yn = d * __builtin_amdgcn_rsqf(var + EPS) * lg + lb;
          float o = yn * sigmoidf_(yn);
          y[(size_t)(t0 + tl + q) * D + ch] = f2bf(o);
        }
      }
      __syncthreads();
    } else if (part < 10) {
      const int cbn = (part - 6) * 64 + c8 * 8;
      float w0[8], w1[8], w2[8];
#pragma unroll
      for (int i = 0; i < 8; ++i) { w0[i] = conv_b_w[cbn + i]; w1[i] = conv_b_w[256 + cbn + i]; w2[i] = conv_b_w[512 + cbn + i]; }
      const int tl0 = r8 * 4;
      uint4 cgv[6], xbv[6], bgv[4];
#pragma unroll
      for (int k = 0; k < 6; ++k) {
        cgv[k] = uint4{0, 0, 0, 0}; xbv[k] = uint4{0, 0, 0, 0};
        if (k >= 2 || (s0 + tl0) > 0) {
          const bf16_t* zr = z + (size_t)(t0 + tl0 - 2 + k) * INC + cbn;
          cgv[k] = *(const uint4*)(zr + 1024);
          xbv[k] = *(const uint4*)(zr + 1280);
        }
      }
#pragma unroll
      for (int k = 0; k < 4; ++k) bgv[k] = *(const uint4*)(z + (size_t)(t0 + tl0 + k) * INC + 768 + cbn);
      float pr[6][8];
#pragma unroll
      for (int k = 0; k < 6; ++k) {
        float a[8], b[8];
        unpack8(cgv[k], a); unpack8(xbv[k], b);
#pragma unroll
        for (int i = 0; i < 8; ++i) pr[k][i] = a[i] * b[i];
      }
#pragma unroll
      for (int k = 0; k < 4; ++k) {
        float bg[8], o[8];
        unpack8(bgv[k], bg);
#pragma unroll
        for (int i = 0; i < 8; ++i) o[i] = bg[i] * (w0[i] * pr[k][i] + w1[i] * pr[k + 1][i] + w2[i] * pr[k + 2][i]);
        uint4 pk; pk.x = pack2(o[0], o[1]); pk.y = pack2(o[2], o[3]); pk.z = pack2(o[4], o[5]); pk.w = pack2(o[6], o[7]);
        *(uint4*)(y + (size_t)(t0 + tl0 + k) * D + 384 + cbn) = pk;
      }
    } else {
      const int hc = part - 10;
      const int ch0 = hc * 64 + c8 * 8;
      bf16_t* vnT = (bf16_t*)smem;
      {
        float lg[8], lb[8];
#pragma unroll
        for (int i = 0; i < 8; ++i) { lg[i] = ln_c_g[ch0 + i]; lb[i] = ln_c_b[ch0 + i]; }
        uint4 vv[4];
#pragma unroll
        for (int p = 0; p < 4; ++p) vv[p] = *(const uint4*)(z + (size_t)(t0 + r8 + 32 * p) * INC + 1920 + ch0);
#pragma unroll
        for (int p = 0; p < 4; ++p) {
          float v[8];
          unpack8(vv[p], v);
          float sm = ((v[0] + v[1]) + (v[2] + v[3])) + ((v[4] + v[5]) + (v[6] + v[7]));
          float mean = group8_sum(sm) * (1.0f / 64);
          float sq = 0.f;
#pragma unroll
          for (int i = 0; i < 8; ++i) { v[i] -= mean; sq += v[i] * v[i]; }
          float rstd = __builtin_amdgcn_rsqf(group8_sum(sq) * (1.0f / 64) + EPS);
          const int r = r8 + 32 * p;
#pragma unroll
          for (int i = 0; i < 8; ++i) vnT[(c8 * 8 + i) * 136 + r] = f2bf(v[i] * rstd * lg[i] + lb[i]);
        }
      }
      __syncthreads();
      const int fr = lane & 15, fq = lane >> 4;
      const bf16_t* wsh = wsb + (size_t)hc * 128 * 128;
      f32x4 acc[4][2];
#pragma unroll
      for (int mi = 0; mi < 4; ++mi)
#pragma unroll
        for (int ni = 0; ni < 2; ++ni) acc[mi][ni] = f32x4{0.f, 0.f, 0.f, 0.f};
      const int nkk = (wid < 2) ? 2 : 4;
      for (int kk = 0; kk < nkk; ++kk) {
        bf16x8 af[4], bf_[2];
#pragma unroll
        for (int ni = 0; ni < 2; ++ni) bf_[ni] = *(const bf16x8*)(wsh + (size_t)(wid * 32 + ni * 16 + fr) * 128 + kk * 32 + fq * 8);
#pragma unroll
        for (int mi = 0; mi < 4; ++mi) af[mi] = *(const bf16x8*)(vnT + (mi * 16 + fr) * 136 + kk * 32 + fq * 8);
#pragma unroll
        for (int mi = 0; mi < 4; ++mi)
#pragma unroll
          for (int ni = 0; ni < 2; ++ni)
            acc[mi][ni] = __builtin_amdgcn_mfma_f32_16x16x32_bf16(af[mi], bf_[ni], acc[mi][ni], 0, 0, 0);
      }
#pragma unroll
      for (int ni = 0; ni < 2; ++ni) {
        const int i = wid * 32 + ni * 16 + fr;
        const float bsv = b_s[hc * 128 + i];
#pragma unroll
        for (int mi = 0; mi < 4; ++mi) {
          const int chb = hc * 64 + mi * 16 + fq * 4;
          uint2 uu = *(const uint2*)(z + (size_t)(t0 + i) * INC + 1536 + chb);
          uint2 pk;
          pk.x = pack2(bflo(uu.x) * (acc[mi][ni][0] + bsv), bfhi(uu.x) * (acc[mi][ni][1] + bsv));
          pk.y = pack2(bflo(uu.y) * (acc[mi][ni][2] + bsv), bfhi(uu.y) * (acc[mi][ni][3] + bsv));
          *(uint2*)(y + (size_t)(t0 + i) * D + 640 + chb) = pk;
        }
      }
      __syncthreads();
    }
  }
}

__device__ __forceinline__ void ins16(float (&lv)[16], float v) {
#pragma unroll
  for (int i = 0; i < 16; ++i) {
    float t = fmaxf(lv[i], v);
    v = fminf(lv[i], v);
    lv[i] = t;
  }
}

__device__ __forceinline__ void bitonic_sort16_desc(float (&v)[16]) {
#pragma unroll
  for (int k = 2; k <= 16; k <<= 1) {
#pragma unroll
    for (int j = k >> 1; j > 0; j >>= 1) {
#pragma unroll
      for (int i = 0; i < 16; ++i) {
        const int l = i ^ j;
        if (l > i) {
          const bool desc = ((i & k) == 0);
          const float hi = fmaxf(v[i], v[l]), lo = fminf(v[i], v[l]);
          v[i] = desc ? hi : lo; v[l] = desc ? lo : hi;
        }
      }
    }
  }
}
__device__ __forceinline__ void merge_top16(float (&a)[16], const float (&b)[16]) {
#pragma unroll
  for (int i = 0; i < 16; ++i) a[i] = fmaxf(a[i], b[15 - i]);
#pragma unroll
  for (int j = 8; j > 0; j >>= 1) {
#pragma unroll
    for (int i = 0; i < 16; ++i) {
      const int l = i ^ j;
      if (l > i) {
        const float hi = fmaxf(a[i], a[l]), lo = fminf(a[i], a[l]);
        a[i] = hi; a[l] = lo;
      }
    }
  }
}
__device__ __forceinline__ void phase_scores(const int TIDX, const int BIDX, const bf16_t* __restrict__ q, const bf16_t* __restrict__ keys  ,
                             int* __restrict__ idxo, float* __restrict__ gateo, char* smem) {
  const int tid = TIDX, lane = tid & 63, wid = tid >> 6;
  const int wr = wid >> 1, wc = wid & 1, fr = lane & 15, fq = lane >> 4;
  float* sT = (float*)smem;
  unsigned* slot = (unsigned*)smem;
  const int m = tid & 127, part = (tid >> 7) ^ ((BIDX >= (int)gridDim.x) ? 1 : 0);
  u32x4_k pra[4], prb[4];
  if (BIDX < 512 * 8) gemm_kloop_issue(tid, q + (size_t)(BIDX >> 3) * 128 * 2048 + (BIDX & 7) * 256, 2048, keys + (size_t)((BIDX & 7) * 2) * 128 * 128, 128, pra, prb);
  const int vstep = VGRID;
  for (int item = BIDX; item < 512 * 8; item += vstep) {
    const int tt = item >> 3, hd = item & 7;
    int tid_i = tid;
    asm volatile("" : "+v"(tid_i));
    float v1[16], v2[16];
#pragma unroll
    for (int half = 0; half < 2; ++half) {
      f32x4 acc[4][4];
      gemm_kloop(tid_i, BIDX, q + (size_t)tt * 128 * 2048 + hd * 256 + half * 128, 2048,
                 keys + (size_t)(hd * 2 + half) * 128 * 128, 128, 128, smem, acc, pra, prb);
      if (half == 0) {
        gemm_kloop_issue(tid_i, q + (size_t)tt * 128 * 2048 + hd * 256 + 128, 2048, keys + (size_t)(hd * 2 + 1) * 128 * 128, 128, pra, prb);
      } else if (item + vstep < 512 * 8) {
        const int ni = item + vstep;
        gemm_kloop_issue(tid_i, q + (size_t)(ni >> 3) * 128 * 2048 + (ni & 7) * 256, 2048, keys + (size_t)((ni & 7) * 2) * 128 * 128, 128, pra, prb);
      }
      float* sbase = sT + (wc * 64 + fq * 4) * 128 + wr * 64 + fr;
#pragma unroll
      for (int mi = 0; mi < 4; ++mi)
#pragma unroll
        for (int ni = 0; ni < 4; ++ni)
#pragma unroll
          for (int j = 0; j < 4; ++j)
            sbase[ni * 2048 + j * 128 + mi * 16] = acc[mi][ni][j];
      __syncthreads();
      float lv[16];
#pragma unroll
      for (int c = 0; c < 4; ++c) {
        float ck[16];
        int pb = part * 64;
        asm volatile("" : "+v"(pb));
        const float* srow = sT + pb * 128 + m;
#pragma unroll
        for (int i = 0; i < 16; ++i) {
          const int key = pb + c * 16 + i;
          ck[i] = __uint_as_float((__float_as_uint(srow[(c * 16 + i) * 128]) & 0xffffff80u) | (unsigned)key);
        }
        bitonic_sort16_desc(ck);
        if (c == 0) {
#pragma unroll
          for (int i = 0; i < 16; ++i) lv[i] = ck[i];
        } else {
          merge_top16(lv, ck);
        }
        __builtin_amdgcn_sched_barrier(0);
      }
      __syncthreads();
      if (part == 1) {
#pragma unroll
        for (int i = 0; i < 16; ++i) sT[i * 128 + m] = lv[i];
      }
      __syncthreads();
      if (part == 0) {
        float ob[16];
#pragma unroll
        for (int i = 0; i < 16; ++i) ob[i] = sT[i * 128 + m];
        merge_top16(lv, ob);
      }
      __syncthreads();
      if (half == 0) {
#pragma unroll
        for (int i = 0; i < 16; ++i) v1[i] = lv[i];
      } else {
#pragma unroll
        for (int i = 0; i < 16; ++i) v2[i] = lv[i];
      }
    }
    if (part == 0) {
#pragma unroll
      for (int i = 0; i < 16; ++i) {
        slot[m * 33 + i] = __float_as_uint(v1[i]);
        slot[m * 33 + 16 + i] = __float_as_uint(v2[i]);
      }
      float fv[16];
#pragma unroll
      for (int i = 0; i < 16; ++i) fv[i] = -3.0e38f;
#pragma unroll
      for (int a = 0; a < 16; ++a)
#pragma unroll
        for (int b = 0; b < 16; ++b)
          if ((a + 1) * (b + 1) <= 16) {
            float sum = __uint_as_float(__float_as_uint(v1[a]) & 0xffffff80u) + __uint_as_float(__float_as_uint(v2[b]) & 0xffffff80u);
            unsigned u = (__float_as_uint(sum) & 0xffffff00u) | (unsigned)(a * 16 + b);
            ins16(fv, __uint_as_float(u));
          }
      float e[16];
      int ex[16];
      float mx = __uint_as_float(__float_as_uint(fv[0]) & 0xffffff00u), sum = 0.f;
#pragma unroll
      for (int i = 0; i < 16; ++i) {
        unsigned u = __float_as_uint(fv[i]);
        int code = (int)(u & 0xffu);
        float val = __uint_as_float(u & 0xffffff00u);
        int k1 = (int)(slot[m * 33 + (code >> 4)] & 127u);
        int k2 = (int)(slot[m * 33 + 16 + (code & 15)] & 127u);
        ex[i] = k1 * 128 + k2;
        e[i] = __expf(val - mx);
        sum += e[i];
      }
      float inv = __builtin_amdgcn_rcpf(sum);
      size_t o = (size_t)(tt * 128 + m) * 128 + hd * 16;
#pragma unroll
      for (int i = 0; i < 16; i += 4) {
        *(int4*)(idxo + o + i) = int4{ex[i], ex[i + 1], ex[i + 2], ex[i + 3]};
        *(float4*)(gateo + o + i) = float4{e[i] * inv, e[i + 1] * inv, e[i + 2] * inv, e[i + 3] * inv};
      }
    }
    __syncthreads();
  }
}

__device__ __forceinline__ void peer_issue(uint4 (&buf)[8], const unsigned char* __restrict__ tab, int idv, int gp, int lane) {
#pragma unroll
  for (int e = 0; e < 8; ++e) {
    const unsigned ex = (unsigned)__builtin_amdgcn_readlane(idv, 8 * e + gp);
    const unsigned char* rowp = tab + ((size_t)ex << 10);
    buf[e] = *(const uint4*)(rowp + (unsigned)(lane << 4));
  }
}
__device__ __forceinline__ float peer_dot(const uint4& r, const f32x2 (&x2)[8]) {
  f32x2 a0 = __builtin_amdgcn_cvt_pk_f32_fp8((int)r.x, false) * x2[0];
  f32x2 a1 = __builtin_amdgcn_cvt_pk_f32_fp8((int)r.x, true) * x2[1];
  a0 += __builtin_amdgcn_cvt_pk_f32_fp8((int)r.y, false) * x2[2];
  a1 += __builtin_amdgcn_cvt_pk_f32_fp8((int)r.y, true) * x2[3];
  a0 += __builtin_amdgcn_cvt_pk_f32_fp8((int)r.z, false) * x2[4];
  a1 += __builtin_amdgcn_cvt_pk_f32_fp8((int)r.z, true) * x2[5];
  a0 += __builtin_amdgcn_cvt_pk_f32_fp8((int)r.w, false) * x2[6];
  a1 += __builtin_amdgcn_cvt_pk_f32_fp8((int)r.w, true) * x2[7];
  a0 += a1;
  return a0.x + a0.y;
}
__device__ __forceinline__ void fmac1(float& o, float a, float x) { asm("v_fmac_f32 %0, %1, %2" : "+v"(o) : "v"(a), "v"(x)); }
__device__ __forceinline__ void peer_axpy(const uint4& r, float a, float (&o)[16]) {
  f32x2 c;
  c = __builtin_amdgcn_cvt_pk_f32_fp8((int)r.x, false); fmac1(o[0], a, c.x); fmac1(o[1], a, c.y);
  c = __builtin_amdgcn_cvt_pk_f32_fp8((int)r.x, true);  fmac1(o[2], a, c.x); fmac1(o[3], a, c.y);
  c = __builtin_amdgcn_cvt_pk_f32_fp8((int)r.y, false); fmac1(o[4], a, c.x); fmac1(o[5], a, c.y);
  c = __builtin_amdgcn_cvt_pk_f32_fp8((int)r.y, true);  fmac1(o[6], a, c.x); fmac1(o[7], a, c.y);
  c = __builtin_amdgcn_cvt_pk_f32_fp8((int)r.z, false); fmac1(o[8], a, c.x); fmac1(o[9], a, c.y);
  c = __builtin_amdgcn_cvt_pk_f32_fp8((int)r.z, true);  fmac1(o[10], a, c.x); fmac1(o[11], a, c.y);
  c = __builtin_amdgcn_cvt_pk_f32_fp8((int)r.w, false); fmac1(o[12], a, c.x); fmac1(o[13], a, c.y);
  c = __builtin_amdgcn_cvt_pk_f32_fp8((int)r.w, true);  fmac1(o[14], a, c.x); fmac1(o[15], a, c.y);
}
__device__ __forceinline__ float reduce8(float (&p)[8], int lane) {
  float q[4];
#pragma unroll
  for (int j = 0; j < 4; ++j) {
    auto r = __builtin_amdgcn_permlane32_swap(__float_as_uint(p[j]), __float_as_uint(p[j + 4]), false, false);
    q[j] = __uint_as_float(r[0]) + __uint_as_float(r[1]);
  }
  float s2[2];
#pragma unroll
  for (int j = 0; j < 2; ++j) {
    auto r = __builtin_amdgcn_permlane16_swap(__float_as_uint(q[j]), __float_as_uint(q[j + 2]), false, false);
    s2[j] = __uint_as_float(r[0]) + __uint_as_float(r[1]);
  }
  const bool b3 = (lane & 8) != 0;
  float keep = b3 ? s2[1] : s2[0];
  float give = b3 ? s2[0] : s2[1];
  float w = keep + dpp_f<0x128>(give);
  w += dpp_f<0xB1>(w);
  w += dpp_f<0x4E>(w);
  w += dpp_f<0x141>(w);
  return w;
}

__device__ __forceinline__ void phase_peer_u(const int TIDX, const int BIDX, const unsigned char* __restrict__ Eu,
                                             const int* __restrict__ idx, const bf16_t* __restrict__ h16, const float* __restrict__ gffn, float* __restrict__ pd, char* smem) {
  const int lane = TIDX & 63, wid = TIDX >> 6;
  const int x = BIDX & 7;
  int nWs = (VGRID >> 3) * 4;
  asm volatile("" : "+s"(nWs));
  const int wslot = __builtin_amdgcn_readfirstlane((BIDX >> 3) * 4 + wid);
  const int g8 = lane >> 3, c8 = lane & 7;
  const int fr = lane & 15, fq = lane >> 4;
  const unsigned tabo = (unsigned)x * (unsigned)(NEXP * 128) + (unsigned)(c8 * 16);
  const unsigned colq = (unsigned)(x * 128 + fq * 16);
  typedef __attribute__((address_space(3))) char lds_char;
  typedef unsigned u32x4_t __attribute__((ext_vector_type(4)));
  typedef __attribute__((address_space(3))) u32x4_t lds_uint4;
  lds_char* lw = (lds_char*)smem + wid * 9216;
  const int woff = g8 * 144 + c8 * 16;
  const int roff = fr * 144 + fq * 16;
  int t = wslot;
  if (t >= T) return;
  int idn[16];
  u32x4_t r[16];
  float gq8[32];
#pragma unroll
  for (int i = 0; i < 16; ++i) { gq8[i] = gffn[colq + i] * 8.0f; gq8[16 + i] = gffn[colq + 64 + i] * 8.0f; }
  typedef __attribute__((address_space(3))) int lds_i;
  typedef __attribute__((address_space(3))) unsigned lds_u;
  lds_i* li = (lds_i*)((lds_char*)smem + 36864 + wid * 1024);
  lds_u* lh = (lds_u*)((lds_char*)smem + 36864 + wid * 1024 + 512);
  int ri0 = idx[(size_t)t * 128 + lane], ri1 = idx[(size_t)t * 128 + 64 + lane];
  unsigned rh = *(const unsigned*)(h16 + (size_t)t * D + x * 128 + 2 * lane);
  li[lane] = ri0; li[64 + lane] = ri1;
  __builtin_amdgcn_wave_barrier();
#pragma unroll
  for (int j = 0; j < 16; ++j) idn[j] = li[8 * j + g8];
#pragma unroll
  for (int j = 0; j < 16; ++j) r[j] = *(const u32x4_t*)(Eu + (size_t)(tabo + ((unsigned)idn[j] << 7)));
  __builtin_amdgcn_wave_barrier();
  if (t + nWs < T) { ri0 = idx[(size_t)(t + nWs) * 128 + lane]; ri1 = idx[(size_t)(t + nWs) * 128 + 64 + lane]; }
  for (; t < T; t += nWs) {
    const int tn = t + nWs, tnn = t + 2 * nWs;
    const bool hasn = tn < T;
    li[lane] = ri0; li[64 + lane] = ri1;
    lh[lane] = rh;
    __builtin_amdgcn_wave_barrier();
#pragma unroll
    for (int j = 0; j < 16; ++j) idn[j] = li[8 * j + g8];
    u32x4_t nc[4];
    nc[0] = *(const lds_uint4*)(lh + fq * 8); nc[1] = *(const lds_uint4*)(lh + fq * 8 + 4);
    nc[2] = *(const lds_uint4*)(lh + 32 + fq * 8); nc[3] = *(const lds_uint4*)(lh + 32 + fq * 8 + 4);
    __builtin_amdgcn_wave_barrier();
    if (hasn) rh = *(const unsigned*)(h16 + (size_t)tn * D + x * 128 + 2 * lane);
    if (tnn < T) { ri0 = idx[(size_t)tnn * 128 + lane]; ri1 = idx[(size_t)tnn * 128 + 64 + lane]; }
    long b8[4];
#pragma unroll
    for (int hh = 0; hh < 2; ++hh) {
      float fv[16];
      const u32x4_t ua = nc[2 * hh], ub = nc[2 * hh + 1];
      fv[0] = bflo(ua.x); fv[1] = bfhi(ua.x); fv[2] = bflo(ua.y); fv[3] = bfhi(ua.y);
      fv[4] = bflo(ua.z); fv[5] = bfhi(ua.z); fv[6] = bflo(ua.w); fv[7] = bfhi(ua.w);
      fv[8] = bflo(ub.x); fv[9] = bfhi(ub.x); fv[10] = bflo(ub.y); fv[11] = bfhi(ub.y);
      fv[12] = bflo(ub.z); fv[13] = bfhi(ub.z); fv[14] = bflo(ub.w); fv[15] = bfhi(ub.w);
      unsigned w[4];
#pragma unroll
      for (int i = 0; i < 4; ++i) {
        int t8 = __builtin_amdgcn_cvt_pk_fp8_f32(fv[4 * i] * gq8[16 * hh + 4 * i], fv[4 * i + 1] * gq8[16 * hh + 4 * i + 1], 0, false);
        t8 = __builtin_amdgcn_cvt_pk_fp8_f32(fv[4 * i + 2] * gq8[16 * hh + 4 * i + 2], fv[4 * i + 3] * gq8[16 * hh + 4 * i + 3], t8, true);
        w[i] = (unsigned)t8;
      }
      b8[2 * hh] = (long)(((unsigned long)w[1] << 32) | w[0]);
      b8[2 * hh + 1] = (long)(((unsigned long)w[3] << 32) | w[2]);
    }
    f32x4 accs[8];
    __builtin_amdgcn_sched_barrier(0);
#define U_QUARTER(q) { \
      lds_char* lb = lw + ((q) & 1) * 4608; \
      *(lds_uint4*)(lb + woff + 0 * 8 * 144) = r[(q) * 4 + 0]; \
      if (hasn) r[(q) * 4 + 0] = *(const u32x4_t*)(Eu + (size_t)(tabo + ((unsigned)idn[(q) * 4 + 0] << 7))); \
      *(lds_uint4*)(lb + woff + 1 * 8 * 144) = r[(q) * 4 + 1]; \
      if (hasn) r[(q) * 4 + 1] = *(const u32x4_t*)(Eu + (size_t)(tabo + ((unsigned)idn[(q) * 4 + 1] << 7))); \
      *(lds_uint4*)(lb + woff + 2 * 8 * 144) = r[(q) * 4 + 2]; \
      if (hasn) r[(q) * 4 + 2] = *(const u32x4_t*)(Eu + (size_t)(tabo + ((unsigned)idn[(q) * 4 + 2] << 7))); \
      *(lds_uint4*)(lb + woff + 3 * 8 * 144) = r[(q) * 4 + 3]; \
      if (hasn) r[(q) * 4 + 3] = *(const u32x4_t*)(Eu + (size_t)(tabo + ((unsigned)idn[(q) * 4 + 3] << 7))); \
      _Pragma("unroll") for (int eg = 0; eg < 2; ++eg) { \
        const u32x4_t a0 = *(const lds_uint4*)(lb + roff + eg * 16 * 144); \
        const u32x4_t a1 = *(const lds_uint4*)(lb + roff + eg * 16 * 144 + 64); \
        f32x4 acc = f32x4{0.f, 0.f, 0.f, 0.f}; \
        acc = __builtin_amdgcn_mfma_f32_16x16x32_fp8_fp8((long)(((unsigned long)a0.y << 32) | a0.x), b8[0], acc, 0, 0, 0); \
        acc = __builtin_amdgcn_mfma_f32_16x16x32_fp8_fp8((long)(((unsigned long)a0.w << 32) | a0.z), b8[1], acc, 0, 0, 0); \
        acc = __builtin_amdgcn_mfma_f32_16x16x32_fp8_fp8((long)(((unsigned long)a1.y << 32) | a1.x), b8[2], acc, 0, 0, 0); \
        acc = __builtin_amdgcn_mfma_f32_16x16x32_fp8_fp8((long)(((unsigned long)a1.w << 32) | a1.z), b8[3], acc, 0, 0, 0); \
        accs[(q) * 2 + eg] = acc; \
      } \
      __builtin_amdgcn_sched_barrier(0); }
    U_QUARTER(0) U_QUARTER(1) U_QUARTER(2) U_QUARTER(3)
#undef U_QUARTER
    {
      f32x4 sel = accs[0];
#pragma unroll
      for (int k = 1; k < 8; ++k) sel = (fr == k) ? accs[k] : sel;
      if (fr < 8) { uint2 pk; pk.x = pack2(sel[0], sel[1]); pk.y = pack2(sel[2], sel[3]);
        *(uint2*)((bf16_t*)pd + ((size_t)x * T + t) * 128 + fr * 16 + fq * 4) = pk; }
    }
  }
}

__device__ __forceinline__ void phase_peer_act(const int TIDX, const int BIDX, const float* __restrict__ pd, const int* __restrict__ idx,
                                               const float* __restrict__ gate, const float* __restrict__ su, const float* __restrict__ sv,
                                               const float* __restrict__ ssq, float* __restrict__ act) {
  const size_t gtid = (size_t)BIDX * 256 + TIDX, gsz = (size_t)VGRID * 256;
  constexpr size_t N8 = (size_t)T * 16;
  for (size_t u8 = gtid; u8 < N8; u8 += gsz) {
    uint4 p[8];
#pragma unroll
    for (int x = 0; x < 8; ++x) p[x] = ((const uint4*)((const bf16_t*)pd + (size_t)x * T * 128))[u8];
    const int4 e0 = ((const int4*)idx)[2 * u8], e1 = ((const int4*)idx)[2 * u8 + 1];
    const float4 g0 = ((const float4*)gate)[2 * u8], g1 = ((const float4*)gate)[2 * u8 + 1];
    float suv[8], svv[8];
    suv[0] = su[e0.x]; suv[1] = su[e0.y]; suv[2] = su[e0.z]; suv[3] = su[e0.w];
    suv[4] = su[e1.x]; suv[5] = su[e1.y]; suv[6] = su[e1.z]; suv[7] = su[e1.w];
    svv[0] = sv[e0.x]; svv[1] = sv[e0.y]; svv[2] = sv[e0.z]; svv[3] = sv[e0.w];
    svv[4] = sv[e1.x]; svv[5] = sv[e1.y]; svv[6] = sv[e1.z]; svv[7] = sv[e1.w];
    const float rsq = __builtin_amdgcn_rsqf(ssq[u8 >> 4] * (1.0f / D) + EPS) * 0.125f;
    float d[8];
#pragma unroll
    for (int i = 0; i < 8; ++i) d[i] = 0.f;
#pragma unroll
    for (int x = 0; x < 8; ++x) {
      d[0] += bflo(p[x].x); d[1] += bfhi(p[x].x); d[2] += bflo(p[x].y); d[3] += bfhi(p[x].y);
      d[4] += bflo(p[x].z); d[5] += bfhi(p[x].z); d[6] += bflo(p[x].w); d[7] += bfhi(p[x].w);
    }
    const float gv[8] = {g0.x, g0.y, g0.z, g0.w, g1.x, g1.y, g1.z, g1.w};
    float o[8];
#pragma unroll
    for (int i = 0; i < 8; ++i) o[i] = gelu_tanh(d[i] * suv[i] * rsq) * gv[i] * svv[i];
    ((float4*)act)[2 * u8] = float4{o[0], o[1], o[2], o[3]};
    ((float4*)act)[2 * u8 + 1] = float4{o[4], o[5], o[6], o[7]};
  }
}

__device__ __forceinline__ void phase_peer_v(const int TIDX, const int BIDX, const unsigned char* __restrict__ Ev,
                                             const int* __restrict__ idx, const float* __restrict__ act, bf16_t* h, bf16_t* a3,
                                             float* __restrict__ ssq, char* smem) {
  const int lane = TIDX & 63, wid = TIDX >> 6;
  const int x = BIDX & 7;
  int nWs = (VGRID >> 3) * 4;
  asm volatile("" : "+s"(nWs));
  const int wslot = __builtin_amdgcn_readfirstlane((BIDX >> 3) * 4 + wid);
  const int g = lane >> 3, c8 = lane & 7;
  const unsigned tabo = (unsigned)x * (unsigned)(NEXP * 128) + (unsigned)(c8 * 16);
  typedef __attribute__((address_space(3))) int lds_i;
  typedef __attribute__((address_space(3))) float lds_f;
  typedef int i32x4_t __attribute__((ext_vector_type(4)));
  typedef float f32x4_t __attribute__((ext_vector_type(4)));
  typedef __attribute__((address_space(3))) i32x4_t lds_i4;
  typedef __attribute__((address_space(3))) f32x4_t lds_f4;
  lds_i* li = (lds_i*)((__attribute__((address_space(3))) char*)smem + wid * 1024);
  lds_f* lf = (lds_f*)((__attribute__((address_space(3))) char*)smem + wid * 1024 + 512);
  int t = wslot;
  if (t >= T) return;
  typedef unsigned u32x4_t __attribute__((ext_vector_type(4)));
  u32x4_t r[16];
  i32x4_t idn[4];
  f32x4_t ac[4];
  int ri0 = idx[(size_t)t * 128 + lane], ri1 = idx[(size_t)t * 128 + 64 + lane];
  float ra0 = act[(size_t)t * 128 + lane], ra1 = act[(size_t)t * 128 + 64 + lane];
  li[lane] = ri0; li[64 + lane] = ri1;
  __builtin_amdgcn_wave_barrier();
#pragma unroll
  for (int q = 0; q < 4; ++q) idn[q] = *(const lds_i4*)(li + g * 16 + q * 4);
#pragma unroll
  for (int j = 0; j < 16; ++j) {
    const unsigned e = (unsigned)idn[j >> 2][j & 3];
    r[j] = *(const u32x4_t*)(Ev + (size_t)(tabo + (e << 7)));
  }
  __builtin_amdgcn_wave_barrier();
  if (t + nWs < T) { ri0 = idx[(size_t)(t + nWs) * 128 + lane]; ri1 = idx[(size_t)(t + nWs) * 128 + 64 + lane]; }
  for (; t < T; t += nWs) {
    const int tn = t + nWs, tnn = t + 2 * nWs;
    const bool hasn = tn < T;
    const int col = x * 128 + c8 * 16 + 2 * g;
    li[lane] = ri0; li[64 + lane] = ri1;
    lf[lane] = ra0; lf[64 + lane] = ra1;
    __builtin_amdgcn_wave_barrier();
#pragma unroll
    for (int q = 0; q < 4; ++q) {
      idn[q] = *(const lds_i4*)(li + g * 16 + q * 4);
      ac[q] = *(const lds_f4*)(lf + g * 16 + q * 4);
    }
    __builtin_amdgcn_wave_barrier();
    const unsigned hp = *(const unsigned*)(h + (size_t)t * D + col);
    float2 hv = float2{bflo(hp), bfhi(hp)};
    if (hasn) { ra0 = act[(size_t)tn * 128 + lane]; ra1 = act[(size_t)tn * 128 + 64 + lane]; }
    if (tnn < T) { ri0 = idx[(size_t)tnn * 128 + lane]; ri1 = idx[(size_t)tnn * 128 + 64 + lane]; }
    __builtin_amdgcn_sched_barrier(0);
    float o[16];
#pragma unroll
    for (int i = 0; i < 16; ++i) o[i] = 0.f;
#pragma unroll
    for (int j = 0; j < 16; ++j) {
      peer_axpy(uint4{r[j].x, r[j].y, r[j].z, r[j].w}, ac[j >> 2][j & 3], o);
      if (hasn) {
        const unsigned e = (unsigned)idn[j >> 2][j & 3];
        r[j] = *(const u32x4_t*)(Ev + (size_t)(tabo + (e << 7)));
      }
      __builtin_amdgcn_sched_barrier(0);
    }
    float q8[8];
#pragma unroll
    for (int i = 0; i < 8; ++i) {
      auto rr = __builtin_amdgcn_permlane32_swap(__float_as_uint(o[i]), __float_as_uint(o[i + 8]), false, false);
      q8[i] = __uint_as_float(rr[0]) + __uint_as_float(rr[1]);
    }
    float s4[4];
#pragma unroll
    for (int i = 0; i < 4; ++i) {
      auto rr = __builtin_amdgcn_permlane16_swap(__float_as_uint(q8[i]), __float_as_uint(q8[i + 4]), false, false);
      s4[i] = __uint_as_float(rr[0]) + __uint_as_float(rr[1]);
    }
    const bool b3 = (lane & 8) != 0;
    float w0 = (b3 ? s4[2] : s4[0]) + dpp_f<0x128>(b3 ? s4[0] : s4[2]);
    float w1 = (b3 ? s4[3] : s4[1]) + dpp_f<0x128>(b3 ? s4[1] : s4[3]);
    hv.x += w0; hv.y += w1;
    float ss = wave_sum(hv.x * hv.x + hv.y * hv.y);
    const unsigned hq = pack2(hv.x, hv.y);
    *(unsigned*)(h + (size_t)t * D + col) = hq;
    *(unsigned*)(a3 + (size_t)t * D + col) = hq;
    if (lane == 0) ssq[(size_t)x * T + t] = ss;
  }
}

#define XB_TMO      128
#define XB_XCNT(j)  (256  + 64 * (j))
#define XB_XSUB(j)  (1280 + 64 * (j))
#define XB_XGEN(j)  (2304 + 64 * (j))
#define XB_TOP      3328
#define XB_TOPGEN   3392
#define XCD_BAR_WORDS 3456
#define XB_SPIN_CAP (1u << 18)
#define LAS __attribute__((address_space(3)))

__device__ __forceinline__ unsigned xb_ld(unsigned* p)              { return __hip_atomic_load(p, __ATOMIC_RELAXED, __HIP_MEMORY_SCOPE_AGENT); }
__device__ __forceinline__ unsigned xb_add(unsigned* p, unsigned v) { return __hip_atomic_fetch_add(p, v, __ATOMIC_RELAXED, __HIP_MEMORY_SCOPE_AGENT); }
__device__ __forceinline__ unsigned xb_xcc_id() { return (unsigned)__builtin_amdgcn_s_getreg((3 << 11) | 20) & 0xFu; }
#define XB_SPIN(cond, bar) do { unsigned _sp = 0; while (cond) { __builtin_amdgcn_s_sleep(1); \
    if ((++_sp & 255u) == 0u) { if (xb_ld(&(bar)[XB_TMO])) break; if (_sp > XB_SPIN_CAP) { atomicAdd(&(bar)[XB_TMO], 1u); break; } } } } while (0)

struct XcdBarrier {
    unsigned* bar; unsigned x;
    volatile LAS unsigned* st;
};

__device__ __forceinline__ XcdBarrier xcd_barrier_post(unsigned* bar, volatile LAS unsigned* st) {
    XcdBarrier b; b.bar = bar; b.x = xb_xcc_id(); b.st = st;
    if (threadIdx.x == 0) (void)xb_add(&bar[XB_XCNT(b.x)], 1u);
    return b;
}
__device__ __forceinline__ void xcd_barrier_complete(unsigned* bar, unsigned x, unsigned& nloc, unsigned& nx) {
    const unsigned G = gridDim.x * gridDim.y * gridDim.z;
    unsigned sum, cnt, mine, sp = 0u;
    for (;;) {
        sum = 0u; cnt = 0u; mine = 0u;
#pragma unroll
        for (unsigned j = 0; j < 16; ++j) { const unsigned c = xb_ld(&bar[XB_XCNT(j)]); sum += c; cnt += (c > 0u) ? 1u : 0u; mine = (j == x) ? c : mine; }
        if (sum == G) break;
        __builtin_amdgcn_s_sleep(1);
        if ((++sp & 255u) == 0u) { if (xb_ld(&bar[XB_TMO])) break; if (sp > XB_SPIN_CAP) { atomicAdd(&bar[XB_TMO], 1u); break; } }
    }
    nloc = mine > 0u ? mine : 1u; nx = cnt > 0u ? cnt : 1u;
}

__device__ __forceinline__ void xcd_barrier(const XcdBarrier& b) {
    asm volatile("s_waitcnt vmcnt(0)" ::: "memory");
    __syncthreads();
    if (threadIdx.x == 0) {
        unsigned* bar = b.bar;
        __builtin_amdgcn_s_waitcnt(0);
        unsigned nloc = b.st[0], nx = b.st[1];
        if (nloc == 0u) { xcd_barrier_complete(bar, b.x, nloc, nx); b.st[0] = nloc; b.st[1] = nx; }
        const unsigned old = xb_add(&bar[XB_XSUB(b.x)], 1u);
        const unsigned gen = old / nloc;
        if (old + 1u == (gen + 1u) * nloc) {
            __builtin_amdgcn_fence(__ATOMIC_RELEASE, "agent");
            asm volatile("s_waitcnt vmcnt(0)" ::: "memory");
            const unsigned og = xb_add(&bar[XB_TOP], 1u);
            const unsigned tg = og / nx;
            if (og + 1u == (tg + 1u) * nx) xb_add(&bar[XB_TOPGEN], 1u);
            else XB_SPIN(xb_ld(&bar[XB_TOPGEN]) == tg, bar);
            __builtin_amdgcn_fence(__ATOMIC_ACQUIRE, "agent");
            xb_add(&bar[XB_XGEN(b.x)], 1u);
            asm volatile("s_waitcnt vmcnt(0)" ::: "memory");
        } else {
            XB_SPIN(xb_ld(&bar[XB_XGEN(b.x)]) == gen, bar);
            __builtin_amdgcn_fence(__ATOMIC_ACQUIRE, "agent");
            asm volatile("s_waitcnt vmcnt(0)" ::: "memory");
        }
    }
    __syncthreads();
}

__device__ __forceinline__ int rebuild_tid(const int wave_id) {
  int lane_id;
  asm volatile("v_mbcnt_lo_u32_b32 %0, -1, 0\n\tv_mbcnt_hi_u32_b32 %0, -1, %0" : "=v"(lane_id));
  return wave_id * 64 + lane_id;
}
__device__ __forceinline__ void run_phase(const int WAVE_ID, const int BL, const Params& P, int ph, char* smem_all) {
  char* ws = P.ws;
  bf16_t* abuf = (bf16_t*)(ws + OFF_ABUF);
  bf16_t* zb = (bf16_t*)(ws + OFF_Z);
  bf16_t* h = (bf16_t*)(ws + OFF_H);
#define VB_PROLOGUE int t2 = rebuild_tid(WAVE_ID); const int TIDX = t2 & 255; const int half_ = __builtin_amdgcn_readfirstlane(t2 >> 8); const int BIDX = BL + half_ * (int)gridDim.x; char* smem = smem_all + half_ * 65536; (void)smem;
  if (ph == 0) { VB_PROLOGUE phase_convert(TIDX, BIDX, P); return; }
  if (ph == NPHASE - 1) { VB_PROLOGUE phase_norm<2, true>(TIDX, BIDX, h, P.in[22], nullptr, P.out); return; }
  const int L = (ph - 1) / 11, s = (ph - 1) % 11;
  const unsigned char* Eu = (const unsigned char*)(ws + OFF_EU) + (size_t)L * NEXP * 1024;
  const unsigned char* Ev = (const unsigned char*)(ws + OFF_EV) + (size_t)L * NEXP * 1024;
  const float* su = (const float*)(ws + OFF_ESC) + L * NEXP;
  const float* sv = (const float*)(ws + OFF_ESC) + (2 + L) * NEXP;
  int* idxb = (int*)(ws + OFF_IDX);
  float* gateb = (float*)(ws + OFF_GATE);
  float* pd = (float*)(ws + OFF_Z);
  float* actb = (float*)(ws + OFF_ACT);
  float* ssq = (float*)(ws + OFF_SSQ);
  float* ssqA = (float*)(ws + OFF_SSQA);
  float* ssqB = (float*)(ws + OFF_SSQB);
  switch (s) {
    case 0: { VB_PROLOGUE phase_norm<0, false>(TIDX, BIDX, P.in[0], nullptr, abuf, nullptr); } break;
    case 1: if (L == 0) run_gemm(rebuild_tid(WAVE_ID), BL, smem_all, abuf, (const bf16_t*)(ws + OFF_WINT), 2304, 1024, pg8::EpiBf16<0>{zb, 2304, nullptr, 0, 0});
            else run_gemm(rebuild_tid(WAVE_ID), BL, smem_all, h, (const bf16_t*)(ws + OFF_WINT) + (size_t)2304 * 1024, 2304, 1024, EpiBf16Rs{zb, 2304, ssqB, WAVE_ID}); break;
    case 2: { VB_PROLOGUE for (int i = BIDX * 256 + TIDX; i < T; i += VGRID * 256) ssqA[i] = 0.f;
      phase_mix(TIDX, BIDX, P, L, zb, abuf, (const bf16_t*)(ws + OFF_WSB) + (size_t)L * 6 * 128 * 128, smem); } break;
    case 3: if (L == 0) run_gemm(rebuild_tid(WAVE_ID), BL, smem_all, abuf, (const bf16_t*)(ws + OFF_WOUTT), 1024, 1024, EpiResid<false>{P.in[0], h, ssqA, WAVE_ID});
            else run_gemm(rebuild_tid(WAVE_ID), BL, smem_all, abuf, (const bf16_t*)(ws + OFF_WOUTT) + (size_t)1024 * 1024, 1024, 1024, EpiResid<true>{h, h, ssqA, WAVE_ID}); break;
    case 4: break;
    case 5: run_gemm(rebuild_tid(WAVE_ID), BL, smem_all, h, (const bf16_t*)(ws + OFF_WQT) + (size_t)L * 2048 * 1024, 2048, 1024, EpiBf16Rs{zb, 2048, ssqA, WAVE_ID}); break;
    case 6: { VB_PROLOGUE
      phase_scores(TIDX, BIDX, zb, (const bf16_t*)(ws + OFF_KEYS) + (size_t)L * 8 * 2 * 128 * 128, idxb, gateb, smem); } break;
    case 7: { VB_PROLOGUE
      phase_peer_u(TIDX, BIDX, Eu, idxb, h, P.in[14] + L * 1024, pd, smem); } break;
    case 8: { VB_PROLOGUE for (int i = BIDX * 256 + TIDX; i < T; i += VGRID * 256) ssqB[i] = 0.f;
      phase_peer_act(TIDX, BIDX, pd, idxb, gateb, su, sv, ssqA, actb); } break;
    case 9: { VB_PROLOGUE phase_peer_v(TIDX, BIDX, Ev, idxb, actb, h, abuf, ssq, smem); } break;
    case 10:
      run_gemm(rebuild_tid(WAVE_ID), BL, smem_all, abuf, (const bf16_t*)(ws + OFF_WPGT) + (size_t)L * 1024 * 1024, 1024, 1024, EpiSig{ssq, zb, WAVE_ID});
      run_gemm(rebuild_tid(WAVE_ID), BL, smem_all, (const bf16_t*)(ws + OFF_PBF) + (size_t)L * T * 256, (const bf16_t*)(ws + OFF_WPET) + (size_t)L * 1024 * 256, 1024, 256, EpiPle{h, zb, ssqB, WAVE_ID});
      break;
  }
}

__global__ void __launch_bounds__(512, 2) peer_trunk_mk(Params P) {
  extern __shared__ __attribute__((aligned(16))) char smem[];
  cg::grid_group grid = cg::this_grid();
  unsigned* bar = (unsigned*)(P.ws + OFF_BAR);
  volatile LAS unsigned* st = (volatile LAS unsigned*)((LAS char*)smem + 131072);
  if (threadIdx.x == 0) { st[0] = 0u; st[1] = 0u; }
  if (blockIdx.x == 0) { for (int i = threadIdx.x; i < XCD_BAR_WORDS; i += 512) bar[i] = 0u; }
  __syncthreads();
  XcdBarrier xb{};
  const int wave_id = __builtin_amdgcn_readfirstlane((int)threadIdx.x >> 6);
  int ph = P.ph_lo;
#ifdef PROBE_DUP
  int dup_left = 1;
#endif
  while (ph < P.ph_hi) {
    int bl = (int)__builtin_amdgcn_workgroup_id_x();
    asm volatile("" : "+s"(bl));
    run_phase(wave_id, bl, P, ph, smem);
    int nph = ph + 1;
    while (nph < NPHASE - 1 && (((nph - 1) % 11) == 4 || nph == 12)) ++nph;
#ifdef PROBE_DUP
    if (ph == 1 + PROBE_DUP && dup_left) { dup_left = 0; nph = ph; }
#endif
    if (nph < P.ph_hi) {
      if (ph == 0) { grid.sync(); xb = xcd_barrier_post(bar, st); }
      else xcd_barrier(xb);
    }
    ph = nph;
  }
}

extern "C" void kernel_launch(void* const* d_in, const int* in_sizes, int n_in, void* d_out, int out_size,
                              void* d_ws, size_t ws_size, hipStream_t stream) {
  static int grid_blocks = 0;
  if (grid_blocks == 0) {
    if (n_in != 23 || ws_size < WS_END) { fprintf(stderr, "kernel_launch: unexpected n_in %d or ws_size %zu (< %zu)\n", n_in, ws_size, (size_t)WS_END); grid_blocks = -1; return; }
    int dev = 0, cus = 0, per_cu = 0;
    hipGetDevice(&dev);
    hipDeviceGetAttribute(&cus, hipDeviceAttributeMultiprocessorCount, dev);
    hipFuncSetAttribute((const void*)peer_trunk_mk, hipFuncAttributeMaxDynamicSharedMemorySize, SMEM_BYTES);
    hipOccupancyMaxActiveBlocksPerMultiprocessor(&per_cu, (const void*)peer_trunk_mk, 512, SMEM_BYTES);
    if (per_cu < 1) per_cu = 1;
    if (per_cu > 1) per_cu = 1;
    grid_blocks = cus * per_cu;
    fprintf(stderr, "kernel_launch: cus %d per_cu %d grid %d\n", cus, per_cu, grid_blocks);
  }
  if (grid_blocks < 0) return;
  Params P{};
  for (int i = 0; i < 23; ++i) P.in[i] = (const float*)d_in[i];
  P.out = (float*)d_out;
  P.ws = (char*)d_ws;
#if ONE_LAUNCH
  P.ph_lo = 0; P.ph_hi = NPHASE;
  void* args[] = {&P};
  hipError_t e = hipLaunchCooperativeKernel((void*)peer_trunk_mk, dim3(grid_blocks), dim3(512), args, SMEM_BYTES, stream);
  if (e != hipSuccess) fprintf(stderr, "cooperative launch failed: %s (grid %d)\n", hipGetErrorString(e), grid_blocks);
#else
  for (int ph = 0; ph < NPHASE; ++ph) {
    P.ph_lo = ph; P.ph_hi = ph + 1;
    hipLaunchKernelGGL(peer_trunk_mk, dim3(grid_blocks), dim3(512), SMEM_BYTES, stream, P);
  }
#endif
}
```

```cpp
#include <hip/hip_runtime.h>
#include <hip/hip_bf16.h>
#include <hip/hip_cooperative_groups.h>
#include <cstdio>
namespace cg = cooperative_groups;

#ifndef ONE_LAUNCH
#define ONE_LAUNCH 1
#endif

typedef unsigned short bf16_t;
using bf16x8 = __attribute__((ext_vector_type(8))) short;
using f32x4 = __attribute__((ext_vector_type(4))) float;

constexpr int T = 65536;
constexpr int D = 1024;
constexpr int SEQ = 8192;
constexpr int INC = 2304;
constexpr int NEXP = 16384;
constexpr float EPS = 1e-6f;
constexpr int SMEM_BYTES = 131072 + 16;
__device__ __forceinline__ int launder_s(int x) { asm volatile("" : "+s"(x)); return x; }
#define VGRID (launder_s((int)gridDim.x * 2))
constexpr int NPHASE = 24;

constexpr size_t OFF_WINT = 0;
constexpr size_t OFF_WOUTT = OFF_WINT + (size_t)2 * 2304 * 1024 * 2;
constexpr size_t OFF_WQT = OFF_WOUTT + (size_t)2 * 1024 * 1024 * 2;
constexpr size_t OFF_WPGT = OFF_WQT + (size_t)2 * 2048 * 1024 * 2;
constexpr size_t OFF_WPET = OFF_WPGT + (size_t)2 * 1024 * 1024 * 2;
constexpr size_t OFF_KEYS = OFF_WPET + (size_t)2 * 1024 * 256 * 2;
constexpr size_t OFF_EU = OFF_KEYS + (size_t)2 * 8 * 2 * 128 * 128 * 2;
constexpr size_t OFF_EV = OFF_EU + (size_t)2 * NEXP * 1024;
constexpr size_t OFF_ESC = OFF_EV + (size_t)2 * NEXP * 1024;
constexpr size_t OFF_PBF = OFF_ESC + (size_t)4 * NEXP * 4;
constexpr size_t OFF_ABUF = OFF_PBF + (size_t)2 * T * 256 * 2;
constexpr size_t OFF_Z = OFF_ABUF + (size_t)T * 1024 * 2;
constexpr size_t OFF_IDX = OFF_Z + (size_t)T * 2304 * 2;
constexpr size_t OFF_GATE = OFF_IDX + (size_t)T * 128 * 4;
constexpr size_t OFF_WSB = OFF_GATE + (size_t)T * 128 * 4;
constexpr size_t OFF_ACT = OFF_WSB + (size_t)2 * 6 * 128 * 128 * 2;
constexpr size_t OFF_SSQ = OFF_ACT + (size_t)T * 128 * 4;
constexpr size_t OFF_N8 = OFF_SSQ + (size_t)8 * T * 4;
constexpr size_t OFF_BAR = OFF_N8 + (size_t)T * 1024;
constexpr size_t OFF_H = OFF_BAR + 16384;
constexpr size_t OFF_SSQA = OFF_H + (size_t)T * 1024 * 2;
constexpr size_t OFF_SSQB = OFF_SSQA + (size_t)T * 4;
constexpr size_t WS_END = OFF_SSQB + (size_t)T * 4;

struct Params {
  const float* in[23];
  float* out;
  char* ws;
  int ph_lo, ph_hi;
};

typedef float cvt_f2 __attribute__((ext_vector_type(2)));
typedef __bf16 cvt_b2 __attribute__((ext_vector_type(2)));
__device__ __forceinline__ unsigned pack2(float a, float b) {
  const cvt_f2 v = {a, b};
  return __builtin_bit_cast(unsigned, __builtin_convertvector(v, cvt_b2));
}
__device__ __forceinline__ unsigned short f2bf(float f) { return (unsigned short)(pack2(f, f) & 0xffffu); }
__device__ __forceinline__ float bf2f(unsigned short b) { return __uint_as_float(((unsigned)b) << 16); }
__device__ __forceinline__ float bflo(unsigned u) { return __uint_as_float(u << 16); }
__device__ __forceinline__ float bfhi(unsigned u) { return __uint_as_float(u & 0xffff0000u); }
__device__ __forceinline__ float sigmoidf_(float x) { return __builtin_amdgcn_rcpf(1.0f + __builtin_amdgcn_exp2f(x * -1.4426950408889634f)); }
__device__ __forceinline__ float gelu_tanh(float x) {
  float u = 0.7978845608028654f * (x + 0.044715f * x * x * x);
  float e = __builtin_amdgcn_exp2f(u * 2.8853900817779268f);
  float th = 1.0f - 2.0f * __builtin_amdgcn_rcpf(e + 1.0f);
  return 0.5f * x * (1.0f + th);
}
template <int CTRL>
__device__ __forceinline__ float dpp_f(float v) {
  return __int_as_float(__builtin_amdgcn_update_dpp(0, __float_as_int(v), CTRL, 0xF, 0xF, true));
}
__device__ __forceinline__ float wave_sum(float v) {
  v += dpp_f<0xB1>(v);
  v += dpp_f<0x4E>(v);
  v += dpp_f<0x141>(v);
  v += dpp_f<0x140>(v);
  float s = __int_as_float(__builtin_amdgcn_readlane(__float_as_int(v), 0)) +
            __int_as_float(__builtin_amdgcn_readlane(__float_as_int(v), 16)) +
            __int_as_float(__builtin_amdgcn_readlane(__float_as_int(v), 32)) +
            __int_as_float(__builtin_amdgcn_readlane(__float_as_int(v), 48));
  return s;
}

__device__ __forceinline__ float wave_max(float v) {
  v = fmaxf(v, dpp_f<0xB1>(v));
  v = fmaxf(v, dpp_f<0x4E>(v));
  v = fmaxf(v, dpp_f<0x141>(v));
  v = fmaxf(v, dpp_f<0x140>(v));
  float s = fmaxf(fmaxf(__int_as_float(__builtin_amdgcn_readlane(__float_as_int(v), 0)),
                        __int_as_float(__builtin_amdgcn_readlane(__float_as_int(v), 16))),
                  fmaxf(__int_as_float(__builtin_amdgcn_readlane(__float_as_int(v), 32)),
                        __int_as_float(__builtin_amdgcn_readlane(__float_as_int(v), 48))));
  return s;
}
typedef float f32x2 __attribute__((ext_vector_type(2)));
__device__ __forceinline__ float group8_sum(float v) {
  v += dpp_f<0xB1>(v);
  v += dpp_f<0x4E>(v);
  v += dpp_f<0x141>(v);
  return v;
}

__device__ __forceinline__ int lds_off(int r, int c) { return r * 128 + ((c ^ ((r >> 1) & 7)) << 4); }

typedef unsigned u32x4_k __attribute__((ext_vector_type(4)));
__device__ __forceinline__ void gemm_kloop_issue(const int TIDX, const bf16_t* __restrict__ A, int lda, const bf16_t* __restrict__ Bt, int ldb,
                                                 u32x4_k (&ra)[4], u32x4_k (&rb)[4]) {
  const int sr = TIDX >> 3, sc = TIDX & 7;
  const bf16_t* ga = A + (size_t)sr * lda + sc * 8;
  const bf16_t* gb = Bt + (size_t)sr * ldb + sc * 8;
#pragma unroll
  for (int i = 0; i < 4; ++i) {
    ra[i] = *(const u32x4_k*)(ga + (size_t)(32 * i) * lda);
    rb[i] = *(const u32x4_k*)(gb + (size_t)(32 * i) * ldb);
  }
}
__device__ __forceinline__ void gemm_kloop(const int TIDX, const int BIDX, const bf16_t* __restrict__ A, int lda,
                                           const bf16_t* __restrict__ Bt, int ldb, int K,
                                           char* smem, f32x4 (&acc)[4][4], u32x4_k (&ra)[4], u32x4_k (&rb)[4]) {
  const int tid = TIDX, lane = tid & 63, wid = tid >> 6;
  const int wr = wid >> 1, wc = wid & 1;
  const int fr = lane & 15, fq = lane >> 4;
  const int sr = tid >> 3, sc = tid & 7;
  const bf16_t* ga = A + (size_t)sr * lda + sc * 8;
  const bf16_t* gb = Bt + (size_t)sr * ldb + sc * 8;
#pragma unroll
  for (int mi = 0; mi < 4; ++mi)
#pragma unroll
    for (int ni = 0; ni < 4; ++ni) acc[mi][ni] = f32x4{0.f, 0.f, 0.f, 0.f};
#pragma unroll
  for (int i = 0; i < 4; ++i) {
    *(u32x4_k*)(smem + lds_off(sr + 32 * i, sc)) = ra[i];
    *(u32x4_k*)(smem + 16384 + lds_off(sr + 32 * i, sc)) = rb[i];
  }
  __syncthreads();
  const int nt = K >> 6;
  for (int kt = 0; kt < nt; ++kt) {
    char* bufp = smem + (kt & 1) * 32768;
    const bool more = (kt + 1 < nt);
    if (more) {
#pragma unroll
      for (int i = 0; i < 4; ++i) {
        ra[i] = *(const u32x4_k*)(ga + (size_t)(32 * i) * lda + (kt + 1) * 64);
        rb[i] = *(const u32x4_k*)(gb + (size_t)(32 * i) * ldb + (kt + 1) * 64);
      }
    }
#pragma unroll
    for (int kk = 0; kk < 2; ++kk) {
      bf16x8 af[4], bfr[4];
#pragma unroll
      for (int mi = 0; mi < 4; ++mi) af[mi] = *(const bf16x8*)(bufp + lds_off(wr * 64 + mi * 16 + fr, kk * 4 + fq));
#pragma unroll
      for (int ni = 0; ni < 4; ++ni) bfr[ni] = *(const bf16x8*)(bufp + 16384 + lds_off(wc * 64 + ni * 16 + fr, kk * 4 + fq));
#pragma unroll
      for (int mi = 0; mi < 4; ++mi)
#pragma unroll
        for (int ni = 0; ni < 4; ++ni)
          acc[mi][ni] = __builtin_amdgcn_mfma_f32_16x16x32_bf16(bfr[ni], af[mi], acc[mi][ni], 0, 0, 0);
    }
    if (more) {
      char* nb = smem + ((kt + 1) & 1) * 32768;
#pragma unroll
      for (int i = 0; i < 4; ++i) {
        *(u32x4_k*)(nb + lds_off(sr + 32 * i, sc)) = ra[i];
        *(u32x4_k*)(nb + 16384 + lds_off(sr + 32 * i, sc)) = rb[i];
      }
    }
    __syncthreads();
  }
}

__device__ __forceinline__ void transpose_convert(const float* __restrict__ src, const float* __restrict__ g, bf16_t* __restrict__ dst,
                                  int Lc, int K, int N, size_t gtid, size_t gsz) {
  const int K8 = K >> 3;
  const size_t total = (size_t)Lc * K8 * N;
  for (size_t u = gtid; u < total; u += gsz) {
    int n = (int)(u % N);
    size_t r = u / N;
    int kc = (int)(r % K8);
    int l = (int)(r / K8);
    float v[8];
#pragma unroll
    for (int i = 0; i < 8; ++i) {
      int k = kc * 8 + i;
      float w = src[((size_t)l * K + k) * N + n];
      if (g) w *= g[l * K + k];
      v[i] = w;
    }
    uint4 o;
    o.x = pack2(v[0], v[1]); o.y = pack2(v[2], v[3]); o.z = pack2(v[4], v[5]); o.w = pack2(v[6], v[7]);
    *(uint4*)(dst + ((size_t)l * N + n) * K + kc * 8) = o;
  }
}
__device__ __forceinline__ void convert_flat(const float* __restrict__ src, bf16_t* __restrict__ dst, size_t n8, size_t gtid, size_t gsz) {
  for (size_t u = gtid; u < n8; u += gsz) {
    float4 a = ((const float4*)src)[2 * u], b = ((const float4*)src)[2 * u + 1];
    uint4 o;
    o.x = pack2(a.x, a.y); o.y = pack2(a.z, a.w); o.z = pack2(b.x, b.y); o.w = pack2(b.z, b.w);
    ((uint4*)dst)[u] = o;
  }
}
__device__ __forceinline__ void phase_convert(const int TIDX, const int BIDX, const Params& P) {
  const size_t gtid = (size_t)BIDX * 256 + TIDX;
  const size_t gsz = (size_t)VGRID * 256;
  char* ws = P.ws;
  transpose_convert(P.in[3], P.in[2], (bf16_t*)(ws + OFF_WINT), 2, 1024, 2304, gtid, gsz);
  transpose_convert(P.in[13], nullptr, (bf16_t*)(ws + OFF_WOUTT), 2, 1024, 1024, gtid, gsz);
  transpose_convert(P.in[15], P.in[14], (bf16_t*)(ws + OFF_WQT), 2, 1024, 2048, gtid, gsz);
  transpose_convert(P.in[21], P.in[19], (bf16_t*)(ws + OFF_WPGT), 2, 1024, 1024, gtid, gsz);
  transpose_convert(P.in[20], nullptr, (bf16_t*)(ws + OFF_WPET), 2, 256, 1024, gtid, gsz);
  convert_flat(P.in[16], (bf16_t*)(ws + OFF_KEYS), (size_t)2 * 8 * 2 * 128 * 128 / 8, gtid, gsz);
  {
    const int lane = TIDX & 63;
    const int gw = BIDX * 4 + (TIDX >> 6), nW = VGRID * 4;
    float* esc = (float*)(ws + OFF_ESC);
    for (int row0 = gw * 2; row0 < 4 * NEXP; row0 += nW * 2) {
      float4 v[2][4];
#pragma unroll
      for (int rr = 0; rr < 2; ++rr) {
        const int row = row0 + rr;
        const float* src = (row < 2 * NEXP) ? (P.in[17] + (size_t)row * 1024) : (P.in[18] + (size_t)(row - 2 * NEXP) * 1024);
#pragma unroll
        for (int i = 0; i < 4; ++i) v[rr][i] = ((const float4*)src)[lane * 4 + i];
      }
#pragma unroll
      for (int rr = 0; rr < 2; ++rr) {
        const int row = row0 + rr;
        float m = 0.f;
#pragma unroll
        for (int i = 0; i < 4; ++i) m = fmaxf(m, fmaxf(fmaxf(fabsf(v[rr][i].x), fabsf(v[rr][i].y)), fmaxf(fabsf(v[rr][i].z), fabsf(v[rr][i].w))));
        m = wave_max(m);
        const float sc = (m > 0.f) ? 224.0f * __builtin_amdgcn_rcpf(m) : 0.f;
        uint4 o;
        unsigned w[4];
#pragma unroll
        for (int i = 0; i < 4; ++i) {
          int t = __builtin_amdgcn_cvt_pk_fp8_f32(v[rr][i].x * sc, v[rr][i].y * sc, 0, false);
          t = __builtin_amdgcn_cvt_pk_fp8_f32(v[rr][i].z * sc, v[rr][i].w * sc, t, true);
          w[i] = (unsigned)t;
        }
        o.x = w[0]; o.y = w[1]; o.z = w[2]; o.w = w[3];
        *(uint4*)(ws + OFF_EU + (size_t)(row / NEXP) * ((size_t)NEXP * 1024) + (size_t)(lane >> 3) * ((size_t)NEXP * 128) + (size_t)(row % NEXP) * 128 + (lane & 7) * 16) = o;
        if (lane == 0) esc[row] = m * (1.0f / 224.0f);
      }
    }
  }
  {
    bf16_t* wsb = (bf16_t*)(ws + OFF_WSB);
    for (size_t u = gtid; u < (size_t)2 * 6 * 128 * 128; u += gsz) {
      int j = (int)(u & 127), i = (int)((u >> 7) & 127);
      float w = P.in[11][u];
      wsb[u] = ((j >> 6) <= (i >> 6)) ? f2bf(w) : (bf16_t)0;
    }
  }
  convert_flat(P.in[1], (bf16_t*)(ws + OFF_PBF), (size_t)2 * T * 256 / 8, gtid, gsz);
}

template <int MODE, bool INB>
__device__ __forceinline__ void phase_norm(const int TIDX, const int BIDX, const void* __restrict__ hraw, const float* __restrict__ g, bf16_t* __restrict__ abuf, float* __restrict__ outp, unsigned char* __restrict__ n8 = nullptr) {
  const int lane = TIDX & 63, wid = TIDX >> 6;
  const int gw = BIDX * 4 + wid, nW = VGRID * 4;
  float4 gv[4];
  if (MODE != 0) {
#pragma unroll
    for (int i = 0; i < 4; ++i) gv[i] = ((const float4*)g)[lane + 64 * i];
  }
  for (int t0 = gw * 4; t0 < T; t0 += nW * 4) {
    float4 v[4][4];
#pragma unroll
    for (int rr = 0; rr < 4; ++rr)
#pragma unroll
      for (int i = 0; i < 4; ++i) {
        if (INB) {
          const uint2 pk = ((const uint2*)((const bf16_t*)hraw + (size_t)(t0 + rr) * D))[lane + 64 * i];
          v[rr][i] = float4{bflo(pk.x), bfhi(pk.x), bflo(pk.y), bfhi(pk.y)};
        } else {
          v[rr][i] = ((const float4*)((const float*)hraw + (size_t)(t0 + rr) * D))[lane + 64 * i];
        }
      }
#pragma unroll
    for (int rr = 0; rr < 4; ++rr) {
      const int t = t0 + rr;
      float ss = 0.f;
#pragma unroll
      for (int i = 0; i < 4; ++i) ss += v[rr][i].x * v[rr][i].x + v[rr][i].y * v[rr][i].y + v[rr][i].z * v[rr][i].z + v[rr][i].w * v[rr][i].w;
      ss = wave_sum(ss);
      float rs = __builtin_amdgcn_rsqf(ss * (1.0f / D) + EPS);
#pragma unroll
      for (int i = 0; i < 4; ++i) {
        float4 o = v[rr][i];
        o.x *= rs; o.y *= rs; o.z *= rs; o.w *= rs;
        if (MODE != 0) { o.x *= gv[i].x; o.y *= gv[i].y; o.z *= gv[i].z; o.w *= gv[i].w; }
        if (MODE == 2) {
          ((float4*)(outp + (size_t)t * D))[lane + 64 * i] = o;
        } else {
          uint2 pk; pk.x = pack2(o.x, o.y); pk.y = pack2(o.z, o.w);
          ((uint2*)(abuf + (size_t)t * D))[lane + 64 * i] = pk;
          if (MODE == 1) {
            const float c0 = fminf(fmaxf(o.x * 16.0f, -440.f), 440.f), c1 = fminf(fmaxf(o.y * 16.0f, -440.f), 440.f);
            const float c2 = fminf(fmaxf(o.z * 16.0f, -440.f), 440.f), c3 = fminf(fmaxf(o.w * 16.0f, -440.f), 440.f);
            int w8 = __builtin_amdgcn_cvt_pk_fp8_f32(c0, c1, 0, false);
            w8 = __builtin_amdgcn_cvt_pk_fp8_f32(c2, c3, w8, true);
            ((int*)(n8 + (size_t)t * D))[lane + 64 * i] = w8;
          }
        }
      }
    }
  }
}

namespace pg8 {
#define PG8_LAS __attribute__((address_space(3)))
typedef unsigned short bf16_t;
typedef short bf16x8 __attribute__((ext_vector_type(8)));
typedef float f32x4 __attribute__((ext_vector_type(4)));
typedef unsigned u32x4 __attribute__((ext_vector_type(4)));
constexpr int BM = 256, BK = 64, HALF = 128, HTB = HALF * BK * 2  , STAGE_BYTES = 8 * HTB, NXCD = 8, WGM = 8;

__host__ __device__ __forceinline__ int lds_byte(int r, int c) { const int st = (r >> 4) * 2 + (c >> 5), rr = r & 15, cc = c & 31, ob = rr * 64 + cc * 2; return st * 1024 + (ob ^ (((ob >> 9) & 1) << 5)); }
__host__ __device__ __forceinline__ void stage_rc(int b, int& R, int& C) { const int st = b / 1024, sb = b % 1024, swz = sb ^ (((sb >> 9) & 1) << 5); R = (st >> 1) * 16 + swz / 64; C = (st & 1) * 32 + (swz % 64) / 2; }
__host__ __device__ __forceinline__ int perm32(int rho) { const int n = rho >> 4, i = rho & 15; return 8 * (i >> 2) + 4 * n + (i & 3); }

struct Unit { int pm, pn; };
struct Gemm { const bf16_t* A; const bf16_t* Bt; int M, N, K; };

struct StaticOrder {
    int nM, nN, nwg, G, c;
    __host__ __device__ void init(int M, int N, int G_, int c_) { nM = M / BM; nN = N / BM; nwg = nM * nN; G = G_; c = c_; }
    __host__ __device__ bool next(int i, Unit& u) const {
        const long L = (long)i * G + c; if (L >= nwg) return false;
        int wgid = (int)L; { const int q = nwg / NXCD, r = nwg % NXCD, xcd = wgid % NXCD, off = wgid / NXCD; wgid = (xcd < r ? xcd * (q + 1) : r * (q + 1) + (xcd - r) * q) + off; }
        const int nig = WGM * nN, gid = wgid / nig, fm = gid * WGM, gsz = (nM - fm) < WGM ? (nM - fm) : WGM;
        u.pm = fm + ((wgid % nig) % gsz); u.pn = (wgid % nig) / gsz; return true;
    }
    __device__ __forceinline__ void a_ready(const Unit&) const {}
    __device__ __forceinline__ void done(const Unit&) const {}
};
__device__ __forceinline__ unsigned cvt_pk_bf16(float lo, float hi) { unsigned r; asm volatile("v_cvt_pk_bf16_f32 %0, %1, %2" : "=v"(r) : "v"(lo), "v"(hi)); return r; }
typedef float f32x2 __attribute__((ext_vector_type(2)));
__device__ __forceinline__ f32x2 gelu_pk(f32x2 v) {
    const f32x2 av = __builtin_elementwise_abs(v), d = av * 0.2316418882f + 1.0f;
    f32x2 t; t.x = __builtin_amdgcn_rcpf(d.x); t.y = __builtin_amdgcn_rcpf(d.y);
    f32x2 q = t * 0.5307027145f + (-0.7265760135f); q = q * t + 0.7107068705f; q = q * t + (-0.142248368f); q = q * t + 0.127414796f; q = q * t;
    const f32x2 s = (v * v) * (-0.72134752044f);
    f32x2 e; e.x = __builtin_amdgcn_exp2f(s.x); e.y = __builtin_amdgcn_exp2f(s.y);
    const f32x2 m = v * (q * e), r = v - m;
    f32x2 o; o.x = v.x < 0.f ? m.x : r.x; o.y = v.y < 0.f ? m.y : r.y; return o;
}
template <int ACT  > struct EpiBf16 {
    static constexpr bool PERM = true, AFTER_DRAIN = false;
    bf16_t* O; int ldc; const float* bias; int split_cols; size_t split_stride;
    __device__ __forceinline__ void operator()(const f32x4 (&acc)[2][2][4][2], const Unit& u, int wr, int wc, int fr, int fq) const {
        const int row0 = u.pm * BM + wr * 64 + fr; int colt = u.pn * BM; bf16_t* base = O;
        if (split_cols) { const int t = colt / split_cols; base += (size_t)t * split_stride; colt -= t * split_cols; }
        const int col0 = colt + wc * 32 + 8 * fq, bcol0 = u.pn * BM + wc * 32 + 8 * fq;
        f32x4 bv[2][2];
#pragma unroll
        for (int bj = 0; bj < 2; ++bj)
#pragma unroll
            for (int n = 0; n < 2; ++n) bv[bj][n] = bias ? *(const f32x4*)(bias + bcol0 + bj * HALF + 4 * n) : (f32x4){0.f, 0.f, 0.f, 0.f};
#pragma unroll
        for (int ai = 0; ai < 2; ++ai)
#pragma unroll
            for (int m = 0; m < 4; ++m) { bf16_t* rowp = base + (size_t)(row0 + ai * HALF + m * 16) * ldc + col0;
#pragma unroll
                for (int bj = 0; bj < 2; ++bj) { f32x4 v0 = acc[ai][bj][m][0] + bv[bj][0], v1 = acc[ai][bj][m][1] + bv[bj][1];
                    if (ACT == 1) { f32x2 a = gelu_pk((f32x2){v0[0], v0[1]}), b = gelu_pk((f32x2){v0[2], v0[3]}), c = gelu_pk((f32x2){v1[0], v1[1]}), d = gelu_pk((f32x2){v1[2], v1[3]});
                        v0 = (f32x4){a.x, a.y, b.x, b.y}; v1 = (f32x4){c.x, c.y, d.x, d.y}; }
                    if (ACT == 2) {
#pragma unroll
                        for (int j = 0; j < 4; ++j) { v0[j] = 0.5f * v0[j] * (1.0f + erff(v0[j] * 0.70710678f)); v1[j] = 0.5f * v1[j] * (1.0f + erff(v1[j] * 0.70710678f)); } }
                    u32x4 w; w.x = cvt_pk_bf16(v0[0], v0[1]); w.y = cvt_pk_bf16(v0[2], v0[3]); w.z = cvt_pk_bf16(v1[0], v1[1]); w.w = cvt_pk_bf16(v1[2], v1[3]);
                    *(u32x4*)(rowp + bj * HALF) = w; } }
    }
};
template <class Epi, class Sched, bool STAMP = false>
__device__ __forceinline__ void gemm_phase(const int TL, PG8_LAS unsigned char* lds, const Gemm g, const Sched& S, const Epi& E, unsigned long long* stamps) {
    const int tid = TL, wid = __builtin_amdgcn_readfirstlane(tid >> 6), lane = tid & 63, wr = wid >> 2, wc = wid & 3, fr = lane & 15, fq = lane >> 4;
    const int K = g.K, nt = K / BK;
    int ts_lo = 0, ts_hi = 0, nts = 0; const unsigned long long rt_entry = STAMP ? (unsigned long long)wall_clock64() : 0ull;
#define PG8_STAMP() do { if (STAMP && wid == 0 && nts < 64) { const unsigned long long _c = (unsigned long long)clock64(); \
        ts_lo = (lane == nts) ? (int)(unsigned)_c : ts_lo; ts_hi = (lane == nts) ? (int)(unsigned)(_c >> 32) : ts_hi; ++nts; } } while (0)
    PG8_STAMP();
    unsigned voffA[2], voffB[2];
#pragma unroll
    for (int i = 0; i < 2; ++i) { int R, C; stage_rc(tid * 16 + i * 8192, R, C); const int Rb = Epi::PERM ? ((R & ~31) + perm32(R & 31)) : R;
        voffA[i] = (unsigned)(R * K + C) * 2u; voffB[i] = (unsigned)(Rb * K + C) * 2u; }
    const size_t kstep = (size_t)(BK * 2);
    const size_t hstep = (size_t)HALF * K * 2;
    const size_t tstep = 2 * hstep;
    const unsigned ldsw = (unsigned)wid * 1024u;
    const int aoff = lds_byte(wr * 64 + fr, fq * 8), boff = lds_byte(wc * 32 + fr, fq * 8);
#define PG8_SA(b, h) (((b) * 2 + (h)) * HTB)
#define PG8_SB(b, h) ((4 + (b) * 2 + (h)) * HTB)
#define PG8_STAGE(bufoff, gbase, voff) do { _Pragma("unroll") for (int _i = 0; _i < 2; ++_i) \
        __builtin_amdgcn_global_load_lds((const unsigned*)((const char*)(gbase) + (voff)[_i]), (PG8_LAS unsigned*)(lds + (bufoff) + ldsw + _i * 8192), 16, 0, 0); } while (0)
#define PG8_LDA(dst, b, h) do { _Pragma("unroll") for (int m = 0; m < 4; ++m) _Pragma("unroll") for (int k = 0; k < 2; ++k) dst[m][k] = *(const PG8_LAS bf16x8*)(lds + PG8_SA(b, h) + aoff + m * 2048 + k * 1024); } while (0)
#define PG8_LDB(dst, b, h) do { _Pragma("unroll") for (int n = 0; n < 2; ++n) _Pragma("unroll") for (int k = 0; k < 2; ++k) dst[n][k] = *(const PG8_LAS bf16x8*)(lds + PG8_SB(b, h) + boff + n * 2048 + k * 1024); } while (0)
#define PG8_MMA(ai, bj, At, Bt) do { __builtin_amdgcn_s_setprio(1); _Pragma("unroll") for (int m = 0; m < 4; ++m) _Pragma("unroll") for (int n = 0; n < 2; ++n) _Pragma("unroll") for (int k = 0; k < 2; ++k) \
        acc[ai][bj][m][n] = __builtin_amdgcn_mfma_f32_16x16x32_bf16(Bt[n][k], At[m][k], acc[ai][bj][m][n], 0, 0, 0); __builtin_amdgcn_s_setprio(0); } while (0)
#define PG8_WAIT_V(n) asm volatile("s_waitcnt vmcnt(" #n ")" ::: "memory")
#define PG8_WAIT_L(n) asm volatile("s_waitcnt lgkmcnt(" #n ")" ::: "memory")
#define PG8_BAR __builtin_amdgcn_s_barrier()
#define PG8_SCHED __builtin_amdgcn_sched_barrier(0)
    Unit cur, nxt; int ui = 0;
    if (!S.next(0, cur)) return;
    f32x4 acc[2][2][4][2];
#pragma unroll
    for (int a = 0; a < 2; ++a)
#pragma unroll
        for (int b = 0; b < 2; ++b)
#pragma unroll
            for (int m = 0; m < 4; ++m)
#pragma unroll
                for (int n = 0; n < 2; ++n) acc[a][b][m][n] = (f32x4){0.f, 0.f, 0.f, 0.f};
    bf16x8 At[4][2], B0[2][2], B1[2][2];
    const char* cA = (const char*)g.A + (size_t)cur.pm * tstep; const char* cB = (const char*)g.Bt + (size_t)cur.pn * tstep;
    S.a_ready(cur);
    PG8_STAGE(PG8_SB(0, 0), cB, voffB); PG8_STAGE(PG8_SA(0, 0), cA, voffA); PG8_STAGE(PG8_SB(0, 1), cB + hstep, voffB); PG8_STAGE(PG8_SA(0, 1), cA + hstep, voffA);
    if (wr == 1) PG8_BAR;
    PG8_WAIT_V(4); PG8_BAR;
    PG8_STAGE(PG8_SB(1, 0), cB + kstep, voffB); PG8_STAGE(PG8_SA(1, 0), cA + kstep, voffA); PG8_STAGE(PG8_SB(1, 1), cB + hstep + kstep, voffB);
    PG8_WAIT_V(6); PG8_BAR;
    PG8_STAMP();
    for (;;) {
        const bool has_next = S.next(ui + 1, nxt);
        const char* nA = has_next ? (const char*)g.A + (size_t)nxt.pm * tstep : cA; const char* nB = has_next ? (const char*)g.Bt + (size_t)nxt.pn * tstep : cB;
        for (int t = 0; t < nt; t += 2) {
            const bool last = (t == nt - 2);
            const char* a1 = cA + (size_t)(t + 1) * kstep;
            const char* a2 = last ? nA : cA + (size_t)(t + 2) * kstep; const char* b2 = last ? nB : cB + (size_t)(t + 2) * kstep;
            const char* a3 = a2 + kstep; const char* b3 = b2 + kstep;
            if (last && has_next) S.a_ready(nxt);
            PG8_LDB(B0, 0, 0); PG8_SCHED; PG8_LDA(At, 0, 0); PG8_STAGE(PG8_SA(1, 1), a1 + hstep, voffA);
            PG8_WAIT_L(8); PG8_BAR; PG8_WAIT_L(0); PG8_MMA(0, 0, At, B0); PG8_BAR; PG8_SCHED;
            PG8_LDB(B1, 0, 1); PG8_STAGE(PG8_SB(0, 0), b2, voffB);
            PG8_BAR; PG8_WAIT_L(0); PG8_MMA(0, 1, At, B1); PG8_BAR;
            PG8_LDA(At, 0, 1); PG8_STAGE(PG8_SA(0, 0), a2, voffA);
            PG8_BAR; PG8_WAIT_L(0); PG8_MMA(1, 0, At, B0); PG8_BAR; PG8_SCHED;
            PG8_STAGE(PG8_SB(0, 1), b2 + hstep, voffB);
            PG8_WAIT_V(6); PG8_BAR; PG8_MMA(1, 1, At, B1); PG8_BAR;
            PG8_LDB(B0, 1, 0); PG8_SCHED; PG8_LDA(At, 1, 0); PG8_STAGE(PG8_SA(0, 1), a2 + hstep, voffA);
            PG8_WAIT_L(8); PG8_BAR; PG8_WAIT_L(0); PG8_MMA(0, 0, At, B0); PG8_BAR; PG8_SCHED;
            PG8_LDB(B1, 1, 1); PG8_STAGE(PG8_SB(1, 0), b3, voffB);
            PG8_BAR; PG8_WAIT_L(0); PG8_MMA(0, 1, At, B1); PG8_BAR;
            PG8_LDA(At, 1, 1); PG8_STAGE(PG8_SA(1, 0), a3, voffA);
            PG8_BAR; PG8_WAIT_L(0); PG8_MMA(1, 0, At, B0); PG8_BAR; PG8_SCHED;
            PG8_STAGE(PG8_SB(1, 1), b3 + hstep, voffB);
            PG8_WAIT_V(6); PG8_BAR; PG8_MMA(1, 1, At, B1); PG8_BAR;
        }
        PG8_STAMP();
        if constexpr (!Epi::AFTER_DRAIN) { E(acc, cur, wr, wc, fr, fq); S.done(cur); }
        PG8_STAMP();
        if (!has_next) break;
#pragma unroll
        for (int a = 0; a < 2; ++a)
#pragma unroll
            for (int b = 0; b < 2; ++b)
#pragma unroll
                for (int m = 0; m < 4; ++m)
#pragma unroll
                    for (int n = 0; n < 2; ++n) acc[a][b][m][n] = (f32x4){0.f, 0.f, 0.f, 0.f};
        cur = nxt; cA = nA; cB = nB; ++ui;
    }
    PG8_WAIT_V(0);
    if (wr == 0) PG8_BAR;
    PG8_BAR;
    if constexpr (Epi::AFTER_DRAIN) { E.fused(acc, cur, wr, wc, fr, fq, lds, wid, lane); S.done(cur); }
    PG8_STAMP();
    if (STAMP && wid == 0) { stamps[lane] = lane < nts ? (((unsigned long long)(unsigned)ts_hi << 32) | (unsigned)ts_lo) : 0ull;
        if (lane == 62) stamps[62] = rt_entry; if (lane == 63) stamps[63] = (unsigned long long)wall_clock64(); }
#undef PG8_STAMP
#undef PG8_SA
#undef PG8_SB
#undef PG8_STAGE
#undef PG8_LDA
#undef PG8_LDB
#undef PG8_MMA
#undef PG8_WAIT_V
#undef PG8_WAIT_L
#undef PG8_BAR
#undef PG8_SCHED
}
}

template <bool INB>
struct EpiResid {
  static constexpr bool PERM = true, AFTER_DRAIN = false;
  const void* hin; bf16_t* hout; float* ssq; int wave_id;
  __device__ __forceinline__ void operator()(const pg8::f32x4 (&acc)[2][2][4][2], const pg8::Unit& u, int, int, int, int) const {
    int lane_id;
    asm volatile("v_mbcnt_lo_u32_b32 %0, -1, 0\n\tv_mbcnt_hi_u32_b32 %0, -1, %0" : "=v"(lane_id));
    const int wr = wave_id >> 2, wc = wave_id & 3, fr = lane_id & 15, fq = lane_id >> 4;
    const int row0 = u.pm * 256 + wr * 64 + fr, col0 = u.pn * 256 + wc * 32 + 8 * fq;
#pragma unroll
    for (int ai = 0; ai < 2; ++ai)
#pragma unroll
      for (int m = 0; m < 4; ++m) {
        const int row = row0 + ai * 128 + m * 16;
        const size_t ro = (size_t)row * D + col0;
        float sq = 0.f;
#pragma unroll
        for (int bj = 0; bj < 2; ++bj)
#pragma unroll
          for (int n = 0; n < 2; ++n) {
            const size_t o = ro + bj * 128 + n * 4;
            pg8::f32x4 v;
            if (INB) { const uint2 pk = *(const uint2*)((const bf16_t*)hin + o); v = pg8::f32x4{bflo(pk.x), bfhi(pk.x), bflo(pk.y), bfhi(pk.y)}; }
            else v = *(const pg8::f32x4*)((const float*)hin + o);
            v = v + acc[ai][bj][m][n];
            uint2 w; w.x = pack2(v[0], v[1]); w.y = pack2(v[2], v[3]);
            *(uint2*)(hout + o) = w;
            const float r0 = bflo(w.x), r1 = bfhi(w.x), r2 = bflo(w.y), r3 = bfhi(w.y);
            sq += r0 * r0 + r1 * r1 + r2 * r2 + r3 * r3;
          }
        sq += __shfl_xor(sq, 16);
        sq += __shfl_xor(sq, 32);
        if (fq == 0) atomicAdd(ssq + row, sq);
      }
  }
};
struct EpiBf16Rs {
  static constexpr bool PERM = true, AFTER_DRAIN = false;
  bf16_t* O; int ldc; const float* ssq; int wave_id;
  __device__ __forceinline__ void operator()(const pg8::f32x4 (&acc)[2][2][4][2], const pg8::Unit& u, int, int, int, int) const {
    int lane_id;
    asm volatile("v_mbcnt_lo_u32_b32 %0, -1, 0\n\tv_mbcnt_hi_u32_b32 %0, -1, %0" : "=v"(lane_id));
    const int wr = wave_id >> 2, wc = wave_id & 3, fr = lane_id & 15, fq = lane_id >> 4;
    const int row0 = u.pm * 256 + wr * 64 + fr, col0 = u.pn * 256 + wc * 32 + 8 * fq;
#pragma unroll
    for (int ai = 0; ai < 2; ++ai)
#pragma unroll
      for (int m = 0; m < 4; ++m) {
        const int row = row0 + ai * 128 + m * 16;
        const float rs = __builtin_amdgcn_rsqf(ssq[row] * (1.0f / D) + EPS);
        bf16_t* rowp = O + (size_t)row * ldc + col0;
#pragma unroll
        for (int bj = 0; bj < 2; ++bj) {
          const pg8::f32x4 v0 = acc[ai][bj][m][0], v1 = acc[ai][bj][m][1];
          pg8::u32x4 w;
          w.x = pack2(v0[0] * rs, v0[1] * rs); w.y = pack2(v0[2] * rs, v0[3] * rs);
          w.z = pack2(v1[0] * rs, v1[1] * rs); w.w = pack2(v1[2] * rs, v1[3] * rs);
          *(pg8::u32x4*)(rowp + bj * 128) = w;
        }
      }
  }
};
struct EpiSig {
  static constexpr bool PERM = true, AFTER_DRAIN = false;
  const float* ssq; bf16_t* sg; int wave_id;
  __device__ __forceinline__ void operator()(const pg8::f32x4 (&acc)[2][2][4][2], const pg8::Unit& u, int, int, int, int) const {
    int lane_id;
    asm volatile("v_mbcnt_lo_u32_b32 %0, -1, 0\n\tv_mbcnt_hi_u32_b32 %0, -1, %0" : "=v"(lane_id));
    const int wr = wave_id >> 2, wc = wave_id & 3, fr = lane_id & 15, fq = lane_id >> 4;
    const int row0 = u.pm * 256 + wr * 64 + fr, col0 = u.pn * 256 + wc * 32 + 8 * fq;
#pragma unroll
    for (int ai = 0; ai < 2; ++ai)
#pragma unroll
      for (int m = 0; m < 4; ++m) {
        const int row = row0 + ai * 128 + m * 16;
        float sq = 0.f;
#pragma unroll
        for (int xx = 0; xx < 8; ++xx) sq += ssq[(size_t)xx * T + row];
        const float rs = __builtin_amdgcn_rsqf(sq * (1.0f / D) + EPS);
        const size_t ro = (size_t)row * D + col0;
#pragma unroll
        for (int bj = 0; bj < 2; ++bj)
#pragma unroll
          for (int n = 0; n < 2; ++n) {
            const pg8::f32x4 a = acc[ai][bj][m][n];
            uint2 pk;
            pk.x = pack2(sigmoidf_(rs * a[0]), sigmoidf_(rs * a[1]));
            pk.y = pack2(sigmoidf_(rs * a[2]), sigmoidf_(rs * a[3]));
            *(uint2*)(sg + ro + bj * 128 + n * 4) = pk;
          }
      }
  }
};
struct EpiPle {
  static constexpr bool PERM = true, AFTER_DRAIN = false;
  bf16_t* h; const bf16_t* sg; float* ssq; int wave_id;
  __device__ __forceinline__ void operator()(const pg8::f32x4 (&acc)[2][2][4][2], const pg8::Unit& u, int, int, int, int) const {
    int lane_id;
    asm volatile("v_mbcnt_lo_u32_b32 %0, -1, 0\n\tv_mbcnt_hi_u32_b32 %0, -1, %0" : "=v"(lane_id));
    const int wr = wave_id >> 2, wc = wave_id & 3, fr = lane_id & 15, fq = lane_id >> 4;
    const int row0 = u.pm * 256 + wr * 64 + fr, col0 = u.pn * 256 + wc * 32 + 8 * fq;
#pragma unroll
    for (int ai = 0; ai < 2; ++ai)
#pragma unroll
      for (int m = 0; m < 4; ++m) {
        const int row = row0 + ai * 128 + m * 16;
        const size_t ro = (size_t)row * D + col0;
        float sq = 0.f;
#pragma unroll
        for (int bj = 0; bj < 2; ++bj)
#pragma unroll
          for (int n = 0; n < 2; ++n) {
            const size_t o = ro + bj * 128 + n * 4;
            const uint2 pk = *(const uint2*)(sg + o);
            const uint2 hp = *(const uint2*)(h + o);
            const pg8::f32x4 a = acc[ai][bj][m][n];
            uint2 w;
            w.x = pack2(bflo(hp.x) + a[0] * bflo(pk.x), bfhi(hp.x) + a[1] * bfhi(pk.x));
            w.y = pack2(bflo(hp.y) + a[2] * bflo(pk.y), bfhi(hp.y) + a[3] * bfhi(pk.y));
            *(uint2*)(h + o) = w;
            const float r0 = bflo(w.x), r1 = bfhi(w.x), r2 = bflo(w.y), r3 = bfhi(w.y);
            sq += r0 * r0 + r1 * r1 + r2 * r2 + r3 * r3;
          }
        sq += __shfl_xor(sq, 16);
        sq += __shfl_xor(sq, 32);
        if (fq == 0) atomicAdd(ssq + row, sq);
      }
  }
};
template <class Epi>
__device__ __forceinline__ void run_gemm(const int TL, const int BL, char* smem, const bf16_t* A, const bf16_t* Bt, int N, int K, const Epi& E) {
  pg8::Gemm g{A, Bt, T, N, K};
  pg8::StaticOrder S; S.init(T, N, (int)gridDim.x, BL);
  pg8::gemm_phase<Epi, pg8::StaticOrder, false>(TL, (PG8_LAS unsigned char*)smem, g, S, E, nullptr);
}

__device__ __forceinline__ void unpack8(const uint4& u, float (&f)[8]) {
  f[0] = bflo(u.x); f[1] = bfhi(u.x); f[2] = bflo(u.y); f[3] = bfhi(u.y);
  f[4] = bflo(u.z); f[5] = bfhi(u.z); f[6] = bflo(u.w); f[7] = bfhi(u.w);
}
__device__ __forceinline__ void phase_mix(const int TIDX, const int BIDX, const Params& P, int L, const bf16_t* __restrict__ z, bf16_t* __restrict__ y,
                                          const bf16_t* __restrict__ wsb, char* smem) {
  const int tid = TIDX, lane = tid & 63, wid = tid >> 6;
  const int r8 = tid >> 3, c8 = tid & 7;
  const float* conv_a_w = P.in[4] + (size_t)L * 31 * 384;
  const float* conv_a_b = P.in[5] + L * 384;
  const float* ln_a_g = P.in[6] + L * 384;
  const float* ln_a_b = P.in[7] + L * 384;
  const float* conv_b_w = P.in[8] + L * 3 * 256;
  const float* ln_c_g = P.in[9] + L * 384;
  const float* ln_c_b = P.in[10] + L * 384;
  const float* b_s = P.in[12] + L * 6 * 128;
  float* fs = (float*)smem;
  for (int item = BIDX; item < 512 * 16; item += VGRID) {
    const int tb = item >> 4, part = (item ^ (item >> 9)) & 15;
    const int t0 = tb * 128;
    const int s0 = t0 & (SEQ - 1);
    if (part < 6) {
      {
        const int ch0 = part * 64 + c8 * 8;
        uint4 vv[5], gg[5];
#pragma unroll
        for (int p = 0; p < 5; ++p) {
          const int r = r8 + 32 * p;
          vv[p] = uint4{0, 0, 0, 0}; gg[p] = uint4{0, 0, 0, 0};
          if (r < 158 && (r >= 30 || s0 > 0)) {
            const bf16_t* zr = z + (size_t)(t0 - 30 + r) * INC + ch0;
            vv[p] = *(const uint4*)zr;
            gg[p] = *(const uint4*)(zr + 384);
          }
        }
#pragma unroll
        for (int p = 0; p < 5; ++p) {
          const int r = r8 + 32 * p;
          if (r < 158) {
            float a[8], g[8];
            unpack8(vv[p], a); unpack8(gg[p], g);
            float4 o0, o1;
            o0.x = a[0] * sigmoidf_(g[0]); o0.y = a[1] * sigmoidf_(g[1]); o0.z = a[2] * sigmoidf_(g[2]); o0.w = a[3] * sigmoidf_(g[3]);
            o1.x = a[4] * sigmoidf_(g[4]); o1.y = a[5] * sigmoidf_(g[5]); o1.z = a[6] * sigmoidf_(g[6]); o1.w = a[7] * sigmoidf_(g[7]);
            *(float4*)(fs + r * 64 + c8 * 8) = o0;
            *(float4*)(fs + r * 64 + c8 * 8 + 4) = o1;
          }
        }
      }
      const int ch = part * 64 + lane;
      float wk[31];
#pragma unroll
      for (int k = 0; k < 31; ++k) wk[k] = conv_a_w[k * 384 + ch];
      const float cb = conv_a_b[ch], lg = ln_a_g[ch], lb = ln_a_b[ch];
      __syncthreads();
      for (int g4 = 0; g4 < 8; ++g4) {
        const int tl = wid * 32 + g4 * 4;
        float yv[34];
#pragma unroll
        for (int k = 0; k < 34; ++k) yv[k] = fs[(tl + k) * 64 + lane];
#pragma unroll
        for (int q = 0; q < 4; ++q) {
          float a = cb;
#pragma unroll
          for (int k = 0; k < 31; ++k) a += wk[k] * yv[q + k];
          float mean = wave_sum(a) * (1.0f / 64);
          float d = a - mean;
          float var = wave_sum(d * d) * (1.0f / 64);
          float yn = d * __builtin_amdgcn_rsqf(var + EPS) * lg + lb;
          float o = yn * sigmoidf_(yn);
          y[(size_t)(t0 + tl + q) * D + ch] = f2bf(o);
        }
      }
      __syncthreads();
    } else if (part < 10) {
      const int cbn = (part - 6) * 64 + c8 * 8;
      float w0[8], w1[8], w2[8];
#pragma unroll
      for (int i = 0; i < 8; ++i) { w0[i] = conv_b_w[cbn + i]; w1[i] = conv_b_w[256 + cbn + i]; w2[i] = conv_b_w[512 + cbn + i]; }
      const int tl0 = r8 * 4;
      uint4 cgv[6], xbv[6], bgv[4];
#pragma unroll
      for (int k = 0; k < 6; ++k) {
        cgv[k] = uint4{0, 0, 0, 0}; xbv[k] = uint4{0, 0, 0, 0};
        if (k >= 2 || (s0 + tl0) > 0) {
          const bf16_t* zr = z + (size_t)(t0 + tl0 - 2 + k) * INC + cbn;
          cgv[k] = *(const uint4*)(zr + 1024);
          xbv[k] = *(const uint4*)(zr + 1280);
        }
      }
#pragma unroll
      for (int k = 0; k < 4; ++k) bgv[k] = *(const uint4*)(z + (size_t)(t0 + tl0 + k) * INC + 768 + cbn);
      float pr[6][8];
#pragma unroll
      for (int k = 0; k < 6; ++k) {
        float a[8], b[8];
        unpack8(cgv[k], a); unpack8(xbv[k], b);
#pragma unroll
        for (int i = 0; i < 8; ++i) pr[k][i] = a[i] * b[i];
      }
#pragma unroll
      for (int k = 0; k < 4; ++k) {
        float bg[8], o[8];
        unpack8(bgv[k], bg);
#pragma unroll
        for (int i = 0; i < 8; ++i) o[i] = bg[i] * (w0[i] * pr[k][i] + w1[i] * pr[k + 1][i] + w2[i] * pr[k + 2][i]);
        uint4 pk; pk.x = pack2(o[0], o[1]); pk.y = pack2(o[2], o[3]); pk.z = pack2(o[4], o[5]); pk.w = pack2(o[6], o[7]);
        *(uint4*)(y + (size_t)(t0 + tl0 + k) * D + 384 + cbn) = pk;
      }
    } else {
      const int hc = part - 10;
      const int ch0 = hc * 64 + c8 * 8;
      bf16_t* vnT = (bf16_t*)smem;
      {
        float lg[8], lb[8];
#pragma unroll
        for (int i = 0; i < 8; ++i) { lg[i] = ln_c_g[ch0 + i]; lb[i] = ln_c_b[ch0 + i]; }
        uint4 vv[4];
#pragma unroll
        for (int p = 0; p < 4; ++p) vv[p] = *(const uint4*)(z + (size_t)(t0 + r8 + 32 * p) * INC + 1920 + ch0);
#pragma unroll
        for (int p = 0; p < 4; ++p) {
          float v[8];
          unpack8(vv[p], v);
          float sm = ((v[0] + v[1]) + (v[2] + v[3])) + ((v[4] + v[5]) + (v[6] + v[7]));
          float mean = group8_sum(sm) * (1.0f / 64);
          float sq = 0.f;
#pragma unroll
          for (int i = 0; i < 8; ++i) { v[i] -= mean; sq += v[i] * v[i]; }
          float rstd = __builtin_amdgcn_rsqf(group8_sum(sq) * (1.0f / 64) + EPS);
          const int r = r8 + 32 * p;
#pragma unroll
          for (int i = 0; i < 8; ++i) vnT[(c8 * 8 + i) * 136 + r] = f2bf(v[i] * rstd * lg[i] + lb[i]);
        }
      }
      __syncthreads();
      const int fr = lane & 15, fq = lane >> 4;
      const bf16_t* wsh = wsb + (size_t)hc * 128 * 128;
      f32x4 acc[4][2];
#pragma unroll
      for (int mi = 0; mi < 4; ++mi)
#pragma unroll
        for (int ni = 0; ni < 2; ++ni) acc[mi][ni] = f32x4{0.f, 0.f, 0.f, 0.f};
      const int nkk = (wid < 2) ? 2 : 4;
      for (int kk = 0; kk < nkk; ++kk) {
        bf16x8 af[4], bf_[2];
#pragma unroll
        for (int ni = 0; ni < 2; ++ni) bf_[ni] = *(const bf16x8*)(wsh + (size_t)(wid * 32 + ni * 16 + fr) * 128 + kk * 32 + fq * 8);
#pragma unroll
        for (int mi = 0; mi < 4; ++mi) af[mi] = *(const bf16x8*)(vnT + (mi * 16 + fr) * 136 + kk * 32 + fq * 8);
#pragma unroll
        for (int mi = 0; mi < 4; ++mi)
#pragma unroll
          for (int ni = 0; ni < 2; ++ni)
            acc[mi][ni] = __builtin_amdgcn_mfma_f32_16x16x32_bf16(af[mi], bf_[ni], acc[mi][ni], 0, 0, 0);
      }
#pragma unroll
      for (int ni = 0; ni < 2; ++ni) {
        const int i = wid * 32 + ni * 16 + fr;
        const float bsv = b_s[hc * 128 + i];
#pragma unroll
        for (int mi = 0; mi < 4; ++mi) {
          const int chb = hc * 64 + mi * 16 + fq * 4;
          uint2 uu = *(const uint2*)(z + (size_t)(t0 + i) * INC + 1536 + chb);
          uint2 pk;
          pk.x = pack2(bflo(uu.x) * (acc[mi][ni][0] + bsv), bfhi(uu.x) * (acc[mi][ni][1] + bsv));
          pk.y = pack2(bflo(uu.y) * (acc[mi][ni][2] + bsv), bfhi(uu.y) * (acc[mi][ni][3] + bsv));
          *(uint2*)(y + (size_t)(t0 + i) * D + 640 + chb) = pk;
        }
      }
      __syncthreads();
    }
  }
}

__device__ __forceinline__ void ins16(float (&lv)[16], float v) {
#pragma unroll
  for (int i = 0; i < 16; ++i) {
    float t = fmaxf(lv[i], v);
    v = fminf(lv[i], v);
    lv[i] = t;
  }
}

__device__ __forceinline__ void bitonic_sort16_desc(float (&v)[16]) {
#pragma unroll
  for (int k = 2; k <= 16; k <<= 1) {
#pragma unroll
    for (int j = k >> 1; j > 0; j >>= 1) {
#pragma unroll
      for (int i = 0; i < 16; ++i) {
        const int l = i ^ j;
        if (l > i) {
          const bool desc = ((i & k) == 0);
          const float hi = fmaxf(v[i], v[l]), lo = fminf(v[i], v[l]);
          v[i] = desc ? hi : lo; v[l] = desc ? lo : hi;
        }
      }
    }
  }
}
__device__ __forceinline__ void merge_top16(float (&a)[16], const float (&b)[16]) {
#pragma unroll
  for (int i = 0; i < 16; ++i) a[i] = fmaxf(a[i], b[15 - i]);
#pragma unroll
  for (int j = 8; j > 0; j >>= 1) {
#pragma unroll
    for (int i = 0; i < 16; ++i) {
      const int l = i ^ j;
      if (l > i) {
        const float hi = fmaxf(a[i], a[l]), lo = fminf(a[i], a[l]);
        a[i] = hi; a[l] = lo;
      }
    }
  }
}
__device__ __forceinline__ void phase_scores(const int TIDX, const int BIDX, const bf16_t* __restrict__ q, const bf16_t* __restrict__ keys  ,
                             int* __restrict__ idxo, float* __restrict__ gateo, char* smem) {
  const int tid = TIDX, lane = tid & 63, wid = tid >> 6;
  const int wr = wid >> 1, wc = wid & 1, fr = lane & 15, fq = lane >> 4;
  float* sT = (float*)smem;
  unsigned* slot = (unsigned*)smem;
  const int m = tid & 127, part = (tid >> 7) ^ ((BIDX >= (int)gridDim.x) ? 1 : 0);
  u32x4_k pra[4], prb[4];
  if (BIDX < 512 * 8) gemm_kloop_issue(tid, q + (size_t)(BIDX >> 3) * 128 * 2048 + (BIDX & 7) * 256, 2048, keys + (size_t)((BIDX & 7) * 2) * 128 * 128, 128, pra, prb);
  const int vstep = VGRID;
  for (int item = BIDX; item < 512 * 8; item += vstep) {
    const int tt = item >> 3, hd = item & 7;
    int tid_i = tid;
    asm volatile("" : "+v"(tid_i));
    float v1[16], v2[16];
#pragma unroll
    for (int half = 0; half < 2; ++half) {
      f32x4 acc[4][4];
      gemm_kloop(tid_i, BIDX, q + (size_t)tt * 128 * 2048 + hd * 256 + half * 128, 2048,
                 keys + (size_t)(hd * 2 + half) * 128 * 128, 128, 128, smem, acc, pra, prb);
      if (half == 0) {
        gemm_kloop_issue(tid_i, q + (size_t)tt * 128 * 2048 + hd * 256 + 128, 2048, keys + (size_t)(hd * 2 + 1) * 128 * 128, 128, pra, prb);
      } else if (item + vstep < 512 * 8) {
        const int ni = item + vstep;
        gemm_kloop_issue(tid_i, q + (size_t)(ni >> 3) * 128 * 2048 + (ni & 7) * 256, 2048, keys + (size_t)((ni & 7) * 2) * 128 * 128, 128, pra, prb);
      }
      float* sbase = sT + (wc * 64 + fq * 4) * 128 + wr * 64 + fr;
#pragma unroll
      for (int mi = 0; mi < 4; ++mi)
#pragma unroll
        for (int ni = 0; ni < 4; ++ni)
#pragma unroll
          for (int j = 0; j < 4; ++j)
            sbase[ni * 2048 + j * 128 + mi * 16] = acc[mi][ni][j];
      __syncthreads();
      float lv[16];
#pragma unroll
      for (int c = 0; c < 4; ++c) {
        float ck[16];
        int pb = part * 64;
        asm volatile("" : "+v"(pb));
        const float* srow = sT + pb * 128 + m;
#pragma unroll
        for (int i = 0; i < 16; ++i) {
          const int key = pb + c * 16 + i;
          ck[i] = __uint_as_float((__float_as_uint(srow[(c * 16 + i) * 128]) & 0xffffff80u) | (unsigned)key);
        }
        bitonic_sort16_desc(ck);
        if (c == 0) {
#pragma unroll
          for (int i = 0; i < 16; ++i) lv[i] = ck[i];
        } else {
          merge_top16(lv, ck);
        }
        __builtin_amdgcn_sched_barrier(0);
      }
      __syncthreads();
      if (part == 1) {
#pragma unroll
        for (int i = 0; i < 16; ++i) sT[i * 128 + m] = lv[i];
      }
      __syncthreads();
      if (part == 0) {
        float ob[16];
#pragma unroll
        for (int i = 0; i < 16; ++i) ob[i] = sT[i * 128 + m];
        merge_top16(lv, ob);
      }
      __syncthreads();
      if (half == 0) {
#pragma unroll
        for (int i = 0; i < 16; ++i) v1[i] = lv[i];
      } else {
#pragma unroll
        for (int i = 0; i < 16; ++i) v2[i] = lv[i];
      }
    }
    if (part == 0) {
#pragma unroll
      for (int i = 0; i < 16; ++i) {
        slot[m * 33 + i] = __float_as_uint(v1[i]);
        slot[m * 33 + 16 + i] = __float_as_uint(v2[i]);
      }
      float fv[16];
#pragma unroll
      for (int i = 0; i < 16; ++i) fv[i] = -3.0e38f;
#pragma unroll
      for (int a = 0; a < 16; ++a)
#pragma unroll
        for (int b = 0; b < 16; ++b)
          if ((a + 1) * (b + 1) <= 16) {
            float sum = __uint_as_float(__float_as_uint(v1[a]) & 0xffffff80u) + __uint_as_float(__float_as_uint(v2[b]) & 0xffffff80u);
            unsigned u = (__float_as_uint(sum) & 0xffffff00u) | (unsigned)(a * 16 + b);
            ins16(fv, __uint_as_float(u));
          }
      float e[16];
      int ex[16];
      float mx = __uint_as_float(__float_as_uint(fv[0]) & 0xffffff00u), sum = 0.f;
#pragma unroll
      for (int i = 0; i < 16; ++i) {
        unsigned u = __float_as_uint(fv[i]);
        int code = (int)(u & 0xffu);
        float val = __uint_as_float(u & 0xffffff00u);
        int k1 = (int)(slot[m * 33 + (code >> 4)] & 127u);
        int k2 = (int)(slot[m * 33 + 16 + (code & 15)] & 127u);
        ex[i] = k1 * 128 + k2;
        e[i] = __expf(val - mx);
        sum += e[i];
      }
      float inv = __builtin_amdgcn_rcpf(sum);
      size_t o = (size_t)(tt * 128 + m) * 128 + hd * 16;
#pragma unroll
      for (int i = 0; i < 16; i += 4) {
        *(int4*)(idxo + o + i) = int4{ex[i], ex[i + 1], ex[i + 2], ex[i + 3]};
        *(float4*)(gateo + o + i) = float4{e[i] * inv, e[i + 1] * inv, e[i + 2] * inv, e[i + 3] * inv};
      }
    }
    __syncthreads();
  }
}

__device__ __forceinline__ void peer_issue(uint4 (&buf)[8], const unsigned char* __restrict__ tab, int idv, int gp, int lane) {
#pragma unroll
  for (int e = 0; e < 8; ++e) {
    const unsigned ex = (unsigned)__builtin_amdgcn_readlane(idv, 8 * e + gp);
    const unsigned char* rowp = tab + ((size_t)ex << 10);
    buf[e] = *(const uint4*)(rowp + (unsigned)(lane << 4));
  }
}
__device__ __forceinline__ float peer_dot(const uint4& r, const f32x2 (&x2)[8]) {
  f32x2 a0 = __builtin_amdgcn_cvt_pk_f32_fp8((int)r.x, false) * x2[0];
  f32x2 a1 = __builtin_amdgcn_cvt_pk_f32_fp8((int)r.x, true) * x2[1];
  a0 += __builtin_amdgcn_cvt_pk_f32_fp8((int)r.y, false) * x2[2];
  a1 += __builtin_amdgcn_cvt_pk_f32_fp8((int)r.y, true) * x2[3];
  a0 += __builtin_amdgcn_cvt_pk_f32_fp8((int)r.z, false) * x2[4];
  a1 += __builtin_amdgcn_cvt_pk_f32_fp8((int)r.z, true) * x2[5];
  a0 += __builtin_amdgcn_cvt_pk_f32_fp8((int)r.w, false) * x2[6];
  a1 += __builtin_amdgcn_cvt_pk_f32_fp8((int)r.w, true) * x2[7];
  a0 += a1;
  return a0.x + a0.y;
}
__device__ __forceinline__ void fmac1(float& o, float a, float x) { asm("v_fmac_f32 %0, %1, %2" : "+v"(o) : "v"(a), "v"(x)); }
__device__ __forceinline__ void peer_axpy(const uint4& r, float a, float (&o)[16]) {
  f32x2 c;
  c = __builtin_amdgcn_cvt_pk_f32_fp8((int)r.x, false); fmac1(o[0], a, c.x); fmac1(o[1], a, c.y);
  c = __builtin_amdgcn_cvt_pk_f32_fp8((int)r.x, true);  fmac1(o[2], a, c.x); fmac1(o[3], a, c.y);
  c = __builtin_amdgcn_cvt_pk_f32_fp8((int)r.y, false); fmac1(o[4], a, c.x); fmac1(o[5], a, c.y);
  c = __builtin_amdgcn_cvt_pk_f32_fp8((int)r.y, true);  fmac1(o[6], a, c.x); fmac1(o[7], a, c.y);
  c = __builtin_amdgcn_cvt_pk_f32_fp8((int)r.z, false); fmac1(o[8], a, c.x); fmac1(o[9], a, c.y);
  c = __builtin_amdgcn_cvt_pk_f32_fp8((int)r.z, true);  fmac1(o[10], a, c.x); fmac1(o[11], a, c.y);
  c = __builtin_amdgcn_cvt_pk_f32_fp8((int)r.w, false); fmac1(o[12], a, c.x); fmac1(o[13], a, c.y);
  c = __builtin_amdgcn_cvt_pk_f32_fp8((int)r.w, true);  fmac1(o[14], a, c.x); fmac1(o[15], a, c.y);
}
__device__ __forceinline__ float reduce8(float (&p)[8], int lane) {
  float q[4];
#pragma unroll
  for (int j = 0; j < 4; ++j) {
    auto r = __builtin_amdgcn_permlane32_swap(__float_as_uint(p[j]), __float_as_uint(p[j + 4]), false, false);
    q[j] = __uint_as_float(r[0]) + __uint_as_float(r[1]);
  }
  float s2[2];
#pragma unroll
  for (int j = 0; j < 2; ++j) {
    auto r = __builtin_amdgcn_permlane16_swap(__float_as_uint(q[j]), __float_as_uint(q[j + 2]), false, false);
    s2[j] = __uint_as_float(r[0]) + __uint_as_float(r[1]);
  }
  const bool b3 = (lane & 8) != 0;
  float keep = b3 ? s2[1] : s2[0];
  float give = b3 ? s2[0] : s2[1];
  float w = keep + dpp_f<0x128>(give);
  w += dpp_f<0xB1>(w);
  w += dpp_f<0x4E>(w);
  w += dpp_f<0x141>(w);
  return w;
}

__device__ __forceinline__ void phase_peer_u(const int TIDX, const int BIDX, const unsigned char* __restrict__ Eu,
                                             const int* __restrict__ idx, const bf16_t* __restrict__ h16, const float* __restrict__ gffn, float* __restrict__ pd, char* smem) {
  const int lane = TIDX & 63, wid = TIDX >> 6;
  const int x = BIDX & 7;
  int nWs = (VGRID >> 3) * 4;
  asm volatile("" : "+s"(nWs));
  const int wslot = __builtin_amdgcn_readfirstlane((BIDX >> 3) * 4 + wid);
  const int g8 = lane >> 3, c8 = lane & 7;
  const int fr = lane & 15, fq = lane >> 4;
  const unsigned tabo = (unsigned)x * (unsigned)(NEXP * 128) + (unsigned)(c8 * 16);
  const unsigned colq = (unsigned)(x * 128 + fq * 16);
  typedef __attribute__((address_space(3))) char lds_char;
  typedef unsigned u32x4_t __attribute__((ext_vector_type(4)));
  typedef __attribute__((address_space(3))) u32x4_t lds_uint4;
  lds_char* lw = (lds_char*)smem + wid * 9216;
  const int woff = g8 * 144 + c8 * 16;
  const int roff = fr * 144 + fq * 16;
  int t = wslot;
  if (t >= T) return;
  int idn[16];
  u32x4_t r[16];
  float gq8[32];
#pragma unroll
  for (int i = 0; i < 16; ++i) { gq8[i] = gffn[colq + i] * 8.0f; gq8[16 + i] = gffn[colq + 64 + i] * 8.0f; }
  typedef __attribute__((address_space(3))) int lds_i;
  typedef __attribute__((address_space(3))) unsigned lds_u;
  lds_i* li = (lds_i*)((lds_char*)smem + 36864 + wid * 1024);
  lds_u* lh = (lds_u*)((lds_char*)smem + 36864 + wid * 1024 + 512);
  int ri0 = idx[(size_t)t * 128 + lane], ri1 = idx[(size_t)t * 128 + 64 + lane];
  unsigned rh = *(const unsigned*)(h16 + (size_t)t * D + x * 128 + 2 * lane);
  li[lane] = ri0; li[64 + lane] = ri1;
  __builtin_amdgcn_wave_barrier();
#pragma unroll
  for (int j = 0; j < 16; ++j) idn[j] = li[8 * j + g8];
#pragma unroll
  for (int j = 0; j < 16; ++j) r[j] = *(const u32x4_t*)(Eu + (size_t)(tabo + ((unsigned)idn[j] << 7)));
  __builtin_amdgcn_wave_barrier();
  if (t + nWs < T) { ri0 = idx[(size_t)(t + nWs) * 128 + lane]; ri1 = idx[(size_t)(t + nWs) * 128 + 64 + lane]; }
  for (; t < T; t += nWs) {
    const int tn = t + nWs, tnn = t + 2 * nWs;
    const bool hasn = tn < T;
    li[lane] = ri0; li[64 + lane] = ri1;
    lh[lane] = rh;
    __builtin_amdgcn_wave_barrier();
#pragma unroll
    for (int j = 0; j < 16; ++j) idn[j] = li[8 * j + g8];
    u32x4_t nc[4];
    nc[0] = *(const lds_uint4*)(lh + fq * 8); nc[1] = *(const lds_uint4*)(lh + fq * 8 + 4);
    nc[2] = *(const lds_uint4*)(lh + 32 + fq * 8); nc[3] = *(const lds_uint4*)(lh + 32 + fq * 8 + 4);
    __builtin_amdgcn_wave_barrier();
    if (hasn) rh = *(const unsigned*)(h16 + (size_t)tn * D + x * 128 + 2 * lane);
    if (tnn < T) { ri0 = idx[(size_t)tnn * 128 + lane]; ri1 = idx[(size_t)tnn * 128 + 64 + lane]; }
    long b8[4];
#pragma unroll
    for (int hh = 0; hh < 2; ++hh) {
      float fv[16];
      const u32x4_t ua = nc[2 * hh], ub = nc[2 * hh + 1];
      fv[0] = bflo(ua.x); fv[1] = bfhi(ua.x); fv[2] = bflo(ua.y); fv[3] = bfhi(ua.y);
      fv[4] = bflo(ua.z); fv[5] = bfhi(ua.z); fv[6] = bflo(ua.w); fv[7] = bfhi(ua.w);
      fv[8] = bflo(ub.x); fv[9] = bfhi(ub.x); fv[10] = bflo(ub.y); fv[11] = bfhi(ub.y);
      fv[12] = bflo(ub.z); fv[13] = bfhi(ub.z); fv[14] = bflo(ub.w); fv[15] = bfhi(ub.w);
      unsigned w[4];
#pragma unroll
      for (int i = 0; i < 4; ++i) {
        int t8 = __builtin_amdgcn_cvt_pk_fp8_f32(fv[4 * i] * gq8[16 * hh + 4 * i], fv[4 * i + 1] * gq8[16 * hh + 4 * i + 1], 0, false);
        t8 = __builtin_amdgcn_cvt_pk_fp8_f32(fv[4 * i + 2] * gq8[16 * hh + 4 * i + 2], fv[4 * i + 3] * gq8[16 * hh + 4 * i + 3], t8, true);
        w[i] = (unsigned)t8;
      }
      b8[2 * hh] = (long)(((unsigned long)w[1] << 32) | w[0]);
      b8[2 * hh + 1] = (long)(((unsigned long)w[3] << 32) | w[2]);
    }
    f32x4 accs[8];
    __builtin_amdgcn_sched_barrier(0);
#define U_QUARTER(q) { \
      lds_char* lb = lw + ((q) & 1) * 4608; \
      *(lds_uint4*)(lb + woff + 0 * 8 * 144) = r[(q) * 4 + 0]; \
      if (hasn) r[(q) * 4 + 0] = *(const u32x4_t*)(Eu + (size_t)(tabo + ((unsigned)idn[(q) * 4 + 0] << 7))); \
      *(lds_uint4*)(lb + woff + 1 * 8 * 144) = r[(q) * 4 + 1]; \
      if (hasn) r[(q) * 4 + 1] = *(const u32x4_t*)(Eu + (size_t)(tabo + ((unsigned)idn[(q) * 4 + 1] << 7))); \
      *(lds_uint4*)(lb + woff + 2 * 8 * 144) = r[(q) * 4 + 2]; \
      if (hasn) r[(q) * 4 + 2] = *(const u32x4_t*)(Eu + (size_t)(tabo + ((unsigned)idn[(q) * 4 + 2] << 7))); \
      *(lds_uint4*)(lb + woff + 3 * 8 * 144) = r[(q) * 4 + 3]; \
      if (hasn) r[(q) * 4 + 3] = *(const u32x4_t*)(Eu + (size_t)(tabo + ((unsigned)idn[(q) * 4 + 3] << 7))); \
      _Pragma("unroll") for (int eg = 0; eg < 2; ++eg) { \
        const u32x4_t a0 = *(const lds_uint4*)(lb + roff + eg * 16 * 144); \
        const u32x4_t a1 = *(const lds_uint4*)(lb + roff + eg * 16 * 144 + 64); \
        f32x4 acc = f32x4{0.f, 0.f, 0.f, 0.f}; \
        acc = __builtin_amdgcn_mfma_f32_16x16x32_fp8_fp8((long)(((unsigned long)a0.y << 32) | a0.x), b8[0], acc, 0, 0, 0); \
        acc = __builtin_amdgcn_mfma_f32_16x16x32_fp8_fp8((long)(((unsigned long)a0.w << 32) | a0.z), b8[1], acc, 0, 0, 0); \
        acc = __builtin_amdgcn_mfma_f32_16x16x32_fp8_fp8((long)(((unsigned long)a1.y << 32) | a1.x), b8[2], acc, 0, 0, 0); \
        acc = __builtin_amdgcn_mfma_f32_16x16x32_fp8_fp8((long)(((unsigned long)a1.w << 32) | a1.z), b8[3], acc, 0, 0, 0); \
        accs[(q) * 2 + eg] = acc; \
      } \
      __builtin_amdgcn_sched_barrier(0); }
    U_QUARTER(0) U_QUARTER(1) U_QUARTER(2) U_QUARTER(3)
#undef U_QUARTER
    {
      f32x4 sel = accs[0];
#pragma unroll
      for (int k = 1; k < 8; ++k) sel = (fr == k) ? accs[k] : sel;
      if (fr < 8) { uint2 pk; pk.x = pack2(sel[0], sel[1]); pk.y = pack2(sel[2], sel[3]);
        *(uint2*)((bf16_t*)pd + ((size_t)x * T + t) * 128 + fr * 16 + fq * 4) = pk; }
    }
  }
}

__device__ __forceinline__ void phase_peer_act(const int TIDX, const int BIDX, const float* __restrict__ pd, const int* __restrict__ idx,
                                               const float* __restrict__ gate, const float* __restrict__ su, const float* __restrict__ sv,
                                               const float* __restrict__ ssq, float* __restrict__ act) {
  const size_t gtid = (size_t)BIDX * 256 + TIDX, gsz = (size_t)VGRID * 256;
  constexpr size_t N8 = (size_t)T * 16;
  for (size_t u8 = gtid; u8 < N8; u8 += gsz) {
    uint4 p[8];
#pragma unroll
    for (int x = 0; x < 8; ++x) p[x] = ((const uint4*)((const bf16_t*)pd + (size_t)x * T * 128))[u8];
    const int4 e0 = ((const int4*)idx)[2 * u8], e1 = ((const int4*)idx)[2 * u8 + 1];
    const float4 g0 = ((const float4*)gate)[2 * u8], g1 = ((const float4*)gate)[2 * u8 + 1];
    float suv[8], svv[8];
    suv[0] = su[e0.x]; suv[1] = su[e0.y]; suv[2] = su[e0.z]; suv[3] = su[e0.w];
    suv[4] = su[e1.x]; suv[5] = su[e1.y]; suv[6] = su[e1.z]; suv[7] = su[e1.w];
    svv[0] = sv[e0.x]; svv[1] = sv[e0.y]; svv[2] = sv[e0.z]; svv[3] = sv[e0.w];
    svv[4] = sv[e1.x]; svv[5] = sv[e1.y]; svv[6] = sv[e1.z]; svv[7] = sv[e1.w];
    const float rsq = __builtin_amdgcn_rsqf(ssq[u8 >> 4] * (1.0f / D) + EPS) * 0.125f;
    float d[8];
#pragma unroll
    for (int i = 0; i < 8; ++i) d[i] = 0.f;
#pragma unroll
    for (int x = 0; x < 8; ++x) {
      d[0] += bflo(p[x].x); d[1] += bfhi(p[x].x); d[2] += bflo(p[x].y); d[3] += bfhi(p[x].y);
      d[4] += bflo(p[x].z); d[5] += bfhi(p[x].z); d[6] += bflo(p[x].w); d[7] += bfhi(p[x].w);
    }
    const float gv[8] = {g0.x, g0.y, g0.z, g0.w, g1.x, g1.y, g1.z, g1.w};
    float o[8];
#pragma unroll
    for (int i = 0; i < 8; ++i) o[i] = gelu_tanh(d[i] * suv[i] * rsq) * gv[i] * svv[i];
    uint4 ob; ob.x = pack2(o[0], o[1]); ob.y = pack2(o[2], o[3]); ob.z = pack2(o[4], o[5]); ob.w = pack2(o[6], o[7]);
    ((uint4*)act)[u8] = ob;
  }
}

__device__ __forceinline__ void phase_peer_v(const int TIDX, const int BIDX, const unsigned char* __restrict__ Ev,
                                             const int* __restrict__ idx, const float* __restrict__ act, bf16_t* h, bf16_t* a3,
                                             float* __restrict__ ssq, char* smem) {
  const int lane = TIDX & 63, wid = TIDX >> 6;
  const int x = BIDX & 7;
  int nWs = (VGRID >> 3) * 4;
  asm volatile("" : "+s"(nWs));
  const int wslot = __builtin_amdgcn_readfirstlane((BIDX >> 3) * 4 + wid);
  const int g = lane >> 3, c8 = lane & 7;
  const unsigned tabo = (unsigned)x * (unsigned)(NEXP * 128) + (unsigned)(c8 * 16);
  typedef __attribute__((address_space(3))) int lds_i;
  typedef __attribute__((address_space(3))) float lds_f;
  typedef int i32x4_t __attribute__((ext_vector_type(4)));
  typedef float f32x4_t __attribute__((ext_vector_type(4)));
  typedef __attribute__((address_space(3))) i32x4_t lds_i4;
  typedef __attribute__((address_space(3))) f32x4_t lds_f4;
  lds_i* li = (lds_i*)((__attribute__((address_space(3))) char*)smem + wid * 1024);
  typedef __attribute__((address_space(3))) unsigned lds_u;
  typedef unsigned u32x4_a __attribute__((ext_vector_type(4)));
  typedef __attribute__((address_space(3))) u32x4_a lds_u4;
  lds_u* lf = (lds_u*)((__attribute__((address_space(3))) char*)smem + wid * 1024 + 512);
  int t = wslot;
  if (t >= T) return;
  typedef unsigned u32x4_t __attribute__((ext_vector_type(4)));
  u32x4_t r[16];
  i32x4_t idn[4];
  float ac[16];
  int ri0 = idx[(size_t)t * 128 + lane], ri1 = idx[(size_t)t * 128 + 64 + lane];
  unsigned ra = ((const unsigned*)act)[(size_t)t * 64 + lane];
  li[lane] = ri0; li[64 + lane] = ri1;
  __builtin_amdgcn_wave_barrier();
#pragma unroll
  for (int q = 0; q < 4; ++q) idn[q] = *(const lds_i4*)(li + g * 16 + q * 4);
#pragma unroll
  for (int j = 0; j < 16; ++j) {
    const unsigned e = (unsigned)idn[j >> 2][j & 3];
    r[j] = *(const u32x4_t*)(Ev + (size_t)(tabo + (e << 7)));
  }
  __builtin_amdgcn_wave_barrier();
  if (t + nWs < T) { ri0 = idx[(size_t)(t + nWs) * 128 + lane]; ri1 = idx[(size_t)(t + nWs) * 128 + 64 + lane]; }
  for (; t < T; t += nWs) {
    const int tn = t + nWs, tnn = t + 2 * nWs;
    const bool hasn = tn < T;
    const int col = x * 128 + c8 * 16 + 2 * g;
    li[lane] = ri0; li[64 + lane] = ri1;
    lf[lane] = ra;
    __builtin_amdgcn_wave_barrier();
#pragma unroll
    for (int q = 0; q < 4; ++q) {
      idn[q] = *(const lds_i4*)(li + g * 16 + q * 4);
    }
    {
      const u32x4_a a0 = *(const lds_u4*)(lf + g * 8), a1 = *(const lds_u4*)(lf + g * 8 + 4);
      ac[0] = bflo(a0.x); ac[1] = bfhi(a0.x); ac[2] = bflo(a0.y); ac[3] = bfhi(a0.y);
      ac[4] = bflo(a0.z); ac[5] = bfhi(a0.z); ac[6] = bflo(a0.w); ac[7] = bfhi(a0.w);
      ac[8] = bflo(a1.x); ac[9] = bfhi(a1.x); ac[10] = bflo(a1.y); ac[11] = bfhi(a1.y);
      ac[12] = bflo(a1.z); ac[13] = bfhi(a1.z); ac[14] = bflo(a1.w); ac[15] = bfhi(a1.w);
    }
    __builtin_amdgcn_wave_barrier();
    const unsigned hp = *(const unsigned*)(h + (size_t)t * D + col);
    float2 hv = float2{bflo(hp), bfhi(hp)};
    if (hasn) ra = ((const unsigned*)act)[(size_t)tn * 64 + lane];
    if (tnn < T) { ri0 = idx[(size_t)tnn * 128 + lane]; ri1 = idx[(size_t)tnn * 128 + 64 + lane]; }
    __builtin_amdgcn_sched_barrier(0);
    float o[16];
#pragma unroll
    for (int i = 0; i < 16; ++i) o[i] = 0.f;
#pragma unroll
    for (int j = 0; j < 16; ++j) {
      peer_axpy(uint4{r[j].x, r[j].y, r[j].z, r[j].w}, ac[j], o);
      if (hasn) {
        const unsigned e = (unsigned)idn[j >> 2][j & 3];
        r[j] = *(const u32x4_t*)(Ev + (size_t)(tabo + (e << 7)));
      }
      __builtin_amdgcn_sched_barrier(0);
    }
    float q8[8];
#pragma unroll
    for (int i = 0; i < 8; ++i) {
      auto rr = __builtin_amdgcn_permlane32_swap(__float_as_uint(o[i]), __float_as_uint(o[i + 8]), false, false);
      q8[i] = __uint_as_float(rr[0]) + __uint_as_float(rr[1]);
    }
    float s4[4];
#pragma unroll
    for (int i = 0; i < 4; ++i) {
      auto rr = __builtin_amdgcn_permlane16_swap(__float_as_uint(q8[i]), __float_as_uint(q8[i + 4]), false, false);
      s4[i] = __uint_as_float(rr[0]) + __uint_as_float(rr[1]);
    }
    const bool b3 = (lane & 8) != 0;
    float w0 = (b3 ? s4[2] : s4[0]) + dpp_f<0x128>(b3 ? s4[0] : s4[2]);
    float w1 = (b3 ? s4[3] : s4[1]) + dpp_f<0x128>(b3 ? s4[1] : s4[3]);
    hv.x += w0; hv.y += w1;
    float ss = wave_sum(hv.x * hv.x + hv.y * hv.y);
    const unsigned hq = pack2(hv.x, hv.y);
    *(unsigned*)(h + (size_t)t * D + col) = hq;
    *(unsigned*)(a3 + (size_t)t * D + col) = hq;
    if (lane == 0) ssq[(size_t)x * T + t] = ss;
  }
}

#define XB_TMO      128
#define XB_XCNT(j)  (256  + 64 * (j))
#define XB_XSUB(j)  (1280 + 64 * (j))
#define XB_XGEN(j)  (2304 + 64 * (j))
#define XB_TOP      3328
#define XB_TOPGEN   3392
#define XCD_BAR_WORDS 3456
#define XB_SPIN_CAP (1u << 18)
#define LAS __attribute__((address_space(3)))

__device__ __forceinline__ unsigned xb_ld(unsigned* p)              { return __hip_atomic_load(p, __ATOMIC_RELAXED, __HIP_MEMORY_SCOPE_AGENT); }
__device__ __forceinline__ unsigned xb_add(unsigned* p, unsigned v) { return __hip_atomic_fetch_add(p, v, __ATOMIC_RELAXED, __HIP_MEMORY_SCOPE_AGENT); }
__device__ __forceinline__ unsigned xb_xcc_id() { return (unsigned)__builtin_amdgcn_s_getreg((3 << 11) | 20) & 0xFu; }
#define XB_SPIN(cond, bar) do { unsigned _sp = 0; while (cond) { __builtin_amdgcn_s_sleep(1); \
    if ((++_sp & 255u) == 0u) { if (xb_ld(&(bar)[XB_TMO])) break; if (_sp > XB_SPIN_CAP) { atomicAdd(&(bar)[XB_TMO], 1u); break; } } } } while (0)

struct XcdBarrier {
    unsigned* bar; unsigned x;
    volatile LAS unsigned* st;
};

__device__ __forceinline__ XcdBarrier xcd_barrier_post(unsigned* bar, volatile LAS unsigned* st) {
    XcdBarrier b; b.bar = bar; b.x = xb_xcc_id(); b.st = st;
    if (threadIdx.x == 0) (void)xb_add(&bar[XB_XCNT(b.x)], 1u);
    return b;
}
__device__ __forceinline__ void xcd_barrier_complete(unsigned* bar, unsigned x, unsigned& nloc, unsigned& nx) {
    const unsigned G = gridDim.x * gridDim.y * gridDim.z;
    unsigned sum, cnt, mine, sp = 0u;
    for (;;) {
        sum = 0u; cnt = 0u; mine = 0u;
#pragma unroll
        for (unsigned j = 0; j < 16; ++j) { const unsigned c = xb_ld(&bar[XB_XCNT(j)]); sum += c; cnt += (c > 0u) ? 1u : 0u; mine = (j == x) ? c : mine; }
        if (sum == G) break;
        __builtin_amdgcn_s_sleep(1);
        if ((++sp & 255u) == 0u) { if (xb_ld(&bar[XB_TMO])) break; if (sp > XB_SPIN_CAP) { atomicAdd(&bar[XB_TMO], 1u); break; } }
    }
    nloc = mine > 0u ? mine : 1u; nx = cnt > 0u ? cnt : 1u;
}

__device__ __forceinline__ void xcd_barrier(const XcdBarrier& b) {
    asm volatile("s_waitcnt vmcnt(0)" ::: "memory");
    __syncthreads();
    if (threadIdx.x == 0) {
        unsigned* bar = b.bar;
        __builtin_amdgcn_s_waitcnt(0);
        unsigned nloc = b.st[0], nx = b.st[1];
        if (nloc == 0u) { xcd_barrier_complete(bar, b.x, nloc, nx); b.st[0] = nloc; b.st[1] = nx; }
        const unsigned old = xb_add(&bar[XB_XSUB(b.x)], 1u);
        const unsigned gen = old / nloc;
        if (old + 1u == (gen + 1u) * nloc) {
            __builtin_amdgcn_fence(__ATOMIC_RELEASE, "agent");
            asm volatile("s_waitcnt vmcnt(0)" ::: "memory");
            const unsigned og = xb_add(&bar[XB_TOP], 1u);
            const unsigned tg = og / nx;
            if (og + 1u == (tg + 1u) * nx) xb_add(&bar[XB_TOPGEN], 1u);
            else XB_SPIN(xb_ld(&bar[XB_TOPGEN]) == tg, bar);
            __builtin_amdgcn_fence(__ATOMIC_ACQUIRE, "agent");
            xb_add(&bar[XB_XGEN(b.x)], 1u);
            asm volatile("s_waitcnt vmcnt(0)" ::: "memory");
        } else {
            XB_SPIN(xb_ld(&bar[XB_XGEN(b.x)]) == gen, bar);
            __builtin_amdgcn_fence(__ATOMIC_ACQUIRE, "agent");
            asm volatile("s_waitcnt vmcnt(0)" ::: "memory");
        }
    }
    __syncthreads();
}

__device__ __forceinline__ int rebuild_tid(const int wave_id) {
  int lane_id;
  asm volatile("v_mbcnt_lo_u32_b32 %0, -1, 0\n\tv_mbcnt_hi_u32_b32 %0, -1, %0" : "=v"(lane_id));
  return wave_id * 64 + lane_id;
}
__device__ __forceinline__ void run_phase(const int WAVE_ID, const int BL, const Params& P, int ph, char* smem_all) {
  char* ws = P.ws;
  bf16_t* abuf = (bf16_t*)(ws + OFF_ABUF);
  bf16_t* zb = (bf16_t*)(ws + OFF_Z);
  bf16_t* h = (bf16_t*)(ws + OFF_H);
#define VB_PROLOGUE int t2 = rebuild_tid(WAVE_ID); const int TIDX = t2 & 255; const int half_ = __builtin_amdgcn_readfirstlane(t2 >> 8); const int BIDX = BL + half_ * (int)gridDim.x; char* smem = smem_all + half_ * 65536; (void)smem;
  if (ph == 0) { VB_PROLOGUE phase_convert(TIDX, BIDX, P); return; }
  if (ph == NPHASE - 1) { VB_PROLOGUE phase_norm<2, true>(TIDX, BIDX, h, P.in[22], nullptr, P.out); return; }
  const int L = (ph - 1) / 11, s = (ph - 1) % 11;
  const unsigned char* Eu = (const unsigned char*)(ws + OFF_EU) + (size_t)L * NEXP * 1024;
  const unsigned char* Ev = (const unsigned char*)(ws + OFF_EV) + (size_t)L * NEXP * 1024;
  const float* su = (const float*)(ws + OFF_ESC) + L * NEXP;
  const float* sv = (const float*)(ws + OFF_ESC) + (2 + L) * NEXP;
  int* idxb = (int*)(ws + OFF_IDX);
  float* gateb = (float*)(ws + OFF_GATE);
  float* pd = (float*)(ws + OFF_Z);
  float* actb = (float*)(ws + OFF_ACT);
  float* ssq = (float*)(ws + OFF_SSQ);
  float* ssqA = (float*)(ws + OFF_SSQA);
  float* ssqB = (float*)(ws + OFF_SSQB);
  switch (s) {
    case 0: { VB_PROLOGUE phase_norm<0, false>(TIDX, BIDX, P.in[0], nullptr, abuf, nullptr); } break;
    case 1: if (L == 0) run_gemm(rebuild_tid(WAVE_ID), BL, smem_all, abuf, (const bf16_t*)(ws + OFF_WINT), 2304, 1024, pg8::EpiBf16<0>{zb, 2304, nullptr, 0, 0});
            else run_gemm(rebuild_tid(WAVE_ID), BL, smem_all, h, (const bf16_t*)(ws + OFF_WINT) + (size_t)2304 * 1024, 2304, 1024, EpiBf16Rs{zb, 2304, ssqB, WAVE_ID}); break;
    case 2: { VB_PROLOGUE for (int i = BIDX * 256 + TIDX; i < T; i += VGRID * 256) ssqA[i] = 0.f;
      phase_mix(TIDX, BIDX, P, L, zb, abuf, (const bf16_t*)(ws + OFF_WSB) + (size_t)L * 6 * 128 * 128, smem); } break;
    case 3: if (L == 0) run_gemm(rebuild_tid(WAVE_ID), BL, smem_all, abuf, (const bf16_t*)(ws + OFF_WOUTT), 1024, 1024, EpiResid<false>{P.in[0], h, ssqA, WAVE_ID});
            else run_gemm(rebuild_tid(WAVE_ID), BL, smem_all, abuf, (const bf16_t*)(ws + OFF_WOUTT) + (size_t)1024 * 1024, 1024, 1024, EpiResid<true>{h, h, ssqA, WAVE_ID}); break;
    case 4: break;
    case 5: run_gemm(rebuild_tid(WAVE_ID), BL, smem_all, h, (const bf16_t*)(ws + OFF_WQT) + (size_t)L * 2048 * 1024, 2048, 1024, EpiBf16Rs{zb, 2048, ssqA, WAVE_ID}); break;
    case 6: { VB_PROLOGUE
      phase_scores(TIDX, BIDX, zb, (const bf16_t*)(ws + OFF_KEYS) + (size_t)L * 8 * 2 * 128 * 128, idxb, gateb, smem); } break;
    case 7: { VB_PROLOGUE
      phase_peer_u(TIDX, BIDX, Eu, idxb, h, P.in[14] + L * 1024, pd, smem); } break;
    case 8: { VB_PROLOGUE for (int i = BIDX * 256 + TIDX; i < T; i += VGRID * 256) ssqB[i] = 0.f;
      phase_peer_act(TIDX, BIDX, pd, idxb, gateb, su, sv, ssqA, actb); } break;
    case 9: { VB_PROLOGUE phase_peer_v(TIDX, BIDX, Ev, idxb, actb, h, abuf, ssq, smem); } break;
    case 10:
      run_gemm(rebuild_tid(WAVE_ID), BL, smem_all, abuf, (const bf16_t*)(ws + OFF_WPGT) + (size_t)L * 1024 * 1024, 1024, 1024, EpiSig{ssq, zb, WAVE_ID});
      run_gemm(rebuild_tid(WAVE_ID), BL, smem_all, (const bf16_t*)(ws + OFF_PBF) + (size_t)L * T * 256, (const bf16_t*)(ws + OFF_WPET) + (size_t)L * 1024 * 256, 1024, 256, EpiPle{h, zb, ssqB, WAVE_ID});
      break;
  }
}

__global__ void __launch_bounds__(512, 2) peer_trunk_mk(Params P) {
  extern __shared__ __attribute__((aligned(16))) char smem[];
  cg::grid_group grid = cg::this_grid();
  unsigned* bar = (unsigned*)(P.ws + OFF_BAR);
  volatile LAS unsigned* st = (volatile LAS unsigned*)((LAS char*)smem + 131072);
  if (threadIdx.x == 0) { st[0] = 0u; st[1] = 0u; }
  if (blockIdx.x == 0) { for (int i = threadIdx.x; i < XCD_BAR_WORDS; i += 512) bar[i] = 0u; }
  __syncthreads();
  XcdBarrier xb{};
  const int wave_id = __builtin_amdgcn_readfirstlane((int)threadIdx.x >> 6);
  int ph = P.ph_lo;
#ifdef PROBE_DUP
  int dup_left = 1;
#endif
  while (ph < P.ph_hi) {
    int bl = (int)__builtin_amdgcn_workgroup_id_x();
    asm volatile("" : "+s"(bl));
    run_phase(wave_id, bl, P, ph, smem);
    int nph = ph + 1;
    while (nph < NPHASE - 1 && (((nph - 1) % 11) == 4 || nph == 12)) ++nph;
#ifdef PROBE_DUP
    if (ph == 1 + PROBE_DUP && dup_left) { dup_left = 0; nph = ph; }
#endif
    if (nph < P.ph_hi) {
      if (ph == 0) { grid.sync(); xb = xcd_barrier_post(bar, st); }
      else xcd_barrier(xb);
    }
    ph = nph;
  }
}

extern "C" void kernel_launch(void* const* d_in, const int* in_sizes, int n_in, void* d_out, int out_size,
                              void* d_ws, size_t ws_size, hipStream_t stream) {
  static int grid_blocks = 0;
  if (grid_blocks == 0) {
    if (n_in != 23 || ws_size < WS_END) { fprintf(stderr, "kernel_launch: unexpected n_in %d or ws_size %zu (< %zu)\n", n_in, ws_size, (size_t)WS_END); grid_blocks = -1; return; }
    int dev = 0, cus = 0, per_cu = 0;
    hipGetDevice(&dev);
    hipDeviceGetAttribute(&cus, hipDeviceAttributeMultiprocessorCount, dev);
    hipFuncSetAttribute((const void*)peer_trunk_mk, hipFuncAttributeMaxDynamicSharedMemorySize, SMEM_BYTES);
    hipOccupancyMaxActiveBlocksPerMultiprocessor(&per_cu, (const void*)peer_trunk_mk, 512, SMEM_BYTES);
    if (per_cu < 1) per_cu = 1;
    if (per_cu > 1) per_cu = 1;
    grid_blocks = cus * per_cu;
    fprintf(stderr, "kernel_launch: cus %d per_cu %d grid %d\n", cus, per_cu, grid_blocks);
  }
  if (grid_blocks < 0) return;
  Params P{};
  for (int i = 0; i < 23; ++i) P.in[i] = (const float*)d_in[i];
  P.out = (float*)d_out;
  P.ws = (char*)d_ws;
#if ONE_LAUNCH
  P.ph_lo = 0; P.ph_hi = NPHASE;
  void* args[] = {&P};
  hipError_t e = hipLaunchCooperativeKernel((void*)peer_trunk_mk, dim3(grid_blocks), dim3(512), args, SMEM_BYTES, stream);
  if (e != hipSuccess) fprintf(stderr, "cooperative launch failed: %s (grid %d)\n", hipGetErrorString(e), grid_blocks);
#else
  for (int ph = 0; ph < NPHASE; ++ph) {
    P.ph_lo = ph; P.ph_hi = ph + 1;
    hipLaunchKernelGGL(peer_trunk_mk, dim3(grid_blocks), dim3(512), SMEM_BYTES, stream, P);
  }
#endif
}
```

```cpp
#include <hip/hip_runtime.h>
#include <hip/hip_bf16.h>
#include <hip/hip_cooperative_groups.h>
#include <cstdio>
namespace cg = cooperative_groups;

#ifndef ONE_LAUNCH
#define ONE_LAUNCH 1
#endif

typedef unsigned short bf16_t;
using bf16x8 = __attribute__((ext_vector_type(8))) short;
using f32x4 = __attribute__((ext_vector_type(4))) float;

constexpr int T = 65536;
constexpr int D = 1024;
constexpr int SEQ = 8192;
constexpr int INC = 2304;
constexpr int NEXP = 16384;
constexpr float EPS = 1e-6f;
constexpr int SMEM_BYTES = 131072 + 16;
__device__ __forceinline__ int launder_s(int x) { asm volatile("" : "+s"(x)); return x; }
#define VGRID (launder_s((int)gridDim.x * 2))
constexpr int NPHASE = 24;

constexpr size_t OFF_WINT = 0;
constexpr size_t OFF_WOUTT = OFF_WINT + (size_t)2 * 2304 * 1024 * 2;
constexpr size_t OFF_WQT = OFF_WOUTT + (size_t)2 * 1024 * 1024 * 2;
constexpr size_t OFF_WPGT = OFF_WQT + (size_t)2 * 2048 * 1024 * 2;
constexpr size_t OFF_WPET = OFF_WPGT + (size_t)2 * 1024 * 1024 * 2;
constexpr size_t OFF_KEYS = OFF_WPET + (size_t)2 * 1024 * 256 * 2;
constexpr size_t OFF_EU = OFF_KEYS + (size_t)2 * 8 * 2 * 128 * 128 * 2;
constexpr size_t OFF_EV = OFF_EU + (size_t)2 * NEXP * 1024;
constexpr size_t OFF_ESC = OFF_EV + (size_t)2 * NEXP * 1024;
constexpr size_t OFF_PBF = OFF_ESC + (size_t)4 * NEXP * 4;
constexpr size_t OFF_ABUF = OFF_PBF + (size_t)2 * T * 256 * 2;
constexpr size_t OFF_Z = OFF_ABUF + (size_t)T * 1024 * 2;
constexpr size_t OFF_IDX = OFF_Z + (size_t)T * 2304 * 2;
constexpr size_t OFF_GATE = OFF_IDX + (size_t)T * 128 * 4;
constexpr size_t OFF_WSB = OFF_GATE + (size_t)T * 128 * 4;
constexpr size_t OFF_ACT = OFF_WSB + (size_t)2 * 6 * 128 * 128 * 2;
constexpr size_t OFF_SSQ = OFF_ACT + (size_t)T * 128 * 4;
constexpr size_t OFF_N8 = OFF_SSQ + (size_t)8 * T * 4;
constexpr size_t OFF_BAR = OFF_N8 + (size_t)T * 1024;
constexpr size_t OFF_H = OFF_BAR + 16384;
constexpr size_t OFF_SSQA = OFF_H + (size_t)T * 1024 * 2;
constexpr size_t OFF_SSQB = OFF_SSQA + (size_t)T * 4;
constexpr size_t WS_END = OFF_SSQB + (size_t)T * 4;

struct Params {
  const float* in[23];
  float* out;
  char* ws;
  int ph_lo, ph_hi;
};

typedef float cvt_f2 __attribute__((ext_vector_type(2)));
typedef __bf16 cvt_b2 __attribute__((ext_vector_type(2)));
__device__ __forceinline__ unsigned pack2(float a, float b) {
  const cvt_f2 v = {a, b};
  return __builtin_bit_cast(unsigned, __builtin_convertvector(v, cvt_b2));
}
__device__ __forceinline__ unsigned short f2bf(float f) { return (unsigned short)(pack2(f, f) & 0xffffu); }
__device__ __forceinline__ float bf2f(unsigned short b) { return __uint_as_float(((unsigned)b) << 16); }
__device__ __forceinline__ float bflo(unsigned u) { return __uint_as_float(u << 16); }
__device__ __forceinline__ float bfhi(unsigned u) { return __uint_as_float(u & 0xffff0000u); }
__device__ __forceinline__ float sigmoidf_(float x) { return __builtin_amdgcn_rcpf(1.0f + __builtin_amdgcn_exp2f(x * -1.4426950408889634f)); }
__device__ __forceinline__ float gelu_tanh(float x) {
  float u = 0.7978845608028654f * (x + 0.044715f * x * x * x);
  float e = __builtin_amdgcn_exp2f(u * 2.8853900817779268f);
  float th = 1.0f - 2.0f * __builtin_amdgcn_rcpf(e + 1.0f);
  return 0.5f * x * (1.0f + th);
}
template <int CTRL>
__device__ __forceinline__ float dpp_f(float v) {
  return __int_as_float(__builtin_amdgcn_update_dpp(0, __float_as_int(v), CTRL, 0xF, 0xF, true));
}
__device__ __forceinline__ float wave_sum(float v) {
  v += dpp_f<0xB1>(v);
  v += dpp_f<0x4E>(v);
  v += dpp_f<0x141>(v);
  v += dpp_f<0x140>(v);
  float s = __int_as_float(__builtin_amdgcn_readlane(__float_as_int(v), 0)) +
            __int_as_float(__builtin_amdgcn_readlane(__float_as_int(v), 16)) +
            __int_as_float(__builtin_amdgcn_readlane(__float_as_int(v), 32)) +
            __int_as_float(__builtin_amdgcn_readlane(__float_as_int(v), 48));
  return s;
}

__device__ __forceinline__ float wave_max(float v) {
  v = fmaxf(v, dpp_f<0xB1>(v));
  v = fmaxf(v, dpp_f<0x4E>(v));
  v = fmaxf(v, dpp_f<0x141>(v));
  v = fmaxf(v, dpp_f<0x140>(v));
  float s = fmaxf(fmaxf(__int_as_float(__builtin_amdgcn_readlane(__float_as_int(v), 0)),
                        __int_as_float(__builtin_amdgcn_readlane(__float_as_int(v), 16))),
                  fmaxf(__int_as_float(__builtin_amdgcn_readlane(__float_as_int(v), 32)),
                        __int_as_float(__builtin_amdgcn_readlane(__float_as_int(v), 48))));
  return s;
}
typedef float f32x2 __attribute__((ext_vector_type(2)));
__device__ __forceinline__ float group8_sum(float v) {
  v += dpp_f<0xB1>(v);
  v += dpp_f<0x4E>(v);
  v += dpp_f<0x141>(v);
  return v;
}

__device__ __forceinline__ int lds_off(int r, int c) { return r * 128 + ((c ^ ((r >> 1) & 7)) << 4); }

typedef unsigned u32x4_k __attribute__((ext_vector_type(4)));
__device__ __forceinline__ void gemm_kloop_issue(const int TIDX, const bf16_t* __restrict__ A, int lda, const bf16_t* __restrict__ Bt, int ldb,
                                                 u32x4_k (&ra)[4], u32x4_k (&rb)[4]) {
  const int sr = TIDX >> 3, sc = TIDX & 7;
  const bf16_t* ga = A + (size_t)sr * lda + sc * 8;
  const bf16_t* gb = Bt + (size_t)sr * ldb + sc * 8;
#pragma unroll
  for (int i = 0; i < 4; ++i) {
    ra[i] = *(const u32x4_k*)(ga + (size_t)(32 * i) * lda);
    rb[i] = *(const u32x4_k*)(gb + (size_t)(32 * i) * ldb);
  }
}
__device__ __forceinline__ void gemm_kloop(const int TIDX, const int BIDX, const bf16_t* __restrict__ A, int lda,
                                           const bf16_t* __restrict__ Bt, int ldb, int K,
                                           char* smem, f32x4 (&acc)[4][4], u32x4_k (&ra)[4], u32x4_k (&rb)[4]) {
  const int tid = TIDX, lane = tid & 63, wid = tid >> 6;
  const int wr = wid >> 1, wc = wid & 1;
  const int fr = lane & 15, fq = lane >> 4;
  const int sr = tid >> 3, sc = tid & 7;
  const bf16_t* ga = A + (size_t)sr * lda + sc * 8;
  const bf16_t* gb = Bt + (size_t)sr * ldb + sc * 8;
#pragma unroll
  for (int mi = 0; mi < 4; ++mi)
#pragma unroll
    for (int ni = 0; ni < 4; ++ni) acc[mi][ni] = f32x4{0.f, 0.f, 0.f, 0.f};
#pragma unroll
  for (int i = 0; i < 4; ++i) {
    *(u32x4_k*)(smem + lds_off(sr + 32 * i, sc)) = ra[i];
    *(u32x4_k*)(smem + 16384 + lds_off(sr + 32 * i, sc)) = rb[i];
  }
  __syncthreads();
  const int nt = K >> 6;
  for (int kt = 0; kt < nt; ++kt) {
    char* bufp = smem + (kt & 1) * 32768;
    const bool more = (kt + 1 < nt);
    if (more) {
#pragma unroll
      for (int i = 0; i < 4; ++i) {
        ra[i] = *(const u32x4_k*)(ga + (size_t)(32 * i) * lda + (kt + 1) * 64);
        rb[i] = *(const u32x4_k*)(gb + (size_t)(32 * i) * ldb + (kt + 1) * 64);
      }
    }
#pragma unroll
    for (int kk = 0; kk < 2; ++kk) {
      bf16x8 af[4], bfr[4];
#pragma unroll
      for (int mi = 0; mi < 4; ++mi) af[mi] = *(const bf16x8*)(bufp + lds_off(wr * 64 + mi * 16 + fr, kk * 4 + fq));
#pragma unroll
      for (int ni = 0; ni < 4; ++ni) bfr[ni] = *(const bf16x8*)(bufp + 16384 + lds_off(wc * 64 + ni * 16 + fr, kk * 4 + fq));
#pragma unroll
      for (int mi = 0; mi < 4; ++mi)
#pragma unroll
        for (int ni = 0; ni < 4; ++ni)
          acc[mi][ni] = __builtin_amdgcn_mfma_f32_16x16x32_bf16(bfr[ni], af[mi], acc[mi][ni], 0, 0, 0);
    }
    if (more) {
      char* nb = smem + ((kt + 1) & 1) * 32768;
#pragma unroll
      for (int i = 0; i < 4; ++i) {
        *(u32x4_k*)(nb + lds_off(sr + 32 * i, sc)) = ra[i];
        *(u32x4_k*)(nb + 16384 + lds_off(sr + 32 * i, sc)) = rb[i];
      }
    }
    __syncthreads();
  }
}

__device__ __forceinline__ void transpose_convert(const float* __restrict__ src, const float* __restrict__ g, bf16_t* __restrict__ dst,
                                  int Lc, int K, int N, size_t gtid, size_t gsz) {
  const int K8 = K >> 3;
  const size_t total = (size_t)Lc * K8 * N;
  for (size_t u = gtid; u < total; u += gsz) {
    int n = (int)(u % N);
    size_t r = u / N;
    int kc = (int)(r % K8);
    int l = (int)(r / K8);
    float v[8];
#pragma unroll
    for (int i = 0; i < 8; ++i) {
      int k = kc * 8 + i;
      float w = src[((size_t)l * K + k) * N + n];
      if (g) w *= g[l * K + k];
      v[i] = w;
    }
    uint4 o;
    o.x = pack2(v[0], v[1]); o.y = pack2(v[2], v[3]); o.z = pack2(v[4], v[5]); o.w = pack2(v[6], v[7]);
    *(uint4*)(dst + ((size_t)l * N + n) * K + kc * 8) = o;
  }
}
__device__ __forceinline__ void convert_flat(const float* __restrict__ src, bf16_t* __restrict__ dst, size_t n8, size_t gtid, size_t gsz) {
  for (size_t u = gtid; u < n8; u += gsz) {
    float4 a = ((const float4*)src)[2 * u], b = ((const float4*)src)[2 * u + 1];
    uint4 o;
    o.x = pack2(a.x, a.y); o.y = pack2(a.z, a.w); o.z = pack2(b.x, b.y); o.w = pack2(b.z, b.w);
    ((uint4*)dst)[u] = o;
  }
}
__device__ __forceinline__ void phase_convert(const int TIDX, const int BIDX, const Params& P) {
  const size_t gtid = (size_t)BIDX * 256 + TIDX;
  const size_t gsz = (size_t)VGRID * 256;
  char* ws = P.ws;
  transpose_convert(P.in[3], P.in[2], (bf16_t*)(ws + OFF_WINT), 2, 1024, 2304, gtid, gsz);
  transpose_convert(P.in[13], nullptr, (bf16_t*)(ws + OFF_WOUTT), 2, 1024, 1024, gtid, gsz);
  transpose_convert(P.in[15], P.in[14], (bf16_t*)(ws + OFF_WQT), 2, 1024, 2048, gtid, gsz);
  transpose_convert(P.in[21], P.in[19], (bf16_t*)(ws + OFF_WPGT), 2, 1024, 1024, gtid, gsz);
  transpose_convert(P.in[20], nullptr, (bf16_t*)(ws + OFF_WPET), 2, 256, 1024, gtid, gsz);
  convert_flat(P.in[16], (bf16_t*)(ws + OFF_KEYS), (size_t)2 * 8 * 2 * 128 * 128 / 8, gtid, gsz);
  {
    const int lane = TIDX & 63;
    const int gw = BIDX * 4 + (TIDX >> 6), nW = VGRID * 4;
    float* esc = (float*)(ws + OFF_ESC);
    for (int row0 = gw * 2; row0 < 4 * NEXP; row0 += nW * 2) {
      float4 v[2][4];
#pragma unroll
      for (int rr = 0; rr < 2; ++rr) {
        const int row = row0 + rr;
        const float* src = (row < 2 * NEXP) ? (P.in[17] + (size_t)row * 1024) : (P.in[18] + (size_t)(row - 2 * NEXP) * 1024);
#pragma unroll
        for (int i = 0; i < 4; ++i) v[rr][i] = ((const float4*)src)[lane * 4 + i];
      }
#pragma unroll
      for (int rr = 0; rr < 2; ++rr) {
        const int row = row0 + rr;
        float m = 0.f;
#pragma unroll
        for (int i = 0; i < 4; ++i) m = fmaxf(m, fmaxf(fmaxf(fabsf(v[rr][i].x), fabsf(v[rr][i].y)), fmaxf(fabsf(v[rr][i].z), fabsf(v[rr][i].w))));
        m = wave_max(m);
        const float sc = (m > 0.f) ? 224.0f * __builtin_amdgcn_rcpf(m) : 0.f;
        uint4 o;
        unsigned w[4];
#pragma unroll
        for (int i = 0; i < 4; ++i) {
          int t = __builtin_amdgcn_cvt_pk_fp8_f32(v[rr][i].x * sc, v[rr][i].y * sc, 0, false);
          t = __builtin_amdgcn_cvt_pk_fp8_f32(v[rr][i].z * sc, v[rr][i].w * sc, t, true);
          w[i] = (unsigned)t;
        }
        o.x = w[0]; o.y = w[1]; o.z = w[2]; o.w = w[3];
        *(uint4*)(ws + OFF_EU + (size_t)(row / NEXP) * ((size_t)NEXP * 1024) + (size_t)(lane >> 3) * ((size_t)NEXP * 128) + (size_t)(row % NEXP) * 128 + (lane & 7) * 16) = o;
        if (lane == 0) esc[row] = m * (1.0f / 224.0f);
      }
    }
  }
  {
    bf16_t* wsb = (bf16_t*)(ws + OFF_WSB);
    for (size_t u = gtid; u < (size_t)2 * 6 * 128 * 128; u += gsz) {
      int j = (int)(u & 127), i = (int)((u >> 7) & 127);
      float w = P.in[11][u];
      wsb[u] = ((j >> 6) <= (i >> 6)) ? f2bf(w) : (bf16_t)0;
    }
  }
  convert_flat(P.in[1], (bf16_t*)(ws + OFF_PBF), (size_t)2 * T * 256 / 8, gtid, gsz);
}

template <int MODE, bool INB>
__device__ __forceinline__ void phase_norm(const int TIDX, const int BIDX, const void* __restrict__ hraw, const float* __restrict__ g, bf16_t* __restrict__ abuf, float* __restrict__ outp, unsigned char* __restrict__ n8 = nullptr) {
  const int lane = TIDX & 63, wid = TIDX >> 6;
  const int gw = BIDX * 4 + wid, nW = VGRID * 4;
  float4 gv[4];
  if (MODE != 0) {
#pragma unroll
    for (int i = 0; i < 4; ++i) gv[i] = ((const float4*)g)[lane + 64 * i];
  }
  for (int t0 = gw * 4; t0 < T; t0 += nW * 4) {
    float4 v[4][4];
#pragma unroll
    for (int rr = 0; rr < 4; ++rr)
#pragma unroll
      for (int i = 0; i < 4; ++i) {
        if (INB) {
          const uint2 pk = ((const uint2*)((const bf16_t*)hraw + (size_t)(t0 + rr) * D))[lane + 64 * i];
          v[rr][i] = float4{bflo(pk.x), bfhi(pk.x), bflo(pk.y), bfhi(pk.y)};
        } else {
          v[rr][i] = ((const float4*)((const float*)hraw + (size_t)(t0 + rr) * D))[lane + 64 * i];
        }
      }
#pragma unroll
    for (int rr = 0; rr < 4; ++rr) {
      const int t = t0 + rr;
      float ss = 0.f;
#pragma unroll
      for (int i = 0; i < 4; ++i) ss += v[rr][i].x * v[rr][i].x + v[rr][i].y * v[rr][i].y + v[rr][i].z * v[rr][i].z + v[rr][i].w * v[rr][i].w;
      ss = wave_sum(ss);
      float rs = __builtin_amdgcn_rsqf(ss * (1.0f / D) + EPS);
#pragma unroll
      for (int i = 0; i < 4; ++i) {
        float4 o = v[rr][i];
        o.x *= rs; o.y *= rs; o.z *= rs; o.w *= rs;
        if (MODE != 0) { o.x *= gv[i].x; o.y *= gv[i].y; o.z *= gv[i].z; o.w *= gv[i].w; }
        if (MODE == 2) {
          ((float4*)(outp + (size_t)t * D))[lane + 64 * i] = o;
        } else {
          uint2 pk; pk.x = pack2(o.x, o.y); pk.y = pack2(o.z, o.w);
          ((uint2*)(abuf + (size_t)t * D))[lane + 64 * i] = pk;
          if (MODE == 1) {
            const float c0 = fminf(fmaxf(o.x * 16.0f, -440.f), 440.f), c1 = fminf(fmaxf(o.y * 16.0f, -440.f), 440.f);
            const float c2 = fminf(fmaxf(o.z * 16.0f, -440.f), 440.f), c3 = fminf(fmaxf(o.w * 16.0f, -440.f), 440.f);
            int w8 = __builtin_amdgcn_cvt_pk_fp8_f32(c0, c1, 0, false);
            w8 = __builtin_amdgcn_cvt_pk_fp8_f32(c2, c3, w8, true);
            ((int*)(n8 + (size_t)t * D))[lane + 64 * i] = w8;
          }
        }
      }
    }
  }
}

namespace pg8 {
#define PG8_LAS __attribute__((address_space(3)))
typedef unsigned short bf16_t;
typedef short bf16x8 __attribute__((ext_vector_type(8)));
typedef float f32x4 __attribute__((ext_vector_type(4)));
typedef unsigned u32x4 __attribute__((ext_vector_type(4)));
constexpr int BM = 256, BK = 64, HALF = 128, HTB = HALF * BK * 2  , STAGE_BYTES = 8 * HTB, NXCD = 8, WGM = 8;

__host__ __device__ __forceinline__ int lds_byte(int r, int c) { const int st = (r >> 4) * 2 + (c >> 5), rr = r & 15, cc = c & 31, ob = rr * 64 + cc * 2; return st * 1024 + (ob ^ (((ob >> 9) & 1) << 5)); }
__host__ __device__ __forceinline__ void stage_rc(int b, int& R, int& C) { const int st = b / 1024, sb = b % 1024, swz = sb ^ (((sb >> 9) & 1) << 5); R = (st >> 1) * 16 + swz / 64; C = (st & 1) * 32 + (swz % 64) / 2; }
__host__ __device__ __forceinline__ int perm32(int rho) { const int n = rho >> 4, i = rho & 15; return 8 * (i >> 2) + 4 * n + (i & 3); }

struct Unit { int pm, pn; };
struct Gemm { const bf16_t* A; const bf16_t* Bt; int M, N, K; };

struct StaticOrder {
    int nM, nN, nwg, G, c;
    __host__ __device__ void init(int M, int N, int G_, int c_) { nM = M / BM; nN = N / BM; nwg = nM * nN; G = G_; c = c_; }
    __host__ __device__ bool next(int i, Unit& u) const {
        const long L = (long)i * G + c; if (L >= nwg) return false;
        int wgid = (int)L; { const int q = nwg / NXCD, r = nwg % NXCD, xcd = wgid % NXCD, off = wgid / NXCD; wgid = (xcd < r ? xcd * (q + 1) : r * (q + 1) + (xcd - r) * q) + off; }
        const int nig = WGM * nN, gid = wgid / nig, fm = gid * WGM, gsz = (nM - fm) < WGM ? (nM - fm) : WGM;
        u.pm = fm + ((wgid % nig) % gsz); u.pn = (wgid % nig) / gsz; return true;
    }
    __device__ __forceinline__ void a_ready(const Unit&) const {}
    __device__ __forceinline__ void done(const Unit&) const {}
};
__device__ __forceinline__ unsigned cvt_pk_bf16(float lo, float hi) { unsigned r; asm volatile("v_cvt_pk_bf16_f32 %0, %1, %2" : "=v"(r) : "v"(lo), "v"(hi)); return r; }
typedef float f32x2 __attribute__((ext_vector_type(2)));
__device__ __forceinline__ f32x2 gelu_pk(f32x2 v) {
    const f32x2 av = __builtin_elementwise_abs(v), d = av * 0.2316418882f + 1.0f;
    f32x2 t; t.x = __builtin_amdgcn_rcpf(d.x); t.y = __builtin_amdgcn_rcpf(d.y);
    f32x2 q = t * 0.5307027145f + (-0.7265760135f); q = q * t + 0.7107068705f; q = q * t + (-0.142248368f); q = q * t + 0.127414796f; q = q * t;
    const f32x2 s = (v * v) * (-0.72134752044f);
    f32x2 e; e.x = __builtin_amdgcn_exp2f(s.x); e.y = __builtin_amdgcn_exp2f(s.y);
    const f32x2 m = v * (q * e), r = v - m;
    f32x2 o; o.x = v.x < 0.f ? m.x : r.x; o.y = v.y < 0.f ? m.y : r.y; return o;
}
template <int ACT  > struct EpiBf16 {
    static constexpr bool PERM = true, AFTER_DRAIN = false;
    bf16_t* O; int ldc; const float* bias; int split_cols; size_t split_stride;
    __device__ __forceinline__ void operator()(const f32x4 (&acc)[2][2][4][2], const Unit& u, int wr, int wc, int fr, int fq) const {
        const int row0 = u.pm * BM + wr * 64 + fr; int colt = u.pn * BM; bf16_t* base = O;
        if (split_cols) { const int t = colt / split_cols; base += (size_t)t * split_stride; colt -= t * split_cols; }
        const int col0 = colt + wc * 32 + 8 * fq, bcol0 = u.pn * BM + wc * 32 + 8 * fq;
        f32x4 bv[2][2];
#pragma unroll
        for (int bj = 0; bj < 2; ++bj)
#pragma unroll
            for (int n = 0; n < 2; ++n) bv[bj][n] = bias ? *(const f32x4*)(bias + bcol0 + bj * HALF + 4 * n) : (f32x4){0.f, 0.f, 0.f, 0.f};
#pragma unroll
        for (int ai = 0; ai < 2; ++ai)
#pragma unroll
            for (int m = 0; m < 4; ++m) { bf16_t* rowp = base + (size_t)(row0 + ai * HALF + m * 16) * ldc + col0;
#pragma unroll
                for (int bj = 0; bj < 2; ++bj) { f32x4 v0 = acc[ai][bj][m][0] + bv[bj][0], v1 = acc[ai][bj][m][1] + bv[bj][1];
                    if (ACT == 1) { f32x2 a = gelu_pk((f32x2){v0[0], v0[1]}), b = gelu_pk((f32x2){v0[2], v0[3]}), c = gelu_pk((f32x2){v1[0], v1[1]}), d = gelu_pk((f32x2){v1[2], v1[3]});
                        v0 = (f32x4){a.x, a.y, b.x, b.y}; v1 = (f32x4){c.x, c.y, d.x, d.y}; }
                    if (ACT == 2) {
#pragma unroll
                        for (int j = 0; j < 4; ++j) { v0[j] = 0.5f * v0[j] * (1.0f + erff(v0[j] * 0.70710678f)); v1[j] = 0.5f * v1[j] * (1.0f + erff(v1[j] * 0.70710678f)); } }
                    u32x4 w; w.x = cvt_pk_bf16(v0[0], v0[1]); w.y = cvt_pk_bf16(v0[2], v0[3]); w.z = cvt_pk_bf16(v1[0], v1[1]); w.w = cvt_pk_bf16(v1[2], v1[3]);
                    *(u32x4*)(rowp + bj * HALF) = w; } }
    }
};
template <class Epi, class Sched, bool STAMP = false>
__device__ __forceinline__ void gemm_phase(const int TL, PG8_LAS unsigned char* lds, const Gemm g, const Sched& S, const Epi& E, unsigned long long* stamps) {
    const int tid = TL, wid = __builtin_amdgcn_readfirstlane(tid >> 6), lane = tid & 63, wr = wid >> 2, wc = wid & 3, fr = lane & 15, fq = lane >> 4;
    const int K = g.K, nt = K / BK;
    int ts_lo = 0, ts_hi = 0, nts = 0; const unsigned long long rt_entry = STAMP ? (unsigned long long)wall_clock64() : 0ull;
#define PG8_STAMP() do { if (STAMP && wid == 0 && nts < 64) { const unsigned long long _c = (unsigned long long)clock64(); \
        ts_lo = (lane == nts) ? (int)(unsigned)_c : ts_lo; ts_hi = (lane == nts) ? (int)(unsigned)(_c >> 32) : ts_hi; ++nts; } } while (0)
    PG8_STAMP();
    unsigned voffA[2], voffB[2];
#pragma unroll
    for (int i = 0; i < 2; ++i) { int R, C; stage_rc(tid * 16 + i * 8192, R, C); const int Rb = Epi::PERM ? ((R & ~31) + perm32(R & 31)) : R;
        voffA[i] = (unsigned)(R * K + C) * 2u; voffB[i] = (unsigned)(Rb * K + C) * 2u; }
    const size_t kstep = (size_t)(BK * 2);
    const size_t hstep = (size_t)HALF * K * 2;
    const size_t tstep = 2 * hstep;
    const unsigned ldsw = (unsigned)wid * 1024u;
    const int aoff = lds_byte(wr * 64 + fr, fq * 8), boff = lds_byte(wc * 32 + fr, fq * 8);
#define PG8_SA(b, h) (((b) * 2 + (h)) * HTB)
#define PG8_SB(b, h) ((4 + (b) * 2 + (h)) * HTB)
#define PG8_STAGE(bufoff, gbase, voff) do { _Pragma("unroll") for (int _i = 0; _i < 2; ++_i) \
        __builtin_amdgcn_global_load_lds((const unsigned*)((const char*)(gbase) + (voff)[_i]), (PG8_LAS unsigned*)(lds + (bufoff) + ldsw + _i * 8192), 16, 0, 0); } while (0)
#define PG8_LDA(dst, b, h) do { _Pragma("unroll") for (int m = 0; m < 4; ++m) _Pragma("unroll") for (int k = 0; k < 2; ++k) dst[m][k] = *(const PG8_LAS bf16x8*)(lds + PG8_SA(b, h) + aoff + m * 2048 + k * 1024); } while (0)
#define PG8_LDB(dst, b, h) do { _Pragma("unroll") for (int n = 0; n < 2; ++n) _Pragma("unroll") for (int k = 0; k < 2; ++k) dst[n][k] = *(const PG8_LAS bf16x8*)(lds + PG8_SB(b, h) + boff + n * 2048 + k * 1024); } while (0)
#define PG8_MMA(ai, bj, At, Bt) do { __builtin_amdgcn_s_setprio(1); _Pragma("unroll") for (int m = 0; m < 4; ++m) _Pragma("unroll") for (int n = 0; n < 2; ++n) _Pragma("unroll") for (int k = 0; k < 2; ++k) \
        acc[ai][bj][m][n] = __builtin_amdgcn_mfma_f32_16x16x32_bf16(Bt[n][k], At[m][k], acc[ai][bj][m][n], 0, 0, 0); __builtin_amdgcn_s_setprio(0); } while (0)
#define PG8_WAIT_V(n) asm volatile("s_waitcnt vmcnt(" #n ")" ::: "memory")
#define PG8_WAIT_L(n) asm volatile("s_waitcnt lgkmcnt(" #n ")" ::: "memory")
#define PG8_BAR __builtin_amdgcn_s_barrier()
#define PG8_SCHED __builtin_amdgcn_sched_barrier(0)
    Unit cur, nxt; int ui = 0;
    if (!S.next(0, cur)) return;
    f32x4 acc[2][2][4][2];
#pragma unroll
    for (int a = 0; a < 2; ++a)
#pragma unroll
        for (int b = 0; b < 2; ++b)
#pragma unroll
            for (int m = 0; m < 4; ++m)
#pragma unroll
                for (int n = 0; n < 2; ++n) acc[a][b][m][n] = (f32x4){0.f, 0.f, 0.f, 0.f};
    bf16x8 At[4][2], B0[2][2], B1[2][2];
    const char* cA = (const char*)g.A + (size_t)cur.pm * tstep; const char* cB = (const char*)g.Bt + (size_t)cur.pn * tstep;
    S.a_ready(cur);
    PG8_STAGE(PG8_SB(0, 0), cB, voffB); PG8_STAGE(PG8_SA(0, 0), cA, voffA); PG8_STAGE(PG8_SB(0, 1), cB + hstep, voffB); PG8_STAGE(PG8_SA(0, 1), cA + hstep, voffA);
    if (wr == 1) PG8_BAR;
    PG8_WAIT_V(4); PG8_BAR;
    PG8_STAGE(PG8_SB(1, 0), cB + kstep, voffB); PG8_STAGE(PG8_SA(1, 0), cA + kstep, voffA); PG8_STAGE(PG8_SB(1, 1), cB + hstep + kstep, voffB);
    PG8_WAIT_V(6); PG8_BAR;
    PG8_STAMP();
    for (;;) {
        const bool has_next = S.next(ui + 1, nxt);
        const char* nA = has_next ? (const char*)g.A + (size_t)nxt.pm * tstep : cA; const char* nB = has_next ? (const char*)g.Bt + (size_t)nxt.pn * tstep : cB;
        for (int t = 0; t < nt; t += 2) {
            const bool last = (t == nt - 2);
            const char* a1 = cA + (size_t)(t + 1) * kstep;
            const char* a2 = last ? nA : cA + (size_t)(t + 2) * kstep; const char* b2 = last ? nB : cB + (size_t)(t + 2) * kstep;
            const char* a3 = a2 + kstep; const char* b3 = b2 + kstep;
            if (last && has_next) S.a_ready(nxt);
            PG8_LDB(B0, 0, 0); PG8_SCHED; PG8_LDA(At, 0, 0); PG8_STAGE(PG8_SA(1, 1), a1 + hstep, voffA);
            PG8_WAIT_L(8); PG8_BAR; PG8_WAIT_L(0); PG8_MMA(0, 0, At, B0); PG8_BAR; PG8_SCHED;
            PG8_LDB(B1, 0, 1); PG8_STAGE(PG8_SB(0, 0), b2, voffB);
            PG8_BAR; PG8_WAIT_L(0); PG8_MMA(0, 1, At, B1); PG8_BAR;
            PG8_LDA(At, 0, 1); PG8_STAGE(PG8_SA(0, 0), a2, voffA);
            PG8_BAR; PG8_WAIT_L(0); PG8_MMA(1, 0, At, B0); PG8_BAR; PG8_SCHED;
            PG8_STAGE(PG8_SB(0, 1), b2 + hstep, voffB);
            PG8_WAIT_V(6); PG8_BAR; PG8_MMA(1, 1, At, B1); PG8_BAR;
            PG8_LDB(B0, 1, 0); PG8_SCHED; PG8_LDA(At, 1, 0); PG8_STAGE(PG8_SA(0, 1), a2 + hstep, voffA);
            PG8_WAIT_L(8); PG8_BAR; PG8_WAIT_L(0); PG8_MMA(0, 0, At, B0); PG8_BAR; PG8_SCHED;
            PG8_LDB(B1, 1, 1); PG8_STAGE(PG8_SB(1, 0), b3, voffB);
            PG8_BAR; PG8_WAIT_L(0); PG8_MMA(0, 1, At, B1); PG8_BAR;
            PG8_LDA(At, 1, 1); PG8_STAGE(PG8_SA(1, 0), a3, voffA);
            PG8_BAR; PG8_WAIT_L(0); PG8_MMA(1, 0, At, B0); PG8_BAR; PG8_SCHED;
            PG8_STAGE(PG8_SB(1, 1), b3 + hstep, voffB);
            PG8_WAIT_V(6); PG8_BAR; PG8_MMA(1, 1, At, B1); PG8_BAR;
        }
        PG8_STAMP();
        if constexpr (!Epi::AFTER_DRAIN) { E(acc, cur, wr, wc, fr, fq); S.done(cur); }
        PG8_STAMP();
        if (!has_next) break;
#pragma unroll
        for (int a = 0; a < 2; ++a)
#pragma unroll
            for (int b = 0; b < 2; ++b)
#pragma unroll
                for (int m = 0; m < 4; ++m)
#pragma unroll
                    for (int n = 0; n < 2; ++n) acc[a][b][m][n] = (f32x4){0.f, 0.f, 0.f, 0.f};
        cur = nxt; cA = nA; cB = nB; ++ui;
    }
    PG8_WAIT_V(0);
    if (wr == 0) PG8_BAR;
    PG8_BAR;
    if constexpr (Epi::AFTER_DRAIN) { E.fused(acc, cur, wr, wc, fr, fq, lds, wid, lane); S.done(cur); }
    PG8_STAMP();
    if (STAMP && wid == 0) { stamps[lane] = lane < nts ? (((unsigned long long)(unsigned)ts_hi << 32) | (unsigned)ts_lo) : 0ull;
        if (lane == 62) stamps[62] = rt_entry; if (lane == 63) stamps[63] = (unsigned long long)wall_clock64(); }
#undef PG8_STAMP
#undef PG8_SA
#undef PG8_SB
#undef PG8_STAGE
#undef PG8_LDA
#undef PG8_LDB
#undef PG8_MMA
#undef PG8_WAIT_V
#undef PG8_WAIT_L
#undef PG8_BAR
#undef PG8_SCHED
}
}

template <bool INB>
struct EpiResid {
  static constexpr bool PERM = true, AFTER_DRAIN = false;
  const void* hin; bf16_t* hout; float* ssq; int wave_id;
  __device__ __forceinline__ void operator()(const pg8::f32x4 (&acc)[2][2][4][2], const pg8::Unit& u, int, int, int, int) const {
    int lane_id;
    asm volatile("v_mbcnt_lo_u32_b32 %0, -1, 0\n\tv_mbcnt_hi_u32_b32 %0, -1, %0" : "=v"(lane_id));
    const int wr = wave_id >> 2, wc = wave_id & 3, fr = lane_id & 15, fq = lane_id >> 4;
    const int row0 = u.pm * 256 + wr * 64 + fr, col0 = u.pn * 256 + wc * 32 + 8 * fq;
#pragma unroll
    for (int ai = 0; ai < 2; ++ai)
#pragma unroll
      for (int m = 0; m < 4; ++m) {
        const int row = row0 + ai * 128 + m * 16;
        const size_t ro = (size_t)row * D + col0;
        float sq = 0.f;
#pragma unroll
        for (int bj = 0; bj < 2; ++bj)
#pragma unroll
          for (int n = 0; n < 2; ++n) {
            const size_t o = ro + bj * 128 + n * 4;
            pg8::f32x4 v;
            if (INB) { const uint2 pk = *(const uint2*)((const bf16_t*)hin + o); v = pg8::f32x4{bflo(pk.x), bfhi(pk.x), bflo(pk.y), bfhi(pk.y)}; }
            else v = *(const pg8::f32x4*)((const float*)hin + o);
            v = v + acc[ai][bj][m][n];
            uint2 w; w.x = pack2(v[0], v[1]); w.y = pack2(v[2], v[3]);
            *(uint2*)(hout + o) = w;
            const float r0 = bflo(w.x), r1 = bfhi(w.x), r2 = bflo(w.y), r3 = bfhi(w.y);
            sq += r0 * r0 + r1 * r1 + r2 * r2 + r3 * r3;
          }
        sq += __shfl_xor(sq, 16);
        sq += __shfl_xor(sq, 32);
        if (fq == 0) atomicAdd(ssq + row, sq);
      }
  }
};
struct EpiBf16Rs {
  static constexpr bool PERM = true, AFTER_DRAIN = false;
  bf16_t* O; int ldc; const float* ssq; int wave_id;
  __device__ __forceinline__ void operator()(const pg8::f32x4 (&acc)[2][2][4][2], const pg8::Unit& u, int, int, int, int) const {
    int lane_id;
    asm volatile("v_mbcnt_lo_u32_b32 %0, -1, 0\n\tv_mbcnt_hi_u32_b32 %0, -1, %0" : "=v"(lane_id));
    const int wr = wave_id >> 2, wc = wave_id & 3, fr = lane_id & 15, fq = lane_id >> 4;
    const int row0 = u.pm * 256 + wr * 64 + fr, col0 = u.pn * 256 + wc * 32 + 8 * fq;
#pragma unroll
    for (int ai = 0; ai < 2; ++ai)
#pragma unroll
      for (int m = 0; m < 4; ++m) {
        const int row = row0 + ai * 128 + m * 16;
        const float rs = __builtin_amdgcn_rsqf(ssq[row] * (1.0f / D) + EPS);
        bf16_t* rowp = O + (size_t)row * ldc + col0;
#pragma unroll
        for (int bj = 0; bj < 2; ++bj) {
          const pg8::f32x4 v0 = acc[ai][bj][m][0], v1 = acc[ai][bj][m][1];
          pg8::u32x4 w;
          w.x = pack2(v0[0] * rs, v0[1] * rs); w.y = pack2(v0[2] * rs, v0[3] * rs);
          w.z = pack2(v1[0] * rs, v1[1] * rs); w.w = pack2(v1[2] * rs, v1[3] * rs);
          *(pg8::u32x4*)(rowp + bj * 128) = w;
        }
      }
  }
};
struct EpiSig {
  static constexpr bool PERM = true, AFTER_DRAIN = false;
  const float* ssq; bf16_t* sg; int wave_id;
  __device__ __forceinline__ void operator()(const pg8::f32x4 (&acc)[2][2][4][2], const pg8::Unit& u, int, int, int, int) const {
    int lane_id;
    asm volatile("v_mbcnt_lo_u32_b32 %0, -1, 0\n\tv_mbcnt_hi_u32_b32 %0, -1, %0" : "=v"(lane_id));
    const int wr = wave_id >> 2, wc = wave_id & 3, fr = lane_id & 15, fq = lane_id >> 4;
    const int row0 = u.pm * 256 + wr * 64 + fr, col0 = u.pn * 256 + wc * 32 + 8 * fq;
#pragma unroll
    for (int ai = 0; ai < 2; ++ai)
#pragma unroll
      for (int m = 0; m < 4; ++m) {
        const int row = row0 + ai * 128 + m * 16;
        float sq = 0.f;
#pragma unroll
        for (int xx = 0; xx < 8; ++xx) sq += ssq[(size_t)xx * T + row];
        const float rs = __builtin_amdgcn_rsqf(sq * (1.0f / D) + EPS);
        const size_t ro = (size_t)row * D + col0;
#pragma unroll
        for (int bj = 0; bj < 2; ++bj)
#pragma unroll
          for (int n = 0; n < 2; ++n) {
            const pg8::f32x4 a = acc[ai][bj][m][n];
            uint2 pk;
            pk.x = pack2(sigmoidf_(rs * a[0]), sigmoidf_(rs * a[1]));
            pk.y = pack2(sigmoidf_(rs * a[2]), sigmoidf_(rs * a[3]));
            *(uint2*)(sg + ro + bj * 128 + n * 4) = pk;
          }
      }
  }
};
struct EpiPle {
  static constexpr bool PERM = true, AFTER_DRAIN = false;
  bf16_t* h; const bf16_t* sg; float* ssq; int wave_id;
  __device__ __forceinline__ void operator()(const pg8::f32x4 (&acc)[2][2][4][2], const pg8::Unit& u, int, int, int, int) const {
    int lane_id;
    asm volatile("v_mbcnt_lo_u32_b32 %0, -1, 0\n\tv_mbcnt_hi_u32_b32 %0, -1, %0" : "=v"(lane_id));
    const int wr = wave_id >> 2, wc = wave_id & 3, fr = lane_id & 15, fq = lane_id >> 4;
    const int row0 = u.pm * 256 + wr * 64 + fr, col0 = u.pn * 256 + wc * 32 + 8 * fq;
#pragma unroll
    for (int ai = 0; ai < 2; ++ai)
#pragma unroll
      for (int m = 0; m < 4; ++m) {
        const int row = row0 + ai * 128 + m * 16;
        const size_t ro = (size_t)row * D + col0;
        float sq = 0.f;
#pragma unroll
        for (int bj = 0; bj < 2; ++bj)
#pragma unroll
          for (int n = 0; n < 2; ++n) {
            const size_t o = ro + bj * 128 + n * 4;
            const uint2 pk = *(const uint2*)(sg + o);
            const uint2 hp = *(const uint2*)(h + o);
            const pg8::f32x4 a = acc[ai][bj][m][n];
            uint2 w;
            w.x = pack2(bflo(hp.x) + a[0] * bflo(pk.x), bfhi(hp.x) + a[1] * bfhi(pk.x));
            w.y = pack2(bflo(hp.y) + a[2] * bflo(pk.y), bfhi(hp.y) + a[3] * bfhi(pk.y));
            *(uint2*)(h + o) = w;
            const float r0 = bflo(w.x), r1 = bfhi(w.x), r2 = bflo(w.y), r3 = bfhi(w.y);
            sq += r0 * r0 + r1 * r1 + r2 * r2 + r3 * r3;
          }
        sq += __shfl_xor(sq, 16);
        sq += __shfl_xor(sq, 32);
        if (fq == 0) atomicAdd(ssq + row, sq);
      }
  }
};
template <class Epi>
__device__ __forceinline__ void run_gemm(const int TL, const int BL, char* smem, const bf16_t* A, const bf16_t* Bt, int N, int K, const Epi& E) {
  pg8::Gemm g{A, Bt, T, N, K};
  pg8::StaticOrder S; S.init(T, N, (int)gridDim.x, BL);
  pg8::gemm_phase<Epi, pg8::StaticOrder, false>(TL, (PG8_LAS unsigned char*)smem, g, S, E, nullptr);
}

__device__ __forceinline__ void unpack8(const uint4& u, float (&f)[8]) {
  f[0] = bflo(u.x); f[1] = bfhi(u.x); f[2] = bflo(u.y); f[3] = bfhi(u.y);
  f[4] = bflo(u.z); f[5] = bfhi(u.z); f[6] = bflo(u.w); f[7] = bfhi(u.w);
}
__device__ __forceinline__ void phase_mix(const int TIDX, const int BIDX, const Params& P, int L, const bf16_t* __restrict__ z, bf16_t* __restrict__ y,
                                          const bf16_t* __restrict__ wsb, char* smem) {
  const int tid = TIDX, lane = tid & 63, wid = tid >> 6;
  const int r8 = tid >> 3, c8 = tid & 7;
  const float* conv_a_w = P.in[4] + (size_t)L * 31 * 384;
  const float* conv_a_b = P.in[5] + L * 384;
  const float* ln_a_g = P.in[6] + L * 384;
  const float* ln_a_b = P.in[7] + L * 384;
  const float* conv_b_w = P.in[8] + L * 3 * 256;
  const float* ln_c_g = P.in[9] + L * 384;
  const float* ln_c_b = P.in[10] + L * 384;
  const float* b_s = P.in[12] + L * 6 * 128;
  float* fs = (float*)smem;
  for (int item = BIDX; item < 512 * 16; item += VGRID) {
    const int tb = item >> 4, part = (item ^ (item >> 9)) & 15;
    const int t0 = tb * 128;
    const int s0 = t0 & (SEQ - 1);
    if (part < 6) {
      {
        const int ch0 = part * 64 + c8 * 8;
        uint4 vv[5], gg[5];
#pragma unroll
        for (int p = 0; p < 5; ++p) {
          const int r = r8 + 32 * p;
          vv[p] = uint4{0, 0, 0, 0}; gg[p] = uint4{0, 0, 0, 0};
          if (r < 158 && (r >= 30 || s0 > 0)) {
            const bf16_t* zr = z + (size_t)(t0 - 30 + r) * INC + ch0;
            vv[p] = *(const uint4*)zr;
            gg[p] = *(const uint4*)(zr + 384);
          }
        }
#pragma unroll
        for (int p = 0; p < 5; ++p) {
          const int r = r8 + 32 * p;
          if (r < 158) {
            float a[8], g[8];
            unpack8(vv[p], a); unpack8(gg[p], g);
            float4 o0, o1;
            o0.x = a[0] * sigmoidf_(g[0]); o0.y = a[1] * sigmoidf_(g[1]); o0.z = a[2] * sigmoidf_(g[2]); o0.w = a[3] * sigmoidf_(g[3]);
            o1.x = a[4] * sigmoidf_(g[4]); o1.y = a[5] * sigmoidf_(g[5]); o1.z = a[6] * sigmoidf_(g[6]); o1.w = a[7] * sigmoidf_(g[7]);
            *(float4*)(fs + r * 64 + c8 * 8) = o0;
            *(float4*)(fs + r * 64 + c8 * 8 + 4) = o1;
          }
        }
      }
      const int ch = part * 64 + lane;
      float wk[31];
#pragma unroll
      for (int k = 0; k < 31; ++k) wk[k] = conv_a_w[k * 384 + ch];
      const float cb = conv_a_b[ch], lg = ln_a_g[ch], lb = ln_a_b[ch];
      __syncthreads();
      for (int g4 = 0; g4 < 8; ++g4) {
        const int tl = wid * 32 + g4 * 4;
        float yv[34];
#pragma unroll
        for (int k = 0; k < 34; ++k) yv[k] = fs[(tl + k) * 64 + lane];
#pragma unroll
        for (int q = 0; q < 4; ++q) {
          float a = cb;
#pragma unroll
          for (int k = 0; k < 31; ++k) a += wk[k] * yv[q + k];
          float mean = wave_sum(a) * (1.0f / 64);
          float d = a - mean;
          float var = wave_sum(d * d) * (1.0f / 64);
          float yn = d * __builtin_amdgcn_rsqf(var + EPS) * lg + lb;
          float o = yn * sigmoidf_(yn);
          y[(size_t)(t0 + tl + q) * D + ch] = f2bf(o);
        }
      }
      __syncthreads();
    } else if (part < 10) {
      const int cbn = (part - 6) * 64 + c8 * 8;
      float w0[8], w1[8], w2[8];
#pragma unroll
      for (int i = 0; i < 8; ++i) { w0[i] = conv_b_w[cbn + i]; w1[i] = conv_b_w[256 + cbn + i]; w2[i] = conv_b_w[512 + cbn + i]; }
      const int tl0 = r8 * 4;
      uint4 cgv[6], xbv[6], bgv[4];
#pragma unroll
      for (int k = 0; k < 6; ++k) {
        cgv[k] = uint4{0, 0, 0, 0}; xbv[k] = uint4{0, 0, 0, 0};
        if (k >= 2 || (s0 + tl0) > 0) {
          const bf16_t* zr = z + (size_t)(t0 + tl0 - 2 + k) * INC + cbn;
          cgv[k] = *(const uint4*)(zr + 1024);
          xbv[k] = *(const uint4*)(zr + 1280);
        }
      }
#pragma unroll
      for (int k = 0; k < 4; ++k) bgv[k] = *(const uint4*)(z + (size_t)(t0 + tl0 + k) * INC + 768 + cbn);
      float pr[6][8];
#pragma unroll
      for (int k = 0; k < 6; ++k) {
        float a[8], b[8];
        unpack8(cgv[k], a); unpack8(xbv[k], b);
#pragma unroll
        for (int i = 0; i < 8; ++i) pr[k][i] = a[i] * b[i];
      }
#pragma unroll
      for (int k = 0; k < 4; ++k) {
        float bg[8], o[8];
        unpack8(bgv[k], bg);
#pragma unroll
        for (int i = 0; i < 8; ++i) o[i] = bg[i] * (w0[i] * pr[k][i] + w1[i] * pr[k + 1][i] + w2[i] * pr[k + 2][i]);
        uint4 pk; pk.x = pack2(o[0], o[1]); pk.y = pack2(o[2], o[3]); pk.z = pack2(o[4], o[5]); pk.w = pack2(o[6], o[7]);
        *(uint4*)(y + (size_t)(t0 + tl0 + k) * D + 384 + cbn) = pk;
      }
    } else {
      const int hc = part - 10;
      const int ch0 = hc * 64 + c8 * 8;
      bf16_t* vnT = (bf16_t*)smem;
      {
        float lg[8], lb[8];
#pragma unroll
        for (int i = 0; i < 8; ++i) { lg[i] = ln_c_g[ch0 + i]; lb[i] = ln_c_b[ch0 + i]; }
        uint4 vv[4];
#pragma unroll
        for (int p = 0; p < 4; ++p) vv[p] = *(const uint4*)(z + (size_t)(t0 + r8 + 32 * p) * INC + 1920 + ch0);
#pragma unroll
        for (int p = 0; p < 4; ++p) {
          float v[8];
          unpack8(vv[p], v);
          float sm = ((v[0] + v[1]) + (v[2] + v[3])) + ((v[4] + v[5]) + (v[6] + v[7]));
          float mean = group8_sum(sm) * (1.0f / 64);
          float sq = 0.f;
#pragma unroll
          for (int i = 0; i < 8; ++i) { v[i] -= mean; sq += v[i] * v[i]; }
          float rstd = __builtin_amdgcn_rsqf(group8_sum(sq) * (1.0f / 64) + EPS);
          const int r = r8 + 32 * p;
#pragma unroll
          for (int i = 0; i < 8; ++i) vnT[(c8 * 8 + i) * 136 + r] = f2bf(v[i] * rstd * lg[i] + lb[i]);
        }
      }
      __syncthreads();
      const int fr = lane & 15, fq = lane >> 4;
      const bf16_t* wsh = wsb + (size_t)hc * 128 * 128;
      f32x4 acc[4][2];
#pragma unroll
      for (int mi = 0; mi < 4; ++mi)
#pragma unroll
        for (int ni = 0; ni < 2; ++ni) acc[mi][ni] = f32x4{0.f, 0.f, 0.f, 0.f};
      const int nkk = (wid < 2) ? 2 : 4;
      for (int kk = 0; kk < nkk; ++kk) {
        bf16x8 af[4], bf_[2];
#pragma unroll
        for (int ni = 0; ni < 2; ++ni) bf_[ni] = *(const bf16x8*)(wsh + (size_t)(wid * 32 + ni * 16 + fr) * 128 + kk * 32 + fq * 8);
#pragma unroll
        for (int mi = 0; mi < 4; ++mi) af[mi] = *(const bf16x8*)(vnT + (mi * 16 + fr) * 136 + kk * 32 + fq * 8);
#pragma unroll
        for (int mi = 0; mi < 4; ++mi)
#pragma unroll
          for (int ni = 0; ni < 2; ++ni)
            acc[mi][ni] = __builtin_amdgcn_mfma_f32_16x16x32_bf16(af[mi], bf_[ni], acc[mi][ni], 0, 0, 0);
      }
#pragma unroll
      for (int ni = 0; ni < 2; ++ni) {
        const int i = wid * 32 + ni * 16 + fr;
        const float bsv = b_s[hc * 128 + i];
#pragma unroll
        for (int mi = 0; mi < 4; ++mi) {
          const int chb = hc * 64 + mi * 16 + fq * 4;
          uint2 uu = *(const uint2*)(z + (size_t)(t0 + i) * INC + 1536 + chb);
          uint2 pk;
          pk.x = pack2(bflo(uu.x) * (acc[mi][ni][0] + bsv), bfhi(uu.x) * (acc[mi][ni][1] + bsv));
          pk.y = pack2(bflo(uu.y) * (acc[mi][ni][2] + bsv), bfhi(uu.y) * (acc[mi][ni][3] + bsv));
          *(uint2*)(y + (size_t)(t0 + i) * D + 640 + chb) = pk;
        }
      }
      __syncthreads();
    }
  }
}

__device__ __forceinline__ void ins16(float (&lv)[16], float v) {
#pragma unroll
  for (int i = 0; i < 16; ++i) {
    float t = fmaxf(lv[i], v);
    v = fminf(lv[i], v);
    lv[i] = t;
  }
}

__device__ __forceinline__ void bitonic_sort16_desc(float (&v)[16]) {
#pragma unroll
  for (int k = 2; k <= 16; k <<= 1) {
#pragma unroll
    for (int j = k >> 1; j > 0; j >>= 1) {
#pragma unroll
      for (int i = 0; i < 16; ++i) {
        const int l = i ^ j;
        if (l > i) {
          const bool desc = ((i & k) == 0);
          const float hi = fmaxf(v[i], v[l]), lo = fminf(v[i], v[l]);
          v[i] = desc ? hi : lo; v[l] = desc ? lo : hi;
        }
      }
    }
  }
}
__device__ __forceinline__ void merge_top16(float (&a)[16], const float (&b)[16]) {
#pragma unroll
  for (int i = 0; i < 16; ++i) a[i] = fmaxf(a[i], b[15 - i]);
#pragma unroll
  for (int j = 8; j > 0; j >>= 1) {
#pragma unroll
    for (int i = 0; i < 16; ++i) {
      const int l = i ^ j;
      if (l > i) {
        const float hi = fmaxf(a[i], a[l]), lo = fminf(a[i], a[l]);
        a[i] = hi; a[l] = lo;
      }
    }
  }
}
__device__ __forceinline__ void phase_scores(const int TIDX, const int BIDX, const bf16_t* __restrict__ q, const bf16_t* __restrict__ keys  ,
                             int* __restrict__ idxo, float* __restrict__ gateo, char* smem) {
  const int tid = TIDX, lane = tid & 63, wid = tid >> 6;
  const int wr = wid >> 1, wc = wid & 1, fr = lane & 15, fq = lane >> 4;
  float* sT = (float*)smem;
  unsigned* slot = (unsigned*)smem;
  const int m = tid & 127, part = (tid >> 7) ^ ((BIDX >= (int)gridDim.x) ? 1 : 0);
  u32x4_k pra[4], prb[4];
  if (BIDX < 512 * 8) gemm_kloop_issue(tid, q + (size_t)(BIDX >> 3) * 128 * 2048 + (BIDX & 7) * 256, 2048, keys + (size_t)((BIDX & 7) * 2) * 128 * 128, 128, pra, prb);
  const int vstep = VGRID;
  for (int item = BIDX; item < 512 * 8; item += vstep) {
    const int tt = item >> 3, hd = item & 7;
    int tid_i = tid;
    asm volatile("" : "+v"(tid_i));
    float v1[16], v2[16];
#pragma unroll
    for (int half = 0; half < 2; ++half) {
      f32x4 acc[4][4];
      gemm_kloop(tid_i, BIDX, q + (size_t)tt * 128 * 2048 + hd * 256 + half * 128, 2048,
                 keys + (size_t)(hd * 2 + half) * 128 * 128, 128, 128, smem, acc, pra, prb);
      if (half == 0) {
        gemm_kloop_issue(tid_i, q + (size_t)tt * 128 * 2048 + hd * 256 + 128, 2048, keys + (size_t)(hd * 2 + 1) * 128 * 128, 128, pra, prb);
      } else if (item + vstep < 512 * 8) {
        const int ni = item + vstep;
        gemm_kloop_issue(tid_i, q + (size_t)(ni >> 3) * 128 * 2048 + (ni & 7) * 256, 2048, keys + (size_t)((ni & 7) * 2) * 128 * 128, 128, pra, prb);
      }
      float* sbase = sT + (wc * 64 + fq * 4) * 128 + wr * 64 + fr;
#pragma unroll
      for (int mi = 0; mi < 4; ++mi)
#pragma unroll
        for (int ni = 0; ni < 4; ++ni)
#pragma unroll
          for (int j = 0; j < 4; ++j)
            sbase[ni * 2048 + j * 128 + mi * 16] = acc[mi][ni][j];
      __syncthreads();
      float lv[16];
#pragma unroll
      for (int c = 0; c < 4; ++c) {
        float ck[16];
        int pb = part * 64;
        asm volatile("" : "+v"(pb));
        const float* srow = sT + pb * 128 + m;
#pragma unroll
        for (int i = 0; i < 16; ++i) {
          const int key = pb + c * 16 + i;
          ck[i] = __uint_as_float((__float_as_uint(srow[(c * 16 + i) * 128]) & 0xffffff80u) | (unsigned)key);
        }
        bitonic_sort16_desc(ck);
        if (c == 0) {
#pragma unroll
          for (int i = 0; i < 16; ++i) lv[i] = ck[i];
        } else {
          merge_top16(lv, ck);
        }
        __builtin_amdgcn_sched_barrier(0);
      }
      __syncthreads();
      if (part == 1) {
#pragma unroll
        for (int i = 0; i < 16; ++i) sT[i * 128 + m] = lv[i];
      }
      __syncthreads();
      if (part == 0) {
        float ob[16];
#pragma unroll
        for (int i = 0; i < 16; ++i) ob[i] = sT[i * 128 + m];
        merge_top16(lv, ob);
      }
      __syncthreads();
      if (half == 0) {
#pragma unroll
        for (int i = 0; i < 16; ++i) v1[i] = lv[i];
      } else {
#pragma unroll
        for (int i = 0; i < 16; ++i) v2[i] = lv[i];
      }
    }
    if (part == 0) {
#pragma unroll
      for (int i = 0; i < 16; ++i) {
        slot[m * 33 + i] = __float_as_uint(v1[i]);
        slot[m * 33 + 16 + i] = __float_as_uint(v2[i]);
      }
      float fv[16];
#pragma unroll
      for (int i = 0; i < 16; ++i) fv[i] = -3.0e38f;
#pragma unroll
      for (int a = 0; a < 16; ++a)
#pragma unroll
        for (int b = 0; b < 16; ++b)
          if ((a + 1) * (b + 1) <= 16) {
            float sum = __uint_as_float(__float_as_uint(v1[a]) & 0xffffff80u) + __uint_as_float(__float_as_uint(v2[b]) & 0xffffff80u);
            unsigned u = (__float_as_uint(sum) & 0xffffff00u) | (unsigned)(a * 16 + b);
            ins16(fv, __uint_as_float(u));
          }
      float e[16];
      int ex[16];
      float mx = __uint_as_float(__float_as_uint(fv[0]) & 0xffffff00u), sum = 0.f;
#pragma unroll
      for (int i = 0; i < 16; ++i) {
        unsigned u = __float_as_uint(fv[i]);
        int code = (int)(u & 0xffu);
        float val = __uint_as_float(u & 0xffffff00u);
        int k1 = (int)(slot[m * 33 + (code >> 4)] & 127u);
        int k2 = (int)(slot[m * 33 + 16 + (code & 15)] & 127u);
        ex[i] = k1 * 128 + k2;
        e[i] = __expf(val - mx);
        sum += e[i];
      }
      float inv = __builtin_amdgcn_rcpf(sum);
      size_t o = (size_t)(tt * 128 + m) * 128 + hd * 16;
#pragma unroll
      for (int i = 0; i < 16; i += 4) {
        *(int4*)(idxo + o + i) = int4{ex[i], ex[i + 1], ex[i + 2], ex[i + 3]};
        *(float4*)(gateo + o + i) = float4{e[i] * inv, e[i + 1] * inv, e[i + 2] * inv, e[i + 3] * inv};
      }
    }
    __syncthreads();
  }
}

__device__ __forceinline__ void peer_issue(uint4 (&buf)[8], const unsigned char* __restrict__ tab, int idv, int gp, int lane) {
#pragma unroll
  for (int e = 0; e < 8; ++e) {
    const unsigned ex = (unsigned)__builtin_amdgcn_readlane(idv, 8 * e + gp);
    const unsigned char* rowp = tab + ((size_t)ex << 10);
    buf[e] = *(const uint4*)(rowp + (unsigned)(lane << 4));
  }
}
__device__ __forceinline__ float peer_dot(const uint4& r, const f32x2 (&x2)[8]) {
  f32x2 a0 = __builtin_amdgcn_cvt_pk_f32_fp8((int)r.x, false) * x2[0];
  f32x2 a1 = __builtin_amdgcn_cvt_pk_f32_fp8((int)r.x, true) * x2[1];
  a0 += __builtin_amdgcn_cvt_pk_f32_fp8((int)r.y, false) * x2[2];
  a1 += __builtin_amdgcn_cvt_pk_f32_fp8((int)r.y, true) * x2[3];
  a0 += __builtin_amdgcn_cvt_pk_f32_fp8((int)r.z, false) * x2[4];
  a1 += __builtin_amdgcn_cvt_pk_f32_fp8((int)r.z, true) * x2[5];
  a0 += __builtin_amdgcn_cvt_pk_f32_fp8((int)r.w, false) * x2[6];
  a1 += __builtin_amdgcn_cvt_pk_f32_fp8((int)r.w, true) * x2[7];
  a0 += a1;
  return a0.x + a0.y;
}
__device__ __forceinline__ void fmac1(float& o, float a, float x) { asm("v_fmac_f32 %0, %1, %2" : "+v"(o) : "v"(a), "v"(x)); }
__device__ __forceinline__ void peer_axpy(const uint4& r, float a, float (&o)[16]) {
  f32x2 c;
  c = __builtin_amdgcn_cvt_pk_f32_fp8((int)r.x, false); fmac1(o[0], a, c.x); fmac1(o[1], a, c.y);
  c = __builtin_amdgcn_cvt_pk_f32_fp8((int)r.x, true);  fmac1(o[2], a, c.x); fmac1(o[3], a, c.y);
  c = __builtin_amdgcn_cvt_pk_f32_fp8((int)r.y, false); fmac1(o[4], a, c.x); fmac1(o[5], a, c.y);
  c = __builtin_amdgcn_cvt_pk_f32_fp8((int)r.y, true);  fmac1(o[6], a, c.x); fmac1(o[7], a, c.y);
  c = __builtin_amdgcn_cvt_pk_f32_fp8((int)r.z, false); fmac1(o[8], a, c.x); fmac1(o[9], a, c.y);
  c = __builtin_amdgcn_cvt_pk_f32_fp8((int)r.z, true);  fmac1(o[10], a, c.x); fmac1(o[11], a, c.y);
  c = __builtin_amdgcn_cvt_pk_f32_fp8((int)r.w, false); fmac1(o[12], a, c.x); fmac1(o[13], a, c.y);
  c = __builtin_amdgcn_cvt_pk_f32_fp8((int)r.w, true);  fmac1(o[14], a, c.x); fmac1(o[15], a, c.y);
}
__device__ __forceinline__ float reduce8(float (&p)[8], int lane) {
  float q[4];
#pragma unroll
  for (int j = 0; j < 4; ++j) {
    auto r = __builtin_amdgcn_permlane32_swap(__float_as_uint(p[j]), __float_as_uint(p[j + 4]), false, false);
    q[j] = __uint_as_float(r[0]) + __uint_as_float(r[1]);
  }
  float s2[2];
#pragma unroll
  for (int j = 0; j < 2; ++j) {
    auto r = __builtin_amdgcn_permlane16_swap(__float_as_uint(q[j]), __float_as_uint(q[j + 2]), false, false);
    s2[j] = __uint_as_float(r[0]) + __uint_as_float(r[1]);
  }
  const bool b3 = (lane & 8) != 0;
  float keep = b3 ? s2[1] : s2[0];
  float give = b3 ? s2[0] : s2[1];
  float w = keep + dpp_f<0x128>(give);
  w += dpp_f<0xB1>(w);
  w += dpp_f<0x4E>(w);
  w += dpp_f<0x141>(w);
  return w;
}

__device__ __forceinline__ void phase_peer_u(const int TIDX, const int BIDX, const unsigned char* __restrict__ Eu,
                                             const int* __restrict__ idx, const bf16_t* __restrict__ h16, const float* __restrict__ gffn, float* __restrict__ pd, char* smem) {
  const int lane = TIDX & 63, wid = TIDX >> 6;
  const int x = BIDX & 7;
  int nWs = (VGRID >> 3) * 4;
  asm volatile("" : "+s"(nWs));
  const int wslot = __builtin_amdgcn_readfirstlane((BIDX >> 3) * 4 + wid);
  const int g8 = lane >> 3, c8 = lane & 7;
  const int fr = lane & 15, fq = lane >> 4;
  const unsigned tabo = (unsigned)x * (unsigned)(NEXP * 128) + (unsigned)(c8 * 16);
  const unsigned colq = (unsigned)(x * 128 + fq * 16);
  typedef __attribute__((address_space(3))) char lds_char;
  typedef unsigned u32x4_t __attribute__((ext_vector_type(4)));
  typedef __attribute__((address_space(3))) u32x4_t lds_uint4;
  lds_char* lw = (lds_char*)smem + wid * 9216;
  const int woff = g8 * 144 + c8 * 16;
  const int roff = fr * 144 + fq * 16;
  int t = wslot;
  if (t >= T) return;
  int idn[16];
  u32x4_t r[16];
  float gq8[32];
#pragma unroll
  for (int i = 0; i < 16; ++i) { gq8[i] = gffn[colq + i] * 8.0f; gq8[16 + i] = gffn[colq + 64 + i] * 8.0f; }
  typedef __attribute__((address_space(3))) int lds_i;
  typedef __attribute__((address_space(3))) unsigned lds_u;
  lds_i* li = (lds_i*)((lds_char*)smem + 36864 + wid * 1024);
  lds_u* lh = (lds_u*)((lds_char*)smem + 36864 + wid * 1024 + 512);
  int ri0 = idx[(size_t)t * 128 + lane], ri1 = idx[(size_t)t * 128 + 64 + lane];
  unsigned rh = *(const unsigned*)(h16 + (size_t)t * D + x * 128 + 2 * lane);
  li[(lane & 7) * 16 + (lane >> 3)] = ri0; li[(lane & 7) * 16 + 8 + (lane >> 3)] = ri1;
  __builtin_amdgcn_wave_barrier();
#pragma unroll
  for (int q4 = 0; q4 < 4; ++q4) {
    const u32x4_t iv = *(const lds_uint4*)((lds_char*)li + (g8 * 16 + q4 * 4) * 4);
    idn[4 * q4] = (int)iv.x; idn[4 * q4 + 1] = (int)iv.y; idn[4 * q4 + 2] = (int)iv.z; idn[4 * q4 + 3] = (int)iv.w;
  }
#pragma unroll
  for (int j = 0; j < 16; ++j) r[j] = *(const u32x4_t*)(Eu + (size_t)(tabo + ((unsigned)idn[j] << 7)));
  __builtin_amdgcn_wave_barrier();
  if (t + nWs < T) { ri0 = idx[(size_t)(t + nWs) * 128 + lane]; ri1 = idx[(size_t)(t + nWs) * 128 + 64 + lane]; }
  for (; t < T; t += nWs) {
    const int tn = t + nWs, tnn = t + 2 * nWs;
    const bool hasn = tn < T;
    li[(lane & 7) * 16 + (lane >> 3)] = ri0; li[(lane & 7) * 16 + 8 + (lane >> 3)] = ri1;
    lh[lane] = rh;
    __builtin_amdgcn_wave_barrier();
#pragma unroll
    for (int q4 = 0; q4 < 4; ++q4) {
    const u32x4_t iv = *(const lds_uint4*)((lds_char*)li + (g8 * 16 + q4 * 4) * 4);
    idn[4 * q4] = (int)iv.x; idn[4 * q4 + 1] = (int)iv.y; idn[4 * q4 + 2] = (int)iv.z; idn[4 * q4 + 3] = (int)iv.w;
  }
    u32x4_t nc[4];
    nc[0] = *(const lds_uint4*)(lh + fq * 8); nc[1] = *(const lds_uint4*)(lh + fq * 8 + 4);
    nc[2] = *(const lds_uint4*)(lh + 32 + fq * 8); nc[3] = *(const lds_uint4*)(lh + 32 + fq * 8 + 4);
    __builtin_amdgcn_wave_barrier();
    if (hasn) rh = *(const unsigned*)(h16 + (size_t)tn * D + x * 128 + 2 * lane);
    if (tnn < T) { ri0 = idx[(size_t)tnn * 128 + lane]; ri1 = idx[(size_t)tnn * 128 + 64 + lane]; }
    long b8[4];
#pragma unroll
    for (int hh = 0; hh < 2; ++hh) {
      float fv[16];
      const u32x4_t ua = nc[2 * hh], ub = nc[2 * hh + 1];
      fv[0] = bflo(ua.x); fv[1] = bfhi(ua.x); fv[2] = bflo(ua.y); fv[3] = bfhi(ua.y);
      fv[4] = bflo(ua.z); fv[5] = bfhi(ua.z); fv[6] = bflo(ua.w); fv[7] = bfhi(ua.w);
      fv[8] = bflo(ub.x); fv[9] = bfhi(ub.x); fv[10] = bflo(ub.y); fv[11] = bfhi(ub.y);
      fv[12] = bflo(ub.z); fv[13] = bfhi(ub.z); fv[14] = bflo(ub.w); fv[15] = bfhi(ub.w);
      unsigned w[4];
#pragma unroll
      for (int i = 0; i < 4; ++i) {
        int t8 = __builtin_amdgcn_cvt_pk_fp8_f32(fv[4 * i] * gq8[16 * hh + 4 * i], fv[4 * i + 1] * gq8[16 * hh + 4 * i + 1], 0, false);
        t8 = __builtin_amdgcn_cvt_pk_fp8_f32(fv[4 * i + 2] * gq8[16 * hh + 4 * i + 2], fv[4 * i + 3] * gq8[16 * hh + 4 * i + 3], t8, true);
        w[i] = (unsigned)t8;
      }
      b8[2 * hh] = (long)(((unsigned long)w[1] << 32) | w[0]);
      b8[2 * hh + 1] = (long)(((unsigned long)w[3] << 32) | w[2]);
    }
    f32x4 accs[8];
    __builtin_amdgcn_sched_barrier(0);
#define U_QUARTER(q) { \
      lds_char* lb = lw + ((q) & 1) * 4608; \
      *(lds_uint4*)(lb + woff + 0 * 8 * 144) = r[(q) * 4 + 0]; \
      if (hasn) r[(q) * 4 + 0] = *(const u32x4_t*)(Eu + (size_t)(tabo + ((unsigned)idn[(q) * 4 + 0] << 7))); \
      *(lds_uint4*)(lb + woff + 1 * 8 * 144) = r[(q) * 4 + 1]; \
      if (hasn) r[(q) * 4 + 1] = *(const u32x4_t*)(Eu + (size_t)(tabo + ((unsigned)idn[(q) * 4 + 1] << 7))); \
      *(lds_uint4*)(lb + woff + 2 * 8 * 144) = r[(q) * 4 + 2]; \
      if (hasn) r[(q) * 4 + 2] = *(const u32x4_t*)(Eu + (size_t)(tabo + ((unsigned)idn[(q) * 4 + 2] << 7))); \
      *(lds_uint4*)(lb + woff + 3 * 8 * 144) = r[(q) * 4 + 3]; \
      if (hasn) r[(q) * 4 + 3] = *(const u32x4_t*)(Eu + (size_t)(tabo + ((unsigned)idn[(q) * 4 + 3] << 7))); \
      _Pragma("unroll") for (int eg = 0; eg < 2; ++eg) { \
        const u32x4_t a0 = *(const lds_uint4*)(lb + roff + eg * 16 * 144); \
        const u32x4_t a1 = *(const lds_uint4*)(lb + roff + eg * 16 * 144 + 64); \
        f32x4 acc = f32x4{0.f, 0.f, 0.f, 0.f}; \
        acc = __builtin_amdgcn_mfma_f32_16x16x32_fp8_fp8((long)(((unsigned long)a0.y << 32) | a0.x), b8[0], acc, 0, 0, 0); \
        acc = __builtin_amdgcn_mfma_f32_16x16x32_fp8_fp8((long)(((unsigned long)a0.w << 32) | a0.z), b8[1], acc, 0, 0, 0); \
        acc = __builtin_amdgcn_mfma_f32_16x16x32_fp8_fp8((long)(((unsigned long)a1.y << 32) | a1.x), b8[2], acc, 0, 0, 0); \
        acc = __builtin_amdgcn_mfma_f32_16x16x32_fp8_fp8((long)(((unsigned long)a1.w << 32) | a1.z), b8[3], acc, 0, 0, 0); \
        accs[(q) * 2 + eg] = acc; \
      } \
      __builtin_amdgcn_sched_barrier(0); }
    U_QUARTER(0) U_QUARTER(1) U_QUARTER(2) U_QUARTER(3)
#undef U_QUARTER
    {
      f32x4 sel = accs[0];
#pragma unroll
      for (int k = 1; k < 8; ++k) sel = (fr == k) ? accs[k] : sel;
      if (fr < 8) { uint2 pk; pk.x = pack2(sel[0], sel[1]); pk.y = pack2(sel[2], sel[3]);
        *(uint2*)((bf16_t*)pd + ((size_t)x * T + t) * 128 + fr * 16 + fq * 4) = pk; }
    }
  }
}

__device__ __forceinline__ void phase_peer_act(const int TIDX, const int BIDX, const float* __restrict__ pd, const int* __restrict__ idx,
                                               const float* __restrict__ gate, const float* __restrict__ su, const float* __restrict__ sv,
                                               const float* __restrict__ ssq, float* __restrict__ act) {
  const size_t gtid = (size_t)BIDX * 256 + TIDX, gsz = (size_t)VGRID * 256;
  constexpr size_t N8 = (size_t)T * 16;
  for (size_t u8 = gtid; u8 < N8; u8 += gsz) {
    uint4 p[8];
#pragma unroll
    for (int x = 0; x < 8; ++x) p[x] = ((const uint4*)((const bf16_t*)pd + (size_t)x * T * 128))[u8];
    const int4 e0 = ((const int4*)idx)[2 * u8], e1 = ((const int4*)idx)[2 * u8 + 1];
    const float4 g0 = ((const float4*)gate)[2 * u8], g1 = ((const float4*)gate)[2 * u8 + 1];
    float suv[8], svv[8];
    suv[0] = su[e0.x]; suv[1] = su[e0.y]; suv[2] = su[e0.z]; suv[3] = su[e0.w];
    suv[4] = su[e1.x]; suv[5] = su[e1.y]; suv[6] = su[e1.z]; suv[7] = su[e1.w];
    svv[0] = sv[e0.x]; svv[1] = sv[e0.y]; svv[2] = sv[e0.z]; svv[3] = sv[e0.w];
    svv[4] = sv[e1.x]; svv[5] = sv[e1.y]; svv[6] = sv[e1.z]; svv[7] = sv[e1.w];
    const float rsq = __builtin_amdgcn_rsqf(ssq[u8 >> 4] * (1.0f / D) + EPS) * 0.125f;
    float d[8];
#pragma unroll
    for (int i = 0; i < 8; ++i) d[i] = 0.f;
#pragma unroll
    for (int x = 0; x < 8; ++x) {
      d[0] += bflo(p[x].x); d[1] += bfhi(p[x].x); d[2] += bflo(p[x].y); d[3] += bfhi(p[x].y);
      d[4] += bflo(p[x].z); d[5] += bfhi(p[x].z); d[6] += bflo(p[x].w); d[7] += bfhi(p[x].w);
    }
    const float gv[8] = {g0.x, g0.y, g0.z, g0.w, g1.x, g1.y, g1.z, g1.w};
    float o[8];
#pragma unroll
    for (int i = 0; i < 8; ++i) o[i] = gelu_tanh(d[i] * suv[i] * rsq) * gv[i] * svv[i];
    uint4 ob; ob.x = pack2(o[0], o[1]); ob.y = pack2(o[2], o[3]); ob.z = pack2(o[4], o[5]); ob.w = pack2(o[6], o[7]);
    ((uint4*)act)[u8] = ob;
  }
}

__device__ __forceinline__ void phase_peer_v(const int TIDX, const int BIDX, const unsigned char* __restrict__ Ev,
                                             const int* __restrict__ idx, const float* __restrict__ act, bf16_t* h, bf16_t* a3,
                                             float* __restrict__ ssq, char* smem) {
  const int lane = TIDX & 63, wid = TIDX >> 6;
  const int x = BIDX & 7;
  int nWs = (VGRID >> 3) * 4;
  asm volatile("" : "+s"(nWs));
  const int wslot = __builtin_amdgcn_readfirstlane((BIDX >> 3) * 4 + wid);
  const int g = lane >> 3, c8 = lane & 7;
  const unsigned tabo = (unsigned)x * (unsigned)(NEXP * 128) + (unsigned)(c8 * 16);
  typedef __attribute__((address_space(3))) int lds_i;
  typedef __attribute__((address_space(3))) float lds_f;
  typedef int i32x4_t __attribute__((ext_vector_type(4)));
  typedef float f32x4_t __attribute__((ext_vector_type(4)));
  typedef __attribute__((address_space(3))) i32x4_t lds_i4;
  typedef __attribute__((address_space(3))) f32x4_t lds_f4;
  lds_i* li = (lds_i*)((__attribute__((address_space(3))) char*)smem + wid * 1024);
  typedef __attribute__((address_space(3))) unsigned lds_u;
  typedef unsigned u32x4_a __attribute__((ext_vector_type(4)));
  typedef __attribute__((address_space(3))) u32x4_a lds_u4;
  lds_u* lf = (lds_u*)((__attribute__((address_space(3))) char*)smem + wid * 1024 + 512);
  int t = wslot;
  if (t >= T) return;
  typedef unsigned u32x4_t __attribute__((ext_vector_type(4)));
  u32x4_t r[16];
  i32x4_t idn[4];
  float ac[16];
  int ri0 = idx[(size_t)t * 128 + lane], ri1 = idx[(size_t)t * 128 + 64 + lane];
  unsigned ra = ((const unsigned*)act)[(size_t)t * 64 + lane];
  li[lane] = ri0; li[64 + lane] = ri1;
  __builtin_amdgcn_wave_barrier();
#pragma unroll
  for (int q = 0; q < 4; ++q) idn[q] = *(const lds_i4*)(li + g * 16 + q * 4);
#pragma unroll
  for (int j = 0; j < 16; ++j) {
    const unsigned e = (unsigned)idn[j >> 2][j & 3];
    r[j] = *(const u32x4_t*)(Ev + (size_t)(tabo + (e << 7)));
  }
  __builtin_amdgcn_wave_barrier();
  if (t + nWs < T) { ri0 = idx[(size_t)(t + nWs) * 128 + lane]; ri1 = idx[(size_t)(t + nWs) * 128 + 64 + lane]; }
  for (; t < T; t += nWs) {
    const int tn = t + nWs, tnn = t + 2 * nWs;
    const bool hasn = tn < T;
    const int col = x * 128 + c8 * 16 + 2 * g;
    li[lane] = ri0; li[64 + lane] = ri1;
    lf[lane] = ra;
    __builtin_amdgcn_wave_barrier();
#pragma unroll
    for (int q = 0; q < 4; ++q) {
      idn[q] = *(const lds_i4*)(li + g * 16 + q * 4);
    }
    {
      const u32x4_a a0 = *(const lds_u4*)(lf + g * 8), a1 = *(const lds_u4*)(lf + g * 8 + 4);
      ac[0] = bflo(a0.x); ac[1] = bfhi(a0.x); ac[2] = bflo(a0.y); ac[3] = bfhi(a0.y);
      ac[4] = bflo(a0.z); ac[5] = bfhi(a0.z); ac[6] = bflo(a0.w); ac[7] = bfhi(a0.w);
      ac[8] = bflo(a1.x); ac[9] = bfhi(a1.x); ac[10] = bflo(a1.y); ac[11] = bfhi(a1.y);
      ac[12] = bflo(a1.z); ac[13] = bfhi(a1.z); ac[14] = bflo(a1.w); ac[15] = bfhi(a1.w);
    }
    __builtin_amdgcn_wave_barrier();
    const unsigned hp = *(const unsigned*)(h + (size_t)t * D + col);
    float2 hv = float2{bflo(hp), bfhi(hp)};
    if (hasn) ra = ((const unsigned*)act)[(size_t)tn * 64 + lane];
    if (tnn < T) { ri0 = idx[(size_t)tnn * 128 + lane]; ri1 = idx[(size_t)tnn * 128 + 64 + lane]; }
    __builtin_amdgcn_sched_barrier(0);
    float o[16];
#pragma unroll
    for (int i = 0; i < 16; ++i) o[i] = 0.f;
#pragma unroll
    for (int j = 0; j < 16; ++j) {
      peer_axpy(uint4{r[j].x, r[j].y, r[j].z, r[j].w}, ac[j], o);
      if (hasn) {
        const unsigned e = (unsigned)idn[j >> 2][j & 3];
        r[j] = *(const u32x4_t*)(Ev + (size_t)(tabo + (e << 7)));
      }
      __builtin_amdgcn_sched_barrier(0);
    }
    float q8[8];
#pragma unroll
    for (int i = 0; i < 8; ++i) {
      auto rr = __builtin_amdgcn_permlane32_swap(__float_as_uint(o[i]), __float_as_uint(o[i + 8]), false, false);
      q8[i] = __uint_as_float(rr[0]) + __uint_as_float(rr[1]);
    }
    float s4[4];
#pragma unroll
    for (int i = 0; i < 4; ++i) {
      auto rr = __builtin_amdgcn_permlane16_swap(__float_as_uint(q8[i]), __float_as_uint(q8[i + 4]), false, false);
      s4[i] = __uint_as_float(rr[0]) + __uint_as_float(rr[1]);
    }
    const bool b3 = (lane & 8) != 0;
    float w0 = (b3 ? s4[2] : s4[0]) + dpp_f<0x128>(b3 ? s4[0] : s4[2]);
    float w1 = (b3 ? s4[3] : s4[1]) + dpp_f<0x128>(b3 ? s4[1] : s4[3]);
    hv.x += w0; hv.y += w1;
    float ss = wave_sum(hv.x * hv.x + hv.y * hv.y);
    const unsigned hq = pack2(hv.x, hv.y);
    *(unsigned*)(h + (size_t)t * D + col) = hq;
    *(unsigned*)(a3 + (size_t)t * D + col) = hq;
    if (lane == 0) ssq[(size_t)x * T + t] = ss;
  }
}

#define XB_TMO      128
#define XB_XCNT(j)  (256  + 64 * (j))
#define XB_XSUB(j)  (1280 + 64 * (j))
#define XB_XGEN(j)  (2304 + 64 * (j))
#define XB_TOP      3328
#define XB_TOPGEN   3392
#define XCD_BAR_WORDS 3456
#define XB_SPIN_CAP (1u << 18)
#define LAS __attribute__((address_space(3)))

__device__ __forceinline__ unsigned xb_ld(unsigned* p)              { return __hip_atomic_load(p, __ATOMIC_RELAXED, __HIP_MEMORY_SCOPE_AGENT); }
__device__ __forceinline__ unsigned xb_add(unsigned* p, unsigned v) { return __hip_atomic_fetch_add(p, v, __ATOMIC_RELAXED, __HIP_MEMORY_SCOPE_AGENT); }
__device__ __forceinline__ unsigned xb_xcc_id() { return (unsigned)__builtin_amdgcn_s_getreg((3 << 11) | 20) & 0xFu; }
#define XB_SPIN(cond, bar) do { unsigned _sp = 0; while (cond) { __builtin_amdgcn_s_sleep(1); \
    if ((++_sp & 255u) == 0u) { if (xb_ld(&(bar)[XB_TMO])) break; if (_sp > XB_SPIN_CAP) { atomicAdd(&(bar)[XB_TMO], 1u); break; } } } } while (0)

struct XcdBarrier {
    unsigned* bar; unsigned x;
    volatile LAS unsigned* st;
};

__device__ __forceinline__ XcdBarrier xcd_barrier_post(unsigned* bar, volatile LAS unsigned* st) {
    XcdBarrier b; b.bar = bar; b.x = xb_xcc_id(); b.st = st;
    if (threadIdx.x == 0) (void)xb_add(&bar[XB_XCNT(b.x)], 1u);
    return b;
}
__device__ __forceinline__ void xcd_barrier_complete(unsigned* bar, unsigned x, unsigned& nloc, unsigned& nx) {
    const unsigned G = gridDim.x * gridDim.y * gridDim.z;
    unsigned sum, cnt, mine, sp = 0u;
    for (;;) {
        sum = 0u; cnt = 0u; mine = 0u;
#pragma unroll
        for (unsigned j = 0; j < 16; ++j) { const unsigned c = xb_ld(&bar[XB_XCNT(j)]); sum += c; cnt += (c > 0u) ? 1u : 0u; mine = (j == x) ? c : mine; }
        if (sum == G) break;
        __builtin_amdgcn_s_sleep(1);
        if ((++sp & 255u) == 0u) { if (xb_ld(&bar[XB_TMO])) break; if (sp > XB_SPIN_CAP) { atomicAdd(&bar[XB_TMO], 1u); break; } }
    }
    nloc = mine > 0u ? mine : 1u; nx = cnt > 0u ? cnt : 1u;
}

__device__ __forceinline__ void xcd_barrier(const XcdBarrier& b) {
    asm volatile("s_waitcnt vmcnt(0)" ::: "memory");
    __syncthreads();
    if (threadIdx.x == 0) {
        unsigned* bar = b.bar;
        __builtin_amdgcn_s_waitcnt(0);
        unsigned nloc = b.st[0], nx = b.st[1];
        if (nloc == 0u) { xcd_barrier_complete(bar, b.x, nloc, nx); b.st[0] = nloc; b.st[1] = nx; }
        const unsigned old = xb_add(&bar[XB_XSUB(b.x)], 1u);
        const unsigned gen = old / nloc;
        if (old + 1u == (gen + 1u) * nloc) {
            __builtin_amdgcn_fence(__ATOMIC_RELEASE, "agent");
            asm volatile("s_waitcnt vmcnt(0)" ::: "memory");
            const unsigned og = xb_add(&bar[XB_TOP], 1u);
            const unsigned tg = og / nx;
            if (og + 1u == (tg + 1u) * nx) xb_add(&bar[XB_TOPGEN], 1u);
            else XB_SPIN(xb_ld(&bar[XB_TOPGEN]) == tg, bar);
            __builtin_amdgcn_fence(__ATOMIC_ACQUIRE, "agent");
            xb_add(&bar[XB_XGEN(b.x)], 1u);
            asm volatile("s_waitcnt vmcnt(0)" ::: "memory");
        } else {
            XB_SPIN(xb_ld(&bar[XB_XGEN(b.x)]) == gen, bar);
            __builtin_amdgcn_fence(__ATOMIC_ACQUIRE, "agent");
            asm volatile("s_waitcnt vmcnt(0)" ::: "memory");
        }
    }
    __syncthreads();
}

__device__ __forceinline__ int rebuild_tid(const int wave_id) {
  int lane_id;
  asm volatile("v_mbcnt_lo_u32_b32 %0, -1, 0\n\tv_mbcnt_hi_u32_b32 %0, -1, %0" : "=v"(lane_id));
  return wave_id * 64 + lane_id;
}
__device__ __forceinline__ void run_phase(const int WAVE_ID, const int BL, const Params& P, int ph, char* smem_all) {
  char* ws = P.ws;
  bf16_t* abuf = (bf16_t*)(ws + OFF_ABUF);
  bf16_t* zb = (bf16_t*)(ws + OFF_Z);
  bf16_t* h = (bf16_t*)(ws + OFF_H);
#define VB_PROLOGUE int t2 = rebuild_tid(WAVE_ID); const int TIDX = t2 & 255; const int half_ = __builtin_amdgcn_readfirstlane(t2 >> 8); const int BIDX = BL + half_ * (int)gridDim.x; char* smem = smem_all + half_ * 65536; (void)smem;
  if (ph == 0) { VB_PROLOGUE phase_convert(TIDX, BIDX, P); return; }
  if (ph == NPHASE - 1) { VB_PROLOGUE phase_norm<2, true>(TIDX, BIDX, h, P.in[22], nullptr, P.out); return; }
  const int L = (ph - 1) / 11, s = (ph - 1) % 11;
  const unsigned char* Eu = (const unsigned char*)(ws + OFF_EU) + (size_t)L * NEXP * 1024;
  const unsigned char* Ev = (const unsigned char*)(ws + OFF_EV) + (size_t)L * NEXP * 1024;
  const float* su = (const float*)(ws + OFF_ESC) + L * NEXP;
  const float* sv = (const float*)(ws + OFF_ESC) + (2 + L) * NEXP;
  int* idxb = (int*)(ws + OFF_IDX);
  float* gateb = (float*)(ws + OFF_GATE);
  float* pd = (float*)(ws + OFF_Z);
  float* actb = (float*)(ws + OFF_ACT);
  float* ssq = (float*)(ws + OFF_SSQ);
  float* ssqA = (float*)(ws + OFF_SSQA);
  float* ssqB = (float*)(ws + OFF_SSQB);
  switch (s) {
    case 0: { VB_PROLOGUE phase_norm<0, false>(TIDX, BIDX, P.in[0], nullptr, abuf, nullptr); } break;
    case 1: if (L == 0) run_gemm(rebuild_tid(WAVE_ID), BL, smem_all, abuf, (const bf16_t*)(ws + OFF_WINT), 2304, 1024, pg8::EpiBf16<0>{zb, 2304, nullptr, 0, 0});
            else run_gemm(rebuild_tid(WAVE_ID), BL, smem_all, h, (const bf16_t*)(ws + OFF_WINT) + (size_t)2304 * 1024, 2304, 1024, EpiBf16Rs{zb, 2304, ssqB, WAVE_ID}); break;
    case 2: { VB_PROLOGUE for (int i = BIDX * 256 + TIDX; i < T; i += VGRID * 256) ssqA[i] = 0.f;
      phase_mix(TIDX, BIDX, P, L, zb, abuf, (const bf16_t*)(ws + OFF_WSB) + (size_t)L * 6 * 128 * 128, smem); } break;
    case 3: if (L == 0) run_gemm(rebuild_tid(WAVE_ID), BL, smem_all, abuf, (const bf16_t*)(ws + OFF_WOUTT), 1024, 1024, EpiResid<false>{P.in[0], h, ssqA, WAVE_ID});
            else run_gemm(rebuild_tid(WAVE_ID), BL, smem_all, abuf, (const bf16_t*)(ws + OFF_WOUTT) + (size_t)1024 * 1024, 1024, 1024, EpiResid<true>{h, h, ssqA, WAVE_ID}); break;
    case 4: break;
    case 5: run_gemm(rebuild_tid(WAVE_ID), BL, smem_all, h, (const bf16_t*)(ws + OFF_WQT) + (size_t)L * 2048 * 1024, 2048, 1024, EpiBf16Rs{zb, 2048, ssqA, WAVE_ID}); break;
    case 6: { VB_PROLOGUE
      phase_scores(TIDX, BIDX, zb, (const bf16_t*)(ws + OFF_KEYS) + (size_t)L * 8 * 2 * 128 * 128, idxb, gateb, smem); } break;
    case 7: { VB_PROLOGUE
      phase_peer_u(TIDX, BIDX, Eu, idxb, h, P.in[14] + L * 1024, pd, smem); } break;
    case 8: { VB_PROLOGUE for (int i = BIDX * 256 + TIDX; i < T; i += VGRID * 256) ssqB[i] = 0.f;
      phase_peer_act(TIDX, BIDX, pd, idxb, gateb, su, sv, ssqA, actb); } break;
    case 9: { VB_PROLOGUE phase_peer_v(TIDX, BIDX, Ev, idxb, actb, h, abuf, ssq, smem); } break;
    case 10:
      run_gemm(rebuild_tid(WAVE_ID), BL, smem_all, abuf, (const bf16_t*)(ws + OFF_WPGT) + (size_t)L * 1024 * 1024, 1024, 1024, EpiSig{ssq, zb, WAVE_ID});
      run_gemm(rebuild_tid(WAVE_ID), BL, smem_all, (const bf16_t*)(ws + OFF_PBF) + (size_t)L * T * 256, (const bf16_t*)(ws + OFF_WPET) + (size_t)L * 1024 * 256, 1024, 256, EpiPle{h, zb, ssqB, WAVE_ID});
      break;
  }
}

__global__ void __launch_bounds__(512, 2) peer_trunk_mk(Params P) {
  extern __shared__ __attribute__((aligned(16))) char smem[];
  cg::grid_group grid = cg::this_grid();
  unsigned* bar = (unsigned*)(P.ws + OFF_BAR);
  volatile LAS unsigned* st = (volatile LAS unsigned*)((LAS char*)smem + 131072);
  if (threadIdx.x == 0) { st[0] = 0u; st[1] = 0u; }
  if (blockIdx.x == 0) { for (int i = threadIdx.x; i < XCD_BAR_WORDS; i += 512) bar[i] = 0u; }
  __syncthreads();
  XcdBarrier xb{};
  const int wave_id = __builtin_amdgcn_readfirstlane((int)threadIdx.x >> 6);
  int ph = P.ph_lo;
#ifdef PROBE_DUP
  int dup_left = 1;
#endif
  while (ph < P.ph_hi) {
    int bl = (int)__builtin_amdgcn_workgroup_id_x();
    asm volatile("" : "+s"(bl));
    run_phase(wave_id, bl, P, ph, smem);
    int nph = ph + 1;
    while (nph < NPHASE - 1 && (((nph - 1) % 11) == 4 || nph == 12)) ++nph;
#ifdef PROBE_DUP
    if (ph == 1 + PROBE_DUP && dup_left) { dup_left = 0; nph = ph; }
#endif
    if (nph < P.ph_hi) {
      if (ph == 0) { grid.sync(); xb = xcd_barrier_post(bar, st); }
      else xcd_barrier(xb);
    }
    ph = nph;
  }
}

extern "C" void kernel_launch(void* const* d_in, const int* in_sizes, int n_in, void* d_out, int out_size,
                              void* d_ws, size_t ws_size, hipStream_t stream) {
  static int grid_blocks = 0;
  if (grid_blocks == 0) {
    if (n_in != 23 || ws_size < WS_END) { fprintf(stderr, "kernel_launch: unexpected n_in %d or ws_size %zu (< %zu)\n", n_in, ws_size, (size_t)WS_END); grid_blocks = -1; return; }
    int dev = 0, cus = 0, per_cu = 0;
    hipGetDevice(&dev);
    hipDeviceGetAttribute(&cus, hipDeviceAttributeMultiprocessorCount, dev);
    hipFuncSetAttribute((const void*)peer_trunk_mk, hipFuncAttributeMaxDynamicSharedMemorySize, SMEM_BYTES);
    hipOccupancyMaxActiveBlocksPerMultiprocessor(&per_cu, (const void*)peer_trunk_mk, 512, SMEM_BYTES);
    if (per_cu < 1) per_cu = 1;
    if (per_cu > 1) per_cu = 1;
    grid_blocks = cus * per_cu;
    fprintf(stderr, "kernel_launch: cus %d per_cu %d grid %d\n", cus, per_cu, grid_blocks);
  }
  if (grid_blocks < 0) return;
  Params P{};
  for (int i = 0; i < 23; ++i) P.in[i] = (const float*)d_in[i];
  P.out = (float*)d_out;
  P.ws = (char*)d_ws;
#if ONE_LAUNCH
  P.ph_lo = 0; P.ph_hi = NPHASE;
  void* args[] = {&P};
  hipError_t e = hipLaunchCooperativeKernel((void*)peer_trunk_mk, dim3(grid_blocks), dim3(512), args, SMEM_BYTES, stream);
  if (e != hipSuccess) fprintf(stderr, "cooperative launch failed: %s (grid %d)\n", hipGetErrorString(e), grid_blocks);
#else
  for (int ph = 0; ph < NPHASE; ++ph) {
    P.ph_lo = ph; P.ph_hi = ph + 1;
    hipLaunchKernelGGL(peer_trunk_mk, dim3(grid_blocks), dim3(512), SMEM_BYTES, stream, P);
  }
#endif
}
```
